# Optimizing an MI355X kernel written in HIP

```python
import jax, jax.numpy as jnp
from jax import lax
import numpy as np

D_MODEL = 1024
BATCH = 8
SEQ = 2048
DEPTH = 1
DEC_BATCH = 128
DEC_SEQ = 4
PAST_LEN = 16384
PAGE_SIZE = 128

CHUNK = 128
D_A = D_MODEL
GROUPS_A = 8
GW_A = D_A // GROUPS_A
HEAD_B = 64
D_B = D_MODEL
H_B = D_B // HEAD_B
DECAY_LORA = 64
ICLR_LORA = 64
GATE_LORA = 128
H_C = 4
D_C = D_MODEL
DH_C = D_C // H_C
N_MEM = 256
D_FF = 4 * D_MODEL
N_BRANCH = 3
P_SHIFT = 3 * D_B + DECAY_LORA + ICLR_LORA + GATE_LORA
P_IN = 2 * D_A + P_SHIFT + D_C + N_BRANCH * D_MODEL
RMS_EPS = 1e-6
LN_EPS = 1e-5
GN_EPS = 64e-5

kernel_name = "gmlp_rwkv7_memxattn_hybrid_step"


def _split(z, widths):
    outs, o = [], 0
    for w in widths:
        outs.append(z[..., o:o + w])
        o += w
    return outs


def rmsnorm(x, g):
    xf = x.astype(jnp.float32)
    y = xf * lax.rsqrt(jnp.mean(xf * xf, axis=-1, keepdims=True) + RMS_EPS)
    return (y * g.astype(jnp.float32)).astype(x.dtype)


def layernorm(x, g, b):
    xf = x.astype(jnp.float32)
    mu = jnp.mean(xf, axis=-1, keepdims=True)
    var = jnp.mean(jnp.square(xf - mu), axis=-1, keepdims=True)
    y = (xf - mu) * lax.rsqrt(var + LN_EPS)
    return (y * g.astype(jnp.float32) + b.astype(jnp.float32)).astype(x.dtype)


def spatial_gate(vn, sg_w, sg_b):
    B, T, _ = vn.shape
    nc = -(-T // CHUNK)
    vp = jnp.pad(vn, ((0, 0), (0, nc * CHUNK - T), (0, 0))).reshape(B, nc, CHUNK, GROUPS_A, GW_A)
    mask = jnp.tril(jnp.ones((CHUNK, CHUNK), dtype=bool))
    w = jnp.where(mask[None], sg_w, jnp.zeros((), sg_w.dtype))
    s = jnp.einsum('gts,bcsgh->bctgh', w, vp) + sg_b.T[None, None, :, :, None]
    return s.reshape(B, nc * CHUNK, D_A)[:, :T]


def wkv7_scan(r, decay, k, v, a_vec, b_vec, s0):
    def step(S, inp):
        r_t, w_t, k_t, v_t, a_t, b_t = inp
        sa = jnp.einsum('bhij,bhj->bhi', S, a_t)
        S = S * w_t[:, :, None, :] + sa[..., None] * b_t[:, :, None, :] + v_t[..., None] * k_t[:, :, None, :]
        return S, jnp.einsum('bhij,bhj->bhi', S, r_t)
    xs = tuple(jnp.moveaxis(t, 1, 0) for t in (r, decay, k, v, a_vec, b_vec))
    S, ys = lax.scan(step, s0, xs)
    return jnp.moveaxis(ys, 0, 1), S


def rwkv7_branch(rz, kz, vz, wl, al, gl, wkv0, p):
    B, T, _ = rz.shape
    f32 = jnp.float32
    w_log = -jax.nn.softplus(-(p['w0'] + jnp.tanh(wl) @ p['w_w2']).astype(f32)) - 0.5
    decay = jnp.exp(-jnp.exp(w_log))
    a = jax.nn.sigmoid((p['a0'] + al @ p['w_a2']).astype(f32))
    g = jax.nn.sigmoid(gl) @ p['w_g2']

    def heads(t):
        return t.astype(f32).reshape(B, T, H_B, HEAD_B)

    kk = heads(kz * p['k_k'])
    kk = kk * lax.rsqrt(jnp.sum(kk * kk, axis=-1, keepdims=True) + 1e-12)
    k = kz.astype(f32) * (1.0 + (a - 1.0) * p['k_a'].astype(f32))
    r_h, k_h, v_h, a_h = heads(rz), heads(k), heads(vz), heads(a)
    y, S = wkv7_scan(r_h, heads(decay), k_h, v_h, -kk, kk * a_h, wkv0.astype(f32))
    mu = jnp.mean(y, axis=-1, keepdims=True)
    var = jnp.mean(jnp.square(y - mu), axis=-1, keepdims=True)
    y = (y - mu) * lax.rsqrt(var + GN_EPS)
    y = y * p['lnx_g'].astype(f32).reshape(H_B, HEAD_B) + p['lnx_b'].astype(f32).reshape(H_B, HEAD_B)
    y = y + jnp.sum(r_h * k_h * p['r_k'].astype(f32), axis=-1, keepdims=True) * v_h
    y = y.reshape(B, T, D_B).astype(rz.dtype) * g
    return y, S


def memory_kv(mem, g, wk, wv):
    B, M, _ = mem.shape
    hm = rmsnorm(mem, g)
    return (hm @ wk).reshape(B, M, H_C, DH_C), (hm @ wv).reshape(B, M, H_C, DH_C)


def memory_cross_attn(qz, mk, mv):
    B, T, _ = qz.shape
    q = qz.reshape(B, T, H_C, DH_C)
    s = jnp.einsum('bthd,bmhd->bhtm', q, mk).astype(jnp.float32) * (DH_C ** -0.5)
    pr = jax.nn.softmax(s, axis=-1).astype(mv.dtype)
    return jnp.einsum('bhtm,bmhd->bthd', pr, mv).reshape(B, T, D_C)


def hybrid_layer(x, mk, mv, shift_prev, wkv_prev, p):
    B, T, _ = x.shape
    h = rmsnorm(x, p['norm1_g'])
    z = h @ p['w_in']
    uz, vz, sz, qz, gz = _split(z, (D_A, D_A, P_SHIFT, D_C, N_BRANCH * D_MODEL))
    prev = jnp.concatenate([shift_prev[:, None].astype(sz.dtype), sz[:, :-1]], axis=1)
    ss = sz + (prev - sz) * p['shift_mu']
    rz, kz, vbz, wl, al, gl = _split(ss, (D_B, D_B, D_B, DECAY_LORA, ICLR_LORA, GATE_LORA))
    u = jax.nn.gelu(uz)
    vn = layernorm(jax.nn.gelu(vz), p['ln_v_g'], p['ln_v_b'])
    y_a = u * spatial_gate(vn, p['sg_w'], p['sg_b'])
    y_b, wkv_new = rwkv7_branch(rz, kz, vbz, wl, al, gl, wkv_prev, p)
    y_c = memory_cross_attn(qz, mk, mv)
    branches = jnp.stack([y_a, y_b, y_c], axis=0)
    proj = jnp.einsum('nbtc,ncd->nbtd', branches, p['w_branch'])
    gates = jax.nn.sigmoid(gz.reshape(B, T, N_BRANCH, D_MODEL))
    merged = jnp.einsum('nbtd,btnd->btd', proj, gates)
    x = x + merged @ p['w_out']
    h2 = rmsnorm(x, p['norm2_g'])
    x = x + jnp.square(jax.nn.relu(h2 @ p['w_up'])) @ p['w_down']
    return x, sz[:, -1], wkv_new.astype(x.dtype), vn


def setup_inputs(seed: int = 0) -> dict:
    key = jax.random.key(seed)
    ks = iter(list(jax.random.split(key, 40)))
    f32 = jnp.float32
    L = DEPTH

    def nrm(shape, scale):
        return jax.random.normal(next(ks), shape, f32) * scale

    def gain(shape):
        return 1.0 + nrm(shape, 0.02)

    def unif(shape, lo, hi):
        return jax.random.uniform(next(ks), shape, f32, lo, hi)

    return {
        "x_prompt": nrm((BATCH, SEQ, D_MODEL), 1.0),
        "x_sample": nrm((DEC_BATCH, DEC_SEQ, D_MODEL), 1.0),
        "mem_prompt": nrm((BATCH, N_MEM, D_MODEL), 1.0),
        "cache_mem_k": nrm((L, DEC_BATCH, N_MEM, H_C, DH_C), 1.0),
        "cache_mem_v": nrm((L, DEC_BATCH, N_MEM, H_C, DH_C), 1.0),
        "state_shift": nrm((L, DEC_BATCH, P_SHIFT), 1.0),
        "state_wkv": nrm((L, DEC_BATCH, H_B, HEAD_B, HEAD_B), 0.1),
        "norm1_g": gain((L, D_MODEL)),
        "w_in": nrm((L, D_MODEL, P_IN), D_MODEL ** -0.5),
        "shift_mu": unif((L, P_SHIFT), 0.0, 1.0),
        "ln_v_g": gain((L, D_A)),
        "ln_v_b": nrm((L, D_A), 0.02),
        "sg_w": nrm((L, GROUPS_A, CHUNK, CHUNK), CHUNK ** -0.5),
        "sg_b": gain((L, GROUPS_A, CHUNK)),
        "w0": unif((L, D_B), -6.0, -1.0),
        "w_w2": nrm((L, DECAY_LORA, D_B), 0.5 * DECAY_LORA ** -0.5),
        "a0": nrm((L, D_B), 0.1),
        "w_a2": nrm((L, ICLR_LORA, D_B), ICLR_LORA ** -0.5),
        "w_g2": nrm((L, GATE_LORA, D_B), GATE_LORA ** -0.5),
        "k_k": 0.85 + nrm((L, D_B), 0.02),
        "k_a": gain((L, D_B)),
        "r_k": nrm((L, H_B, HEAD_B), 0.1),
        "lnx_g": gain((L, D_B)),
        "lnx_b": nrm((L, D_B), 0.02),
        "mem_norm_g": gain((L, D_MODEL)),
        "w_mem_k": nrm((L, D_MODEL, D_C), D_MODEL ** -0.5),
        "w_mem_v": nrm((L, D_MODEL, D_C), D_MODEL ** -0.5),
        "w_branch": nrm((L, N_BRANCH, D_MODEL, D_MODEL), D_MODEL ** -0.5),
        "w_out": nrm((L, D_MODEL, D_MODEL), D_MODEL ** -0.5),
        "norm2_g": gain((L, D_MODEL)),
        "w_up": nrm((L, D_MODEL, D_FF), D_MODEL ** -0.5),
        "w_down": nrm((L, D_FF, D_MODEL), D_FF ** -0.5),
        "norm_f_g": gain((D_MODEL,)),
    }


def reference(x_prompt, x_sample, mem_prompt, cache_mem_k, cache_mem_v, state_shift, state_wkv,
              norm1_g, w_in, shift_mu, ln_v_g, ln_v_b, sg_w, sg_b, w0, w_w2, a0, w_a2, w_g2,
              k_k, k_a, r_k, lnx_g, lnx_b, mem_norm_g, w_mem_k, w_mem_v, w_branch, w_out,
              norm2_g, w_up, w_down, norm_f_g):
    xp, xs = x_prompt, x_sample
    Bp = x_prompt.shape[0]
    p_shift, p_wkv, p_mk, p_mv = [], [], [], []
    s_shift, s_wkv, s_gv = [], [], []
    for l in range(DEPTH):
        p = dict(norm1_g=norm1_g[l], w_in=w_in[l], shift_mu=shift_mu[l], ln_v_g=ln_v_g[l],
                 ln_v_b=ln_v_b[l], sg_w=sg_w[l], sg_b=sg_b[l], w0=w0[l], w_w2=w_w2[l], a0=a0[l],
                 w_a2=w_a2[l], w_g2=w_g2[l], k_k=k_k[l], k_a=k_a[l], r_k=r_k[l], lnx_g=lnx_g[l],
                 lnx_b=lnx_b[l], w_branch=w_branch[l], w_out=w_out[l], norm2_g=norm2_g[l],
                 w_up=w_up[l], w_down=w_down[l])
        mk_p, mv_p = memory_kv(mem_prompt, mem_norm_g[l], w_mem_k[l], w_mem_v[l])
        shift0 = jnp.zeros((Bp, P_SHIFT), x_prompt.dtype)
        wkv0 = jnp.zeros((Bp, H_B, HEAD_B, HEAD_B), jnp.float32)
        xp, sh_p, wkv_p, _ = hybrid_layer(xp, mk_p, mv_p, shift0, wkv0, p)
        xs, sh_s, wkv_s, vn_s = hybrid_layer(xs, cache_mem_k[l], cache_mem_v[l],
                                             state_shift[l], state_wkv[l], p)
        p_shift.append(sh_p); p_wkv.append(wkv_p); p_mk.append(mk_p); p_mv.append(mv_p)
        s_shift.append(sh_s); s_wkv.append(wkv_s); s_gv.append(vn_s)
    y_prompt = rmsnorm(xp, norm_f_g)
    y_sample = rmsnorm(xs, norm_f_g)
    return (y_prompt, y_sample, jnp.stack(p_shift), jnp.stack(p_wkv), jnp.stack(p_mk),
            jnp.stack(p_mv), jnp.stack(s_shift), jnp.stack(s_wkv), jnp.stack(s_gv))
```

```cpp
#include <hip/hip_runtime.h>
#include <hip/hip_cooperative_groups.h>
#include <cstdio>
namespace cg = cooperative_groups;
namespace pg8 {
#define PG8_LAS __attribute__((address_space(3)))
typedef unsigned short bf16_t;
typedef short bf16x8 __attribute__((ext_vector_type(8)));
typedef float f32x4 __attribute__((ext_vector_type(4)));
typedef unsigned u32x4 __attribute__((ext_vector_type(4)));
constexpr int BM = 256, BK = 64, HALF = 128, HTB = HALF * BK * 2  , STAGE_BYTES = 8 * HTB, NXCD = 8, WGM = 8;

__host__ __device__ __forceinline__ int lds_byte(int r, int c) { const int st = (r >> 4) * 2 + (c >> 5), rr = r & 15, cc = c & 31, ob = rr * 64 + cc * 2; return st * 1024 + (ob ^ (((ob >> 9) & 1) << 5)); }
__host__ __device__ __forceinline__ void stage_rc(int b, int& R, int& C) { const int st = b / 1024, sb = b % 1024, swz = sb ^ (((sb >> 9) & 1) << 5); R = (st >> 1) * 16 + swz / 64; C = (st & 1) * 32 + (swz % 64) / 2; }
__host__ __device__ __forceinline__ int perm32(int rho) { const int n = rho >> 4, i = rho & 15; return 8 * (i >> 2) + 4 * n + (i & 3); }

struct Unit { int pm, pn; };
struct Gemm { const bf16_t* A; const bf16_t* Bt; int M, N, K; };

struct StaticOrder {
    int nM, nN, nwg, G, c;
    __host__ __device__ void init(int M, int N, int G_, int c_) { nM = M / BM; nN = N / BM; nwg = nM * nN; G = G_; c = c_; }
    __host__ __device__ bool next(int i, Unit& u) const {
        const long L = (long)i * G + c; if (L >= nwg) return false;
        int wgid = (int)L; { const int q = nwg / NXCD, r = nwg % NXCD, xcd = wgid % NXCD, off = wgid / NXCD; wgid = (xcd < r ? xcd * (q + 1) : r * (q + 1) + (xcd - r) * q) + off; }
        const int nig = WGM * nN, gid = wgid / nig, fm = gid * WGM, gsz = (nM - fm) < WGM ? (nM - fm) : WGM;
        u.pm = fm + ((wgid % nig) % gsz); u.pn = (wgid % nig) / gsz; return true;
    }
    __device__ __forceinline__ void a_ready(const Unit&) const {}
    __device__ __forceinline__ void done(const Unit&) const {}
};
__device__ __forceinline__ unsigned cvt_pk_bf16(float lo, float hi) { unsigned r; asm volatile("v_cvt_pk_bf16_f32 %0, %1, %2" : "=v"(r) : "v"(lo), "v"(hi)); return r; }
template <class Epi, class Sched, bool STAMP = false>
__device__ __forceinline__ void gemm_phase(PG8_LAS unsigned char* lds, const Gemm g, const Sched& S, const Epi& E, unsigned long long* stamps) {
    const int tid = threadIdx.x, wid = __builtin_amdgcn_readfirstlane(tid >> 6), lane = tid & 63, wr = wid >> 2, wc = wid & 3, fr = lane & 15, fq = lane >> 4;
    const int K = g.K, nt = K / BK;
    int ts_lo = 0, ts_hi = 0, nts = 0; const unsigned long long rt_entry = STAMP ? (unsigned long long)wall_clock64() : 0ull;
#define PG8_STAMP() do { if (STAMP && wid == 0 && nts < 64) { const unsigned long long _c = (unsigned long long)clock64(); \
        ts_lo = (lane == nts) ? (int)(unsigned)_c : ts_lo; ts_hi = (lane == nts) ? (int)(unsigned)(_c >> 32) : ts_hi; ++nts; } } while (0)
    PG8_STAMP();
    unsigned voffA[2], voffB[2];
#pragma unroll
    for (int i = 0; i < 2; ++i) { int R, C; stage_rc(tid * 16 + i * 8192, R, C); const int Rb = Epi::PERM ? ((R & ~31) + perm32(R & 31)) : R;
        voffA[i] = (unsigned)(R * K + C) * 2u; voffB[i] = (unsigned)(Rb * K + C) * 2u; }
    const size_t kstep = (size_t)(BK * 2);
    const size_t hstep = (size_t)HALF * K * 2;
    const size_t tstep = 2 * hstep;
    const unsigned ldsw = (unsigned)wid * 1024u;
    const int aoff = lds_byte(wr * 64 + fr, fq * 8), boff = lds_byte(wc * 32 + fr, fq * 8);
#define PG8_SA(b, h) (((b) * 2 + (h)) * HTB)
#define PG8_SB(b, h) ((4 + (b) * 2 + (h)) * HTB)
#define PG8_STAGE(bufoff, gbase, voff) do { _Pragma("unroll") for (int _i = 0; _i < 2; ++_i) \
        __builtin_amdgcn_global_load_lds((const unsigned*)((const char*)(gbase) + (voff)[_i]), (PG8_LAS unsigned*)(lds + (bufoff) + ldsw + _i * 8192), 16, 0, 0); } while (0)
#define PG8_LDA(dst, b, h) do { _Pragma("unroll") for (int m = 0; m < 4; ++m) _Pragma("unroll") for (int k = 0; k < 2; ++k) dst[m][k] = *(const PG8_LAS bf16x8*)(lds + PG8_SA(b, h) + aoff + m * 2048 + k * 1024); } while (0)
#define PG8_LDB(dst, b, h) do { _Pragma("unroll") for (int n = 0; n < 2; ++n) _Pragma("unroll") for (int k = 0; k < 2; ++k) dst[n][k] = *(const PG8_LAS bf16x8*)(lds + PG8_SB(b, h) + boff + n * 2048 + k * 1024); } while (0)
#define PG8_MMA(ai, bj, At, Bt) do { __builtin_amdgcn_s_setprio(1); _Pragma("unroll") for (int m = 0; m < 4; ++m) _Pragma("unroll") for (int n = 0; n < 2; ++n) _Pragma("unroll") for (int k = 0; k < 2; ++k) \
        acc[ai][bj][m][n] = __builtin_amdgcn_mfma_f32_16x16x32_bf16(Bt[n][k], At[m][k], acc[ai][bj][m][n], 0, 0, 0); __builtin_amdgcn_s_setprio(0); } while (0)
#define PG8_WAIT_V(n) asm volatile("s_waitcnt vmcnt(" #n ")" ::: "memory")
#define PG8_WAIT_L(n) asm volatile("s_waitcnt lgkmcnt(" #n ")" ::: "memory")
#define PG8_BAR __builtin_amdgcn_s_barrier()
#define PG8_SCHED __builtin_amdgcn_sched_barrier(0)
    Unit cur, nxt; int ui = 0;
    if (!S.next(0, cur)) return;
    f32x4 acc[2][2][4][2];
#pragma unroll
    for (int a = 0; a < 2; ++a)
#pragma unroll
        for (int b = 0; b < 2; ++b)
#pragma unroll
            for (int m = 0; m < 4; ++m)
#pragma unroll
                for (int n = 0; n < 2; ++n) acc[a][b][m][n] = (f32x4){0.f, 0.f, 0.f, 0.f};
    bf16x8 At[4][2], B0[2][2], B1[2][2];
    const char* cA = (const char*)g.A + (size_t)cur.pm * tstep; const char* cB = (const char*)g.Bt + (size_t)cur.pn * tstep;
    S.a_ready(cur);
    PG8_STAGE(PG8_SB(0, 0), cB, voffB); PG8_STAGE(PG8_SA(0, 0), cA, voffA); PG8_STAGE(PG8_SB(0, 1), cB + hstep, voffB); PG8_STAGE(PG8_SA(0, 1), cA + hstep, voffA);
    if (wr == 1) PG8_BAR;
    PG8_WAIT_V(4); PG8_BAR;
    PG8_STAGE(PG8_SB(1, 0), cB + kstep, voffB); PG8_STAGE(PG8_SA(1, 0), cA + kstep, voffA); PG8_STAGE(PG8_SB(1, 1), cB + hstep + kstep, voffB);
    PG8_WAIT_V(6); PG8_BAR;
    PG8_STAMP();
    for (;;) {
        const bool has_next = S.next(ui + 1, nxt);
        const char* nA = has_next ? (const char*)g.A + (size_t)nxt.pm * tstep : cA; const char* nB = has_next ? (const char*)g.Bt + (size_t)nxt.pn * tstep : cB;
        for (int t = 0; t < nt; t += 2) {
            const bool last = (t == nt - 2);
            const char* a1 = cA + (size_t)(t + 1) * kstep;
            const char* a2 = last ? nA : cA + (size_t)(t + 2) * kstep; const char* b2 = last ? nB : cB + (size_t)(t + 2) * kstep;
            const char* a3 = a2 + kstep; const char* b3 = b2 + kstep;
            if (last && has_next) S.a_ready(nxt);
            PG8_LDB(B0, 0, 0); PG8_SCHED; PG8_LDA(At, 0, 0); PG8_STAGE(PG8_SA(1, 1), a1 + hstep, voffA);
            PG8_WAIT_L(8); PG8_BAR; PG8_WAIT_L(0); PG8_MMA(0, 0, At, B0); PG8_BAR; PG8_SCHED;
            PG8_LDB(B1, 0, 1); PG8_STAGE(PG8_SB(0, 0), b2, voffB);
            PG8_BAR; PG8_WAIT_L(0); PG8_MMA(0, 1, At, B1); PG8_BAR;
            PG8_LDA(At, 0, 1); PG8_STAGE(PG8_SA(0, 0), a2, voffA);
            PG8_BAR; PG8_WAIT_L(0); PG8_MMA(1, 0, At, B0); PG8_BAR; PG8_SCHED;
            PG8_STAGE(PG8_SB(0, 1), b2 + hstep, voffB);
            PG8_WAIT_V(6); PG8_BAR; PG8_MMA(1, 1, At, B1); PG8_BAR;
            PG8_LDB(B0, 1, 0); PG8_SCHED; PG8_LDA(At, 1, 0); PG8_STAGE(PG8_SA(0, 1), a2 + hstep, voffA);
            PG8_WAIT_L(8); PG8_BAR; PG8_WAIT_L(0); PG8_MMA(0, 0, At, B0); PG8_BAR; PG8_SCHED;
            PG8_LDB(B1, 1, 1); PG8_STAGE(PG8_SB(1, 0), b3, voffB);
            PG8_BAR; PG8_WAIT_L(0); PG8_MMA(0, 1, At, B1); PG8_BAR;
            PG8_LDA(At, 1, 1); PG8_STAGE(PG8_SA(1, 0), a3, voffA);
            PG8_BAR; PG8_WAIT_L(0); PG8_MMA(1, 0, At, B0); PG8_BAR; PG8_SCHED;
            PG8_STAGE(PG8_SB(1, 1), b3 + hstep, voffB);
            PG8_WAIT_V(6); PG8_BAR; PG8_MMA(1, 1, At, B1); PG8_BAR;
        }
        PG8_STAMP();
        if constexpr (!Epi::AFTER_DRAIN) { E(acc, cur, wr, wc, fr, fq); S.done(cur); }
        PG8_STAMP();
        if (!has_next) break;
#pragma unroll
        for (int a = 0; a < 2; ++a)
#pragma unroll
            for (int b = 0; b < 2; ++b)
#pragma unroll
                for (int m = 0; m < 4; ++m)
#pragma unroll
                    for (int n = 0; n < 2; ++n) acc[a][b][m][n] = (f32x4){0.f, 0.f, 0.f, 0.f};
        cur = nxt; cA = nA; cB = nB; ++ui;
    }
    PG8_WAIT_V(0);
    if (wr == 0) PG8_BAR;
    PG8_BAR;
    if constexpr (Epi::AFTER_DRAIN) { E.fused(acc, cur, wr, wc, fr, fq, lds, wid, lane); S.done(cur); }
    PG8_STAMP();
    if (STAMP && wid == 0) { stamps[lane] = lane < nts ? (((unsigned long long)(unsigned)ts_hi << 32) | (unsigned)ts_lo) : 0ull;
        if (lane == 62) stamps[62] = rt_entry; if (lane == 63) stamps[63] = (unsigned long long)wall_clock64(); }
#undef PG8_STAMP
#undef PG8_SA
#undef PG8_SB
#undef PG8_STAGE
#undef PG8_LDA
#undef PG8_LDB
#undef PG8_MMA
#undef PG8_WAIT_V
#undef PG8_WAIT_L
#undef PG8_BAR
#undef PG8_SCHED
}
}

using pg8::bf16_t; using pg8::bf16x8; using pg8::f32x4; using pg8::u32x4;
typedef unsigned u32x2 __attribute__((ext_vector_type(2)));
typedef float f32x2 __attribute__((ext_vector_type(2)));
#define LAS __attribute__((address_space(3)))
#ifndef DBG
#define DBG 0
#endif
#ifndef DBGSEL
#define DBGSEL 0
#endif

constexpr int MP = 16384, MS = 512, MT = 16896, DM = 1024, PIN = 9472, PSH = 3328, DFF = 4096;
constexpr int NPANEL = MT / 256;
constexpr size_t O_YP = 0, O_YS = 16777216, O_PSH = 17301504, O_PWKV = 17328128, O_PMK = 17852416, O_PMV = 19949568,
                 O_SSH = 22046720, O_SWKV = 22472704, O_SGV = 30861312, O_END = 31385600;
constexpr size_t WS_CTL = 0, WS_SSQ1 = 256, WS_SSQ2 = WS_SSQ1 + 67584, WS_WTIN = WS_SSQ2 + 67584,
    WS_WTBR = WS_WTIN + 19398656, WS_WTOUT = WS_WTBR + 6291456, WS_WTUP = WS_WTOUT + 2097152, WS_WTDN = WS_WTUP + 8388608,
    WS_WTMKV = WS_WTDN + 8388608, WS_WTW2 = WS_WTMKV + 4194304, WS_WTA2 = WS_WTW2 + 131072, WS_WTG2 = WS_WTA2 + 131072,
    WS_SGW = WS_WTG2 + 262144, WS_HMB = WS_SGW + 262144, WS_MKB = WS_HMB + 4194304, WS_MVT = WS_MKB + 4194304,
    WS_Y3 = WS_MVT + 4194304, WS_GV = WS_Y3 + 103809024, WS_SZ = WS_GV + 34603008, WS_GT = WS_SZ + 112459776,
    WS_HB = WS_GT + 103809024, WS_AV = WS_HB + 34603008, WS_GG = WS_AV + 34603008, WS_END = WS_GG + 34603008;
constexpr size_t WS_MF = WS_SZ, WS_MB = WS_GV, WS_X1 = WS_GT, WS_X1B = WS_HB, WS_HID = WS_Y3, WS_X2 = WS_SZ, WS_E = WS_HB;
constexpr int LDS_BYTES = 131072 + 256;
constexpr int QW_OFF = 131072;

struct Params { const float* in[33]; float* out; unsigned char* ws; };

enum { I_XP = 0, I_XS, I_MEM, I_CK, I_CV, I_SSH, I_SWKV, I_N1G, I_WIN, I_MU, I_LNG, I_LNB, I_SGW, I_SGB, I_W0, I_WW2, I_A0, I_WA2,
       I_WG2, I_KK, I_KA, I_RK, I_LXG, I_LXB, I_MNG, I_WMK, I_WMV, I_WBR, I_WOUT, I_N2G, I_WUP, I_WDN, I_NFG };

__device__ __forceinline__ float bflo(unsigned u) { return __uint_as_float(u << 16); }
__device__ __forceinline__ float bfhi(unsigned u) { return __uint_as_float(u & 0xffff0000u); }
typedef __bf16 bf2_t __attribute__((ext_vector_type(2)));
__device__ __forceinline__ unsigned pk2(float lo, float hi) { const f32x2 v = {lo, hi}; const bf2_t b = __builtin_convertvector(v, bf2_t); return __builtin_bit_cast(unsigned, b); }
__device__ __forceinline__ float rcpf(float x) { return __builtin_amdgcn_rcpf(x); }
__device__ __forceinline__ float sigmoidf_(float x) { return rcpf(1.f + __expf(-x)); }
__device__ __forceinline__ float gelu_tanh(float x) { const float t = 1.5957691216f * (x + 0.044715f * x * x * x); return x * sigmoidf_(t); }
__device__ __forceinline__ float tanhf_(float x) { return 1.f - 2.f * rcpf(__expf(2.f * x) + 1.f); }
template <int CTRL> __device__ __forceinline__ float dpp_mov(float x) { return __int_as_float(__builtin_amdgcn_update_dpp(0, __float_as_int(x), CTRL, 0xF, 0xF, true)); }
__device__ __forceinline__ float red8(float x) { x += dpp_mov<0xB1>(x); x += dpp_mov<0x4E>(x); x += dpp_mov<0x141>(x); return x; }
__device__ __forceinline__ float red16(float x) { x = red8(x); x += dpp_mov<0x140>(x); return x; }
__device__ __forceinline__ float wave_sum(float x) { x = red16(x); x += __shfl_xor(x, 16); x += __shfl_xor(x, 32); return x; }
__device__ __forceinline__ float wave_max(float x) {
#pragma unroll
    for (int o = 1; o < 64; o <<= 1) x = fmaxf(x, __shfl_xor(x, o));
    return x; }
__device__ __forceinline__ f32x4 mfma16(bf16x8 a, bf16x8 b, f32x4 c) { return __builtin_amdgcn_mfma_f32_16x16x32_bf16(a, b, c, 0, 0, 0); }
__device__ __forceinline__ void unpack4(u32x2 q, float (&o)[4]) { o[0] = bflo(q[0]); o[1] = bfhi(q[0]); o[2] = bflo(q[1]); o[3] = bfhi(q[1]); }

struct TJob { const float* src; bf16_t* dst; const float* gain; int K, N; };
__device__ __forceinline__ void transpose_tile(const TJob& j, int tile, LAS float* t) {
    const int tid = threadIdx.x; const int tn = j.N >> 6; const int k0 = (tile / tn) << 6, n0 = (tile % tn) << 6;
#pragma unroll
    for (int pp = 0; pp < 2; ++pp) { const int r = (tid >> 4) + pp * 32, c = (tid & 15) * 4;
        const f32x4 v = *(const f32x4*)(j.src + (size_t)(k0 + r) * j.N + n0 + c); const float g = j.gain ? j.gain[k0 + r] : 1.f;
        t[r * 65 + c] = v[0] * g; t[r * 65 + c + 1] = v[1] * g; t[r * 65 + c + 2] = v[2] * g; t[r * 65 + c + 3] = v[3] * g; }
    __syncthreads();
    { const int n = tid >> 3, k8 = (tid & 7) * 8; u32x4 o;
#pragma unroll
      for (int q = 0; q < 4; ++q) o[q] = pk2(t[(k8 + 2 * q) * 65 + n], t[(k8 + 2 * q + 1) * 65 + n]);
      *(u32x4*)(j.dst + (size_t)(n0 + n) * j.K + k0 + k8) = o; }
    __syncthreads();
}
__device__ __forceinline__ void phase0(const Params& p, LAS unsigned char* lds) {
    const int tid = threadIdx.x, wid = tid >> 6, lane = tid & 63; unsigned char* ws = p.ws;
    if (blockIdx.x == 0) {
        if (tid < 64) ((unsigned*)(ws + WS_CTL))[tid] = 0u;
        float* z = (float*)(ws + WS_SSQ1);
        for (int i = tid; i < 2 * MT; i += 512) z[i] = 0.f;
    }
    for (int it = blockIdx.x; it < 6016; it += gridDim.x) {
        TJob j; int base;
        if (it < 2368)      { j = {p.in[I_WIN], (bf16_t*)(ws + WS_WTIN), p.in[I_N1G], 1024, PIN}; base = 0; }
        else if (it < 3136) { const int n = (it - 2368) >> 8; j = {p.in[I_WBR] + (size_t)n * 1048576, (bf16_t*)(ws + WS_WTBR) + (size_t)n * 1048576, nullptr, 1024, 1024}; base = 2368 + n * 256; }
        else if (it < 3392) { j = {p.in[I_WOUT], (bf16_t*)(ws + WS_WTOUT), nullptr, 1024, 1024}; base = 3136; }
        else if (it < 4416) { j = {p.in[I_WUP], (bf16_t*)(ws + WS_WTUP), p.in[I_N2G], 1024, 4096}; base = 3392; }
        else if (it < 5440) { j = {p.in[I_WDN], (bf16_t*)(ws + WS_WTDN), nullptr, 4096, 1024}; base = 4416; }
        else if (it < 5696) { j = {p.in[I_WMK], (bf16_t*)(ws + WS_WTMKV), p.in[I_MNG], 1024, 1024}; base = 5440; }
        else if (it < 5952) { j = {p.in[I_WMV], (bf16_t*)(ws + WS_WTMKV) + 1048576, p.in[I_MNG], 1024, 1024}; base = 5696; }
        else if (it < 5968) { j = {p.in[I_WW2], (bf16_t*)(ws + WS_WTW2), nullptr, 64, 1024}; base = 5952; }
        else if (it < 5984) { j = {p.in[I_WA2], (bf16_t*)(ws + WS_WTA2), nullptr, 64, 1024}; base = 5968; }
        else                { j = {p.in[I_WG2], (bf16_t*)(ws + WS_WTG2), nullptr, 128, 1024}; base = 5984; }
        transpose_tile(j, it - base, (LAS float*)lds);
    }
    for (int r = blockIdx.x * 8 + wid; r < MT + 2048; r += gridDim.x * 8) {
        const float* src; bf16_t* dst;
        if (r < MP) { src = p.in[I_XP] + (size_t)r * 1024; dst = (bf16_t*)(ws + WS_HB) + (size_t)r * 1024; }
        else if (r < MT) { src = p.in[I_XS] + (size_t)(r - MP) * 1024; dst = (bf16_t*)(ws + WS_HB) + (size_t)r * 1024; }
        else { src = p.in[I_MEM] + (size_t)(r - MT) * 1024; dst = (bf16_t*)(ws + WS_HMB) + (size_t)(r - MT) * 1024; }
        f32x4 v[4]; float ss = 0.f;
#pragma unroll
        for (int c = 0; c < 4; ++c) { v[c] = *(const f32x4*)(src + c * 256 + lane * 4); ss += v[c][0] * v[c][0] + v[c][1] * v[c][1] + v[c][2] * v[c][2] + v[c][3] * v[c][3]; }
        ss = wave_sum(ss); const float rs = rsqrtf(ss * (1.f / 1024.f) + 1e-6f);
#pragma unroll
        for (int c = 0; c < 4; ++c) { u32x2 o; o[0] = pk2(v[c][0] * rs, v[c][1] * rs); o[1] = pk2(v[c][2] * rs, v[c][3] * rs); *(u32x2*)(dst + c * 256 + lane * 4) = o; }
    }
    { const float* sg = p.in[I_SGW]; bf16_t* d = (bf16_t*)(ws + WS_SGW);
      for (int i = blockIdx.x * 512 + tid; i < 8 * 128 * 128; i += gridDim.x * 512) { const int t = (i >> 7) & 127, s = i & 127; d[i] = (bf16_t)(pk2(s <= t ? sg[i] : 0.f, 0.f) & 0xffffu); } }
}

struct EpiZ {
    static constexpr bool PERM = true, AFTER_DRAIN = false;
    bf16_t *U, *GVp, *SZp, *Qp, *GTp; float* out;
    __device__ __forceinline__ void operator()(const f32x4 (&acc)[2][2][4][2], const pg8::Unit& u, int wr, int wc, int fr, int fq) const {
        const int pn = u.pn; bf16_t* base; int ldc, colt, act;
        if (pn < 4) { base = U; ldc = 1024; colt = pn * 256; act = 1; }
        else if (pn < 8) { base = GVp; ldc = 1024; colt = (pn - 4) * 256; act = 1; }
        else if (pn < 21) { base = SZp; ldc = PSH; colt = (pn - 8) * 256; act = 0; }
        else if (pn < 25) { base = Qp; ldc = 1024; colt = (pn - 21) * 256; act = 3; }
        else { base = GTp; ldc = 3072; colt = (pn - 25) * 256; act = 2; }
        const int row0 = u.pm * 256 + wr * 64 + fr, col0 = colt + wc * 32 + 8 * fq;
#pragma unroll
        for (int ai = 0; ai < 2; ++ai)
#pragma unroll
            for (int m = 0; m < 4; ++m) { const int row = row0 + ai * 128 + m * 16; bf16_t* rowp = base + (size_t)row * ldc + col0;
#pragma unroll
                for (int bj = 0; bj < 2; ++bj) { f32x4 v0 = acc[ai][bj][m][0], v1 = acc[ai][bj][m][1];
                    if (act == 1) {
#pragma unroll
                        for (int q = 0; q < 4; ++q) { v0[q] = gelu_tanh(v0[q]); v1[q] = gelu_tanh(v1[q]); } }
                    else if (act == 2) {
#pragma unroll
                        for (int q = 0; q < 4; ++q) { v0[q] = sigmoidf_(v0[q]); v1[q] = sigmoidf_(v1[q]); } }
                    else if (act == 0) {
                        const bool lastp = row < MP ? ((row & 2047) == 2047) : (((row - MP) & 3) == 3);
                        if (lastp) { float* d = (row < MP ? out + O_PSH + (size_t)(row >> 11) * PSH : out + O_SSH + (size_t)((row - MP) >> 2) * PSH) + col0 + bj * 128;
                            *(f32x4*)d = v0; *(f32x4*)(d + 4) = v1; } }
                    u32x4 o; o[0] = pk2(v0[0], v0[1]); o[1] = pk2(v0[2], v0[3]); o[2] = pk2(v1[0], v1[1]); o[3] = pk2(v1[2], v1[3]);
                    *(u32x4*)(rowp + bj * 128) = o; } }
    }
};
struct EpiMem {
    static constexpr bool PERM = false, AFTER_DRAIN = false;
    float* out; bf16_t *MKB, *MVT;
    __device__ __forceinline__ void operator()(const f32x4 (&acc)[2][2][4][2], const pg8::Unit& u, int wr, int wc, int fr, int fq) const {
        const int row0 = u.pm * 256 + wr * 64 + fr, col0 = u.pn * 256 + wc * 32 + 4 * fq; const bool isv = u.pn >= 4;
#pragma unroll
        for (int ai = 0; ai < 2; ++ai)
#pragma unroll
            for (int m = 0; m < 4; ++m) { const int row = row0 + ai * 128 + m * 16;
#pragma unroll
                for (int bj = 0; bj < 2; ++bj)
#pragma unroll
                    for (int n = 0; n < 2; ++n) { const f32x4 v = acc[ai][bj][m][n]; const int col = col0 + bj * 128 + n * 16;
                        if (!isv) { *(f32x4*)(out + O_PMK + (size_t)row * 1024 + col) = v; u32x2 o; o[0] = pk2(v[0], v[1]); o[1] = pk2(v[2], v[3]); *(u32x2*)(MKB + (size_t)row * 1024 + col) = o; }
                        else { const int c = col - 1024; *(f32x4*)(out + O_PMV + (size_t)row * 1024 + c) = v;
                            const int b = row >> 8, mem = row & 255, head = c >> 8, d = c & 255; bf16_t* dst = MVT + ((size_t)((b * 4 + head) * 256 + d)) * 256 + mem;
                            const unsigned p0 = pk2(v[0], v[1]), p1 = pk2(v[2], v[3]);
                            dst[0] = (bf16_t)(p0 & 0xffffu); dst[256] = (bf16_t)(p0 >> 16); dst[512] = (bf16_t)(p1 & 0xffffu); dst[768] = (bf16_t)(p1 >> 16); } } }
    }
};
struct BranchOrder {
    int G, c;
    __device__ bool next(int i, pg8::Unit& u) const { const int tile = (i / 3) * G + c, n = i % 3; if (tile >= NPANEL * 4) return false; u.pm = n * NPANEL + (tile >> 2); u.pn = n * 4 + (tile & 3); return true; }
    __device__ __forceinline__ void a_ready(const pg8::Unit&) const {}
    __device__ __forceinline__ void done(const pg8::Unit&) const {}
};
struct EpiMerge {
    static constexpr bool PERM = false, AFTER_DRAIN = false;
    const bf16_t* GT; float* MF; bf16_t* MB;
    __device__ __forceinline__ void operator()(const f32x4 (&acc)[2][2][4][2], const pg8::Unit& u, int wr, int wc, int fr, int fq) const {
        const int n = u.pm / NPANEL, pm = u.pm - n * NPANEL, pn = u.pn & 3;
        const int row0 = pm * 256 + wr * 64 + fr, col0 = pn * 256 + wc * 32 + 4 * fq;
#pragma unroll
        for (int ai = 0; ai < 2; ++ai)
#pragma unroll
            for (int m = 0; m < 4; ++m) { const int row = row0 + ai * 128 + m * 16;
#pragma unroll
                for (int bj = 0; bj < 2; ++bj)
#pragma unroll
                    for (int nn = 0; nn < 2; ++nn) { const int col = col0 + bj * 128 + nn * 16; f32x4 v = acc[ai][bj][m][nn];
                        const u32x2 g = *(const u32x2*)(GT + (size_t)row * 3072 + n * 1024 + col); float gf[4]; unpack4(g, gf);
                        v[0] *= gf[0]; v[1] *= gf[1]; v[2] *= gf[2]; v[3] *= gf[3];
                        float* mp = MF + (size_t)row * 1024 + col;
                        if (n == 0) *(f32x4*)mp = v;
                        else if (n == 1) { const f32x4 o = *(const f32x4*)mp; *(f32x4*)mp = o + v; }
                        else { const f32x4 o = *(const f32x4*)mp; v = o + v; u32x2 w; w[0] = pk2(v[0], v[1]); w[1] = pk2(v[2], v[3]); *(u32x2*)(MB + (size_t)row * 1024 + col) = w; } } }
    }
};
struct EpiRes {
    static constexpr bool PERM = false, AFTER_DRAIN = false;
    const float* resP; const float* resS; float* X; bf16_t* XB; float* ssq;
    __device__ __forceinline__ void operator()(const f32x4 (&acc)[2][2][4][2], const pg8::Unit& u, int wr, int wc, int fr, int fq) const {
        const int row0 = u.pm * 256 + wr * 64 + fr, col0 = u.pn * 256 + wc * 32 + 4 * fq;
#pragma unroll
        for (int ai = 0; ai < 2; ++ai)
#pragma unroll
            for (int m = 0; m < 4; ++m) { const int row = row0 + ai * 128 + m * 16; float ss = 0.f;
                const float* rp = row < MP ? resP + (size_t)row * 1024 : resS + (size_t)(row - MP) * 1024;
#pragma unroll
                for (int bj = 0; bj < 2; ++bj)
#pragma unroll
                    for (int nn = 0; nn < 2; ++nn) { const int col = col0 + bj * 128 + nn * 16; const f32x4 r = *(const f32x4*)(rp + col); const f32x4 v = acc[ai][bj][m][nn] + r;
                        *(f32x4*)(X + (size_t)row * 1024 + col) = v; ss += v[0] * v[0] + v[1] * v[1] + v[2] * v[2] + v[3] * v[3];
                        if (XB) { u32x2 w; w[0] = pk2(v[0], v[1]); w[1] = pk2(v[2], v[3]); *(u32x2*)(XB + (size_t)row * 1024 + col) = w; } }
                ss += __shfl_xor(ss, 16); ss += __shfl_xor(ss, 32);
                if (fq == 0) atomicAdd(ssq + row, ss); }
    }
};
struct EpiUp {
    static constexpr bool PERM = true, AFTER_DRAIN = false;
    const float* ssq; bf16_t* H;
    __device__ __forceinline__ void operator()(const f32x4 (&acc)[2][2][4][2], const pg8::Unit& u, int wr, int wc, int fr, int fq) const {
        const int row0 = u.pm * 256 + wr * 64 + fr, col0 = u.pn * 256 + wc * 32 + 8 * fq;
#pragma unroll
        for (int ai = 0; ai < 2; ++ai)
#pragma unroll
            for (int m = 0; m < 4; ++m) { const int row = row0 + ai * 128 + m * 16; const float rs = rsqrtf(ssq[row] * (1.f / 1024.f) + 1e-6f);
#pragma unroll
                for (int bj = 0; bj < 2; ++bj) { f32x4 v0 = acc[ai][bj][m][0], v1 = acc[ai][bj][m][1];
#pragma unroll
                    for (int q = 0; q < 4; ++q) { float a = fmaxf(v0[q] * rs, 0.f); v0[q] = a * a; float b = fmaxf(v1[q] * rs, 0.f); v1[q] = b * b; }
                    u32x4 o; o[0] = pk2(v0[0], v0[1]); o[1] = pk2(v0[2], v0[3]); o[2] = pk2(v1[0], v1[1]); o[3] = pk2(v1[2], v1[3]);
                    *(u32x4*)(H + (size_t)row * DFF + col0 + bj * 128) = o; } }
    }
};

template <int L> __device__ __forceinline__ void lora_part(const Params& p, LAS unsigned char* lds, int m0, int wid, int fr, int fq) {
    constexpr int KB = L == 0 ? 0 : (L == 1 ? 64 : 128), NKS = L == 2 ? 4 : 2, LDW = L == 2 ? 128 : 64;
    unsigned char* ws = p.ws;
    const bf16_t* Wt = (const bf16_t*)(ws + (L == 0 ? WS_WTW2 : (L == 1 ? WS_WTA2 : WS_WTG2)));
    bf16_t* dst = (bf16_t*)(ws + (L == 0 ? WS_E : (L == 1 ? WS_AV : WS_GG)));
    const float* bias = L == 0 ? p.in[I_W0] : p.in[I_A0];
    for (int nt = 0; nt < 8; ++nt) { const int n0 = wid * 128 + nt * 16;
        bf16x8 xf[NKS];
#pragma unroll
        for (int ks = 0; ks < NKS; ++ks) xf[ks] = *(const bf16x8*)(Wt + (size_t)(n0 + fr) * LDW + ks * 32 + fq * 8);
        const int c = n0 + 4 * fq; f32x4 bv = {0.f, 0.f, 0.f, 0.f}; if (L < 2) bv = *(const f32x4*)(bias + c);
#pragma unroll
        for (int mt = 0; mt < 2; ++mt) { f32x4 acc = {0.f, 0.f, 0.f, 0.f};
#pragma unroll
            for (int ks = 0; ks < NKS; ++ks) { const bf16x8 yf = *(const LAS bf16x8*)(lds + ((mt * 16 + fr) * 264 + KB + ks * 32 + fq * 8) * 2); acc = mfma16(xf[ks], yf, acc); }
            const int m = m0 + mt * 16 + fr; float o[4];
#pragma unroll
            for (int q = 0; q < 4; ++q) { const float z = acc[q] + bv[q]; o[q] = L == 0 ? 0.60653066f * sigmoidf_(z) : (L == 1 ? sigmoidf_(z) : z); }
            u32x2 w; w[0] = pk2(o[0], o[1]); w[1] = pk2(o[2], o[3]); *(u32x2*)(dst + (size_t)m * 1024 + c) = w; } }
}
__device__ __forceinline__ void p2_item(const Params& p, LAS unsigned char* lds, int item) {
    const int tid = threadIdx.x, wid = tid >> 6, lane = tid & 63, fr = lane & 15, fq = lane >> 4; unsigned char* ws = p.ws;
    const int m0 = item * 32;
    { bf16_t* GVp = (bf16_t*)(ws + WS_GV); const float* lng = p.in[I_LNG]; const float* lnb = p.in[I_LNB];
      for (int i = 0; i < 4; ++i) { const int m = m0 + wid * 4 + i; bf16_t* row = GVp + (size_t)m * 1024; float x[16];
#pragma unroll
          for (int c = 0; c < 2; ++c) { const u32x4 q = *(const u32x4*)(row + c * 512 + lane * 8);
#pragma unroll
              for (int k = 0; k < 4; ++k) { x[c * 8 + 2 * k] = bflo(q[k]); x[c * 8 + 2 * k + 1] = bfhi(q[k]); } }
          float s = 0.f;
#pragma unroll
          for (int k = 0; k < 16; ++k) s += x[k];
          s = wave_sum(s); const float mean = s * (1.f / 1024.f); float vs = 0.f;
#pragma unroll
          for (int k = 0; k < 16; ++k) { x[k] -= mean; vs += x[k] * x[k]; }
          vs = wave_sum(vs); const float rstd = rsqrtf(vs * (1.f / 1024.f) + 1e-5f);
#pragma unroll
          for (int c = 0; c < 2; ++c) { const int col = c * 512 + lane * 8; float y[8];
              const f32x4 g0 = *(const f32x4*)(lng + col), g1 = *(const f32x4*)(lng + col + 4), b0 = *(const f32x4*)(lnb + col), b1 = *(const f32x4*)(lnb + col + 4);
#pragma unroll
              for (int k = 0; k < 4; ++k) { y[k] = x[c * 8 + k] * rstd * g0[k] + b0[k]; y[4 + k] = x[c * 8 + 4 + k] * rstd * g1[k] + b1[k]; }
              u32x4 o; o[0] = pk2(y[0], y[1]); o[1] = pk2(y[2], y[3]); o[2] = pk2(y[4], y[5]); o[3] = pk2(y[6], y[7]); *(u32x4*)(row + col) = o;
              if (m >= MP) { float* d = p.out + O_SGV + (size_t)(m - MP) * 1024 + col; *(f32x4*)d = (f32x4){y[0], y[1], y[2], y[3]}; *(f32x4*)(d + 4) = (f32x4){y[4], y[5], y[6], y[7]}; } } } }
    { const int tt = tid >> 4, sub = tid & 15, m = m0 + tt; const bf16_t* cur = (const bf16_t*)(ws + WS_SZ) + (size_t)m * PSH + 3072 + sub * 16;
      const u32x4 c0 = *(const u32x4*)cur, c1 = *(const u32x4*)(cur + 8); float cv[16], pv[16];
#pragma unroll
      for (int k = 0; k < 4; ++k) { cv[2 * k] = bflo(c0[k]); cv[2 * k + 1] = bfhi(c0[k]); cv[8 + 2 * k] = bflo(c1[k]); cv[8 + 2 * k + 1] = bfhi(c1[k]); }
      const bool first = m < MP ? ((m & 2047) == 0) : (((m - MP) & 3) == 0);
      if (!first) { const u32x4 q0 = *(const u32x4*)(cur - PSH), q1 = *(const u32x4*)(cur - PSH + 8);
#pragma unroll
          for (int k = 0; k < 4; ++k) { pv[2 * k] = bflo(q0[k]); pv[2 * k + 1] = bfhi(q0[k]); pv[8 + 2 * k] = bflo(q1[k]); pv[8 + 2 * k + 1] = bfhi(q1[k]); } }
      else if (m >= MP) { const float* st = p.in[I_SSH] + (size_t)((m - MP) >> 2) * PSH + 3072 + sub * 16;
#pragma unroll
          for (int k = 0; k < 4; ++k) { const f32x4 q = *(const f32x4*)(st + 4 * k); pv[4 * k] = q[0]; pv[4 * k + 1] = q[1]; pv[4 * k + 2] = q[2]; pv[4 * k + 3] = q[3]; } }
      else {
#pragma unroll
          for (int k = 0; k < 16; ++k) pv[k] = 0.f; }
      const float* mu = p.in[I_MU] + 3072 + sub * 16; float o[16];
#pragma unroll
      for (int k = 0; k < 4; ++k) { const f32x4 q = *(const f32x4*)(mu + 4 * k);
#pragma unroll
          for (int e = 0; e < 4; ++e) { const float c = cv[4 * k + e]; o[4 * k + e] = c + (pv[4 * k + e] - c) * q[e]; } }
      if (sub < 4) {
#pragma unroll
          for (int k = 0; k < 16; ++k) o[k] = tanhf_(o[k]); }
      else if (sub >= 8) {
#pragma unroll
          for (int k = 0; k < 16; ++k) o[k] = sigmoidf_(o[k]); }
      u32x4 w0, w1;
#pragma unroll
      for (int k = 0; k < 4; ++k) { w0[k] = pk2(o[2 * k], o[2 * k + 1]); w1[k] = pk2(o[8 + 2 * k], o[8 + 2 * k + 1]); }
      LAS u32x4* d = (LAS u32x4*)(lds + (tt * 264 + sub * 16) * 2); d[0] = w0; d[1] = w1; }
    __syncthreads();
    lora_part<0>(p, lds, m0, wid, fr, fq); lora_part<1>(p, lds, m0, wid, fr, fq); lora_part<2>(p, lds, m0, wid, fr, fq);
    __syncthreads();
}

struct ScanPre { u32x2 cr, ck, cv, pr, pk, pv, e, a, g; };
__device__ __forceinline__ u32x2 pack4f(const float* s) { const f32x4 q = *(const f32x4*)s; u32x2 o; o[0] = pk2(q[0], q[1]); o[1] = pk2(q[2], q[3]); return o; }
__device__ __forceinline__ void scan_head(const Params& p, LAS unsigned char* lds, int row0, int T, int h, const float* s0, float* sfin, const float* shift0) {
    const int tid = threadIdx.x, wid = tid >> 6, lane = tid & 63; unsigned char* ws = p.ws;
    const bf16_t* SZp = (const bf16_t*)(ws + WS_SZ); const bf16_t* Ep = (const bf16_t*)(ws + WS_E); const bf16_t* Ap = (const bf16_t*)(ws + WS_AV); const bf16_t* Gp = (const bf16_t*)(ws + WS_GG);
    bf16_t* YB = (bf16_t*)(ws + WS_Y3) + (size_t)MT * 1024;
    LAS float* bufs = (LAS float*)lds;
    LAS float* Yl = (LAS float*)(lds + 98304);
    LAS float* BON = (LAS float*)(lds + 98304 + 8192);
    const int tt = tid >> 4, j4 = (tid & 15) * 4, ch = h * 64 + j4;
    const int si = wid * 8 + (lane >> 3), jb = (lane & 7) * 8;
    f32x2 S[4];
    if (s0) {
#pragma unroll
        for (int q = 0; q < 4; ++q) S[q] = *(const f32x2*)(s0 + si * 64 + jb + 2 * q); }
    else {
#pragma unroll
        for (int q = 0; q < 4; ++q) S[q] = (f32x2){0.f, 0.f}; }
    float mur[4], muk[4], muv[4], kkc[4], kac[4], rkc[4];
    { const f32x4 a = *(const f32x4*)(p.in[I_MU] + ch), b = *(const f32x4*)(p.in[I_MU] + 1024 + ch), c = *(const f32x4*)(p.in[I_MU] + 2048 + ch),
                  d = *(const f32x4*)(p.in[I_KK] + ch), e = *(const f32x4*)(p.in[I_KA] + ch), f = *(const f32x4*)(p.in[I_RK] + ch);
#pragma unroll
      for (int q = 0; q < 4; ++q) { mur[q] = a[q]; muk[q] = b[q]; muv[q] = c[q]; kkc[q] = d[q]; kac[q] = e[q]; rkc[q] = f[q]; } }
    auto load_pre = [&](int t0, ScanPre& P) {
        const int t = t0 + tt;
        if (t < T) { const size_t m = (size_t)(row0 + t); const bf16_t* c = SZp + m * PSH + ch;
            P.cr = *(const u32x2*)c; P.ck = *(const u32x2*)(c + 1024); P.cv = *(const u32x2*)(c + 2048);
            if (t > 0) { P.pr = *(const u32x2*)(c - PSH); P.pk = *(const u32x2*)(c - PSH + 1024); P.pv = *(const u32x2*)(c - PSH + 2048); }
            else if (shift0) { P.pr = pack4f(shift0 + ch); P.pk = pack4f(shift0 + 1024 + ch); P.pv = pack4f(shift0 + 2048 + ch); }
            else { P.pr = (u32x2){0u, 0u}; P.pk = P.pr; P.pv = P.pr; }
            P.e = *(const u32x2*)(Ep + m * 1024 + ch); P.a = *(const u32x2*)(Ap + m * 1024 + ch); P.g = *(const u32x2*)(Gp + m * 1024 + ch); }
        else { P.cr = (u32x2){0u, 0u}; P.ck = P.cr; P.cv = P.cr; P.pr = P.cr; P.pk = P.cr; P.pv = P.cr; P.e = P.cr; P.a = P.cr; P.g = P.cr; }
    };
    auto store_pre = [&](const ScanPre& P, int nb) {
        float cr[4], ck[4], cv[4], pr[4], pk[4], pv[4], e[4], a[4];
        unpack4(P.cr, cr); unpack4(P.ck, ck); unpack4(P.cv, cv); unpack4(P.pr, pr); unpack4(P.pk, pk); unpack4(P.pv, pv); unpack4(P.e, e); unpack4(P.a, a);
        f32x4 r, w, k, na, bb, v; float ssq = 0.f, bon = 0.f; float kkr[4];
#pragma unroll
        for (int q = 0; q < 4; ++q) { r[q] = cr[q] + (pr[q] - cr[q]) * mur[q]; const float kz = ck[q] + (pk[q] - ck[q]) * muk[q]; v[q] = cv[q] + (pv[q] - cv[q]) * muv[q];
            k[q] = kz * (1.f + (a[q] - 1.f) * kac[q]); kkr[q] = kz * kkc[q]; ssq += kkr[q] * kkr[q]; bon += r[q] * k[q] * rkc[q]; w[q] = __expf(-e[q]); }
        ssq = red16(ssq); bon = red16(bon); const float rn = rsqrtf(ssq + 1e-12f);
#pragma unroll
        for (int q = 0; q < 4; ++q) { const float kk = kkr[q] * rn; na[q] = -kk; bb[q] = kk * a[q]; }
        LAS float* b = bufs + nb * 12288 + tt * 64 + j4;
        *(LAS f32x4*)(b) = r; *(LAS f32x4*)(b + 2048) = w; *(LAS f32x4*)(b + 4096) = k; *(LAS f32x4*)(b + 6144) = na; *(LAS f32x4*)(b + 8192) = bb; *(LAS f32x4*)(b + 10240) = v;
        if ((tid & 15) == 0) BON[nb * 32 + tt] = bon;
    };
    ScanPre P; load_pre(0, P); store_pre(P, 0); u32x2 gcur = P.g;
    __syncthreads();
    const int nch = (T + 31) >> 5;
    for (int c = 0; c < nch; ++c) {
        const int cb = c & 1, t0 = c * 32, nv = (T - t0) < 32 ? (T - t0) : 32;
        const bool more = (c + 1) < nch;
        if (more) load_pre(t0 + 32, P);
        { const LAS float* b = bufs + cb * 12288 + jb; const LAS float* vb = bufs + cb * 12288 + 10240 + si;
#pragma unroll 2
          for (int t = 0; t < nv; ++t) { const LAS float* bt = b + t * 64;
              const f32x4 r0 = *(const LAS f32x4*)(bt), r1 = *(const LAS f32x4*)(bt + 4), w0 = *(const LAS f32x4*)(bt + 2048), w1 = *(const LAS f32x4*)(bt + 2052),
                          k0 = *(const LAS f32x4*)(bt + 4096), k1 = *(const LAS f32x4*)(bt + 4100), a0 = *(const LAS f32x4*)(bt + 6144), a1 = *(const LAS f32x4*)(bt + 6148),
                          b0 = *(const LAS f32x4*)(bt + 8192), b1 = *(const LAS f32x4*)(bt + 8196);
              const float v = vb[t * 64];
              f32x2 d = S[0] * (f32x2){a0[0], a0[1]} + S[1] * (f32x2){a0[2], a0[3]}; f32x2 d2 = S[2] * (f32x2){a1[0], a1[1]} + S[3] * (f32x2){a1[2], a1[3]}; d = d + d2;
              float sa = red8(d[0] + d[1]);
              const f32x2 sa2 = {sa, sa}, v2 = {v, v};
              S[0] = S[0] * (f32x2){w0[0], w0[1]} + (sa2 * (f32x2){b0[0], b0[1]} + v2 * (f32x2){k0[0], k0[1]});
              S[1] = S[1] * (f32x2){w0[2], w0[3]} + (sa2 * (f32x2){b0[2], b0[3]} + v2 * (f32x2){k0[2], k0[3]});
              S[2] = S[2] * (f32x2){w1[0], w1[1]} + (sa2 * (f32x2){b1[0], b1[1]} + v2 * (f32x2){k1[0], k1[1]});
              S[3] = S[3] * (f32x2){w1[2], w1[3]} + (sa2 * (f32x2){b1[2], b1[3]} + v2 * (f32x2){k1[2], k1[3]});
              f32x2 y = S[0] * (f32x2){r0[0], r0[1]} + S[1] * (f32x2){r0[2], r0[3]}; f32x2 y2 = S[2] * (f32x2){r1[0], r1[1]} + S[3] * (f32x2){r1[2], r1[3]}; y = y + y2;
              const float yy = red8(y[0] + y[1]);
              if ((lane & 7) == 0) Yl[t * 64 + si] = yy; } }
        if (more) store_pre(P, cb ^ 1);
        __syncthreads();
        if (tt < nv) { const int i4 = j4; const size_t m = (size_t)(row0 + t0 + tt);
            const f32x4 y = *(const LAS f32x4*)(Yl + tt * 64 + i4); const f32x4 v = *(const LAS f32x4*)(bufs + cb * 12288 + 10240 + tt * 64 + i4); const float bon = BON[cb * 32 + tt];
            float s = y[0] + y[1] + y[2] + y[3]; s = red16(s); const float mean = s * (1.f / 64.f);
            float d[4], vs = 0.f;
#pragma unroll
            for (int q = 0; q < 4; ++q) { d[q] = y[q] - mean; vs += d[q] * d[q]; }
            vs = red16(vs); const float rstd = rsqrtf(vs * (1.f / 64.f) + 64e-5f);
            const f32x4 lg = *(const f32x4*)(p.in[I_LXG] + h * 64 + i4), lb = *(const f32x4*)(p.in[I_LXB] + h * 64 + i4); float g[4]; unpack4(gcur, g); float o[4];
#pragma unroll
            for (int q = 0; q < 4; ++q) o[q] = (d[q] * rstd * lg[q] + lb[q] + bon * v[q]) * g[q];
            u32x2 w; w[0] = pk2(o[0], o[1]); w[1] = pk2(o[2], o[3]); *(u32x2*)(YB + m * 1024 + h * 64 + i4) = w; }
        gcur = P.g;
        __syncthreads();
    }
#pragma unroll
    for (int q = 0; q < 4; ++q) *(f32x2*)(sfin + si * 64 + jb + 2 * q) = S[q];
}

__device__ __forceinline__ void attn_prompt_item(const Params& p, int item) {
    const int tid = threadIdx.x, wid = tid >> 6, lane = tid & 63, fr = lane & 15, fq = lane >> 4; unsigned char* ws = p.ws;
    const int b = item >> 6, head = (item >> 4) & 3, qt = item & 15;
    bf16_t* Qp = (bf16_t*)(ws + WS_Y3) + (size_t)2 * MT * 1024; const bf16_t* MKB = (const bf16_t*)(ws + WS_MKB); const bf16_t* MVT = (const bf16_t*)(ws + WS_MVT);
    const int qrow = b * 2048 + qt * 128 + wid * 16;
    bf16x8 qf[8];
#pragma unroll
    for (int ks = 0; ks < 8; ++ks) qf[ks] = *(const bf16x8*)(Qp + (size_t)(qrow + fr) * 1024 + head * 256 + ks * 32 + fq * 8);
    f32x4 s[16];
#pragma unroll
    for (int nt = 0; nt < 16; ++nt) { f32x4 acc = {0.f, 0.f, 0.f, 0.f}; const bf16_t* kp = MKB + (size_t)(b * 256 + nt * 16 + fr) * 1024 + head * 256 + fq * 8;
#pragma unroll
        for (int ks = 0; ks < 8; ++ks) { const bf16x8 kf = *(const bf16x8*)(kp + ks * 32); acc = mfma16(kf, qf[ks], acc); }
        s[nt] = acc; }
    float mx = -3.0e38f;
#pragma unroll
    for (int nt = 0; nt < 16; ++nt) mx = fmaxf(fmaxf(fmaxf(s[nt][0], s[nt][1]), fmaxf(s[nt][2], s[nt][3])), mx);
    mx = fmaxf(mx, __shfl_xor(mx, 16)); mx = fmaxf(mx, __shfl_xor(mx, 32));
    float sum = 0.f;
#pragma unroll
    for (int nt = 0; nt < 16; ++nt)
#pragma unroll
        for (int q = 0; q < 4; ++q) { const float e = __expf((s[nt][q] - mx) * 0.0625f); s[nt][q] = e; sum += e; }
    sum += __shfl_xor(sum, 16); sum += __shfl_xor(sum, 32); const float inv = rcpf(sum);
    u32x4 pf[8];
#pragma unroll
    for (int ks = 0; ks < 8; ++ks) { pf[ks][0] = pk2(s[2 * ks][0] * inv, s[2 * ks][1] * inv); pf[ks][1] = pk2(s[2 * ks][2] * inv, s[2 * ks][3] * inv);
        pf[ks][2] = pk2(s[2 * ks + 1][0] * inv, s[2 * ks + 1][1] * inv); pf[ks][3] = pk2(s[2 * ks + 1][2] * inv, s[2 * ks + 1][3] * inv); }
#pragma unroll 4
    for (int dt = 0; dt < 16; ++dt) { f32x4 acc = {0.f, 0.f, 0.f, 0.f}; const bf16_t* vp = MVT + ((size_t)((b * 4 + head) * 256 + dt * 16 + fr)) * 256 + 4 * fq;
#pragma unroll
        for (int ks = 0; ks < 8; ++ks) { const u32x2 lo = *(const u32x2*)(vp + ks * 32), hi = *(const u32x2*)(vp + ks * 32 + 16); u32x4 vv; vv[0] = lo[0]; vv[1] = lo[1]; vv[2] = hi[0]; vv[3] = hi[1];
            acc = mfma16(__builtin_bit_cast(bf16x8, vv), __builtin_bit_cast(bf16x8, pf[ks]), acc); }
        u32x2 w; w[0] = pk2(acc[0], acc[1]); w[1] = pk2(acc[2], acc[3]);
        *(u32x2*)(Qp + (size_t)(qrow + fr) * 1024 + head * 256 + dt * 16 + 4 * fq) = w; }
}

__device__ __forceinline__ void attn_sample_item(const Params& p, LAS unsigned char* lds, int item) {
    const int tid = threadIdx.x, wid = tid >> 6, lane = tid & 63, l16 = lane & 15, rg = lane >> 4; unsigned char* ws = p.ws;
    const int b = item >> 2, head = item & 3;
    bf16_t* Qp = (bf16_t*)(ws + WS_Y3) + (size_t)2 * MT * 1024 + (size_t)(MP + 4 * b) * 1024 + head * 256;
    const float* Kp = p.in[I_CK] + ((size_t)b * 256 * 4 + head) * 256; const float* Vp = p.in[I_CV] + ((size_t)b * 256 * 4 + head) * 256;
    LAS float* sc = (LAS float*)lds; LAS float* pr = (LAS float*)(lds + 4096); LAS float* part = (LAS float*)(lds + 8192);
    float qv[4][4][4];
#pragma unroll
    for (int t = 0; t < 4; ++t)
#pragma unroll
        for (int c = 0; c < 4; ++c) { const u32x2 q = *(const u32x2*)(Qp + t * 1024 + 64 * c + 4 * l16); unpack4(q, qv[t][c]); }
#pragma unroll 2
    for (int it = 0; it < 8; ++it) { const int mrow = wid * 32 + it * 4 + rg; const float* kr = Kp + (size_t)mrow * 1024 + 4 * l16; float d[4] = {0.f, 0.f, 0.f, 0.f};
#pragma unroll
        for (int c = 0; c < 4; ++c) { const f32x4 kv = *(const f32x4*)(kr + 64 * c);
#pragma unroll
            for (int t = 0; t < 4; ++t) d[t] += kv[0] * qv[t][c][0] + kv[1] * qv[t][c][1] + kv[2] * qv[t][c][2] + kv[3] * qv[t][c][3]; }
#pragma unroll
        for (int t = 0; t < 4; ++t) { const float r = red16(d[t]); if (l16 == 0) sc[t * 256 + mrow] = r * 0.0625f; } }
    __syncthreads();
    if (wid < 4) { const f32x4 x = *(const LAS f32x4*)(sc + wid * 256 + lane * 4); float mx = fmaxf(fmaxf(x[0], x[1]), fmaxf(x[2], x[3])); mx = wave_max(mx);
        float e[4], sum = 0.f;
#pragma unroll
        for (int q = 0; q < 4; ++q) { e[q] = __expf(x[q] - mx); sum += e[q]; }
        sum = wave_sum(sum); const float inv = rcpf(sum);
#pragma unroll
        for (int q = 0; q < 4; ++q) pr[(lane * 4 + q) * 4 + wid] = e[q] * inv; }
    __syncthreads();
    { f32x4 acc[4];
#pragma unroll
      for (int t = 0; t < 4; ++t) acc[t] = (f32x4){0.f, 0.f, 0.f, 0.f};
#pragma unroll 8
      for (int it = 0; it < 32; ++it) { const int mrow = wid * 32 + it; const f32x4 vv = *(const f32x4*)(Vp + (size_t)mrow * 1024 + lane * 4); const f32x4 pp = *(const LAS f32x4*)(pr + mrow * 4);
#pragma unroll
          for (int t = 0; t < 4; ++t) acc[t] += pp[t] * vv; }
#pragma unroll
      for (int t = 0; t < 4; ++t) *(LAS f32x4*)(part + (wid * 4 + t) * 256 + lane * 4) = acc[t]; }
    __syncthreads();
    { const int o = tid * 2, t = o >> 8, d = o & 255; float a0 = 0.f, a1 = 0.f;
#pragma unroll
      for (int w = 0; w < 8; ++w) { const f32x2 v = *(const LAS f32x2*)(part + (w * 4 + t) * 256 + d); a0 += v[0]; a1 += v[1]; }
      *(unsigned*)(Qp + t * 1024 + d) = pk2(a0, a1); }
    __syncthreads();
}

__device__ __forceinline__ void sg_prompt_item(const Params& p, LAS unsigned char* lds, int item) {
    const int tid = threadIdx.x, wid = tid >> 6, lane = tid & 63, fr = lane & 15, fq = lane >> 4; unsigned char* ws = p.ws;
    const int chn = item >> 3, g = item & 7, m0 = chn * 128;
    const bf16_t* VN = (const bf16_t*)(ws + WS_GV); const bf16_t* SGW = (const bf16_t*)(ws + WS_SGW) + g * 16384; bf16_t* U = (bf16_t*)(ws + WS_Y3);
    LAS bf16_t* VT = (LAS bf16_t*)lds;
    { const int s = tid >> 2, hq = (tid & 3) * 32; const bf16_t* src = VN + (size_t)(m0 + s) * 1024 + g * 128 + hq;
#pragma unroll
      for (int c = 0; c < 4; ++c) { const u32x4 q = *(const u32x4*)(src + c * 8);
#pragma unroll
          for (int k = 0; k < 4; ++k) { VT[(hq + c * 8 + 2 * k) * 136 + s] = (bf16_t)(q[k] & 0xffffu); VT[(hq + c * 8 + 2 * k + 1) * 136 + s] = (bf16_t)(q[k] >> 16); } } }
    __syncthreads();
    const int h0 = wid * 16; bf16x8 xf[4];
#pragma unroll
    for (int ks = 0; ks < 4; ++ks) xf[ks] = *(const LAS bf16x8*)(VT + (h0 + fr) * 136 + ks * 32 + fq * 8);
    const float* sgb = p.in[I_SGB] + g * 128;
#pragma unroll
    for (int mt = 0; mt < 8; ++mt) { f32x4 acc = {0.f, 0.f, 0.f, 0.f};
#pragma unroll
        for (int ks = 0; ks < 4; ++ks) if (32 * ks <= 16 * mt + 15) { const bf16x8 yf = *(const bf16x8*)(SGW + (mt * 16 + fr) * 128 + ks * 32 + fq * 8); acc = mfma16(xf[ks], yf, acc); }
        const int t = mt * 16 + fr; const float bias = sgb[t]; bf16_t* up = U + (size_t)(m0 + t) * 1024 + g * 128 + h0 + 4 * fq;
        const u32x2 uq = *(const u32x2*)up; float uf[4]; unpack4(uq, uf);
        u32x2 w; w[0] = pk2(uf[0] * (acc[0] + bias), uf[1] * (acc[1] + bias)); w[1] = pk2(uf[2] * (acc[2] + bias), uf[3] * (acc[3] + bias)); *(u32x2*)up = w; }
    __syncthreads();
}
__device__ __forceinline__ void sg_sample_item(const Params& p, int item) {
    const int tid = threadIdx.x; unsigned char* ws = p.ws; const bf16_t* VN = (const bf16_t*)(ws + WS_GV); bf16_t* U = (bf16_t*)(ws + WS_Y3);
    const float* sgw = p.in[I_SGW]; const float* sgb = p.in[I_SGB];
    for (int e = tid; e < 32 * 128; e += 512) { const int r = e >> 7, c8 = (e & 127) * 8; const int m = MP + item * 32 + r, t = r & 3, g = c8 >> 7; float a[8];
#pragma unroll
        for (int k = 0; k < 8; ++k) a[k] = sgb[g * 128 + t];
        for (int s = 0; s <= t; ++s) { const float w = sgw[(g * 128 + t) * 128 + s]; const u32x4 q = *(const u32x4*)(VN + (size_t)(m - t + s) * 1024 + c8);
#pragma unroll
            for (int k = 0; k < 4; ++k) { a[2 * k] += w * bflo(q[k]); a[2 * k + 1] += w * bfhi(q[k]); } }
        bf16_t* up = U + (size_t)m * 1024 + c8; const u32x4 uq = *(const u32x4*)up; u32x4 o;
#pragma unroll
        for (int k = 0; k < 4; ++k) o[k] = pk2(bflo(uq[k]) * a[2 * k], bfhi(uq[k]) * a[2 * k + 1]);
        *(u32x4*)up = o; }
}

constexpr int Q_SATT = 0, Q_PATT = 512, Q_SGP = 1024, Q_SGS = 2048, Q_SSCAN = 2064, Q_END = 2064 + 2048;

template <int PH> __device__ __forceinline__ void run_phase(const Params& p, LAS unsigned char* lds) {
    unsigned char* ws = p.ws; const int G = gridDim.x, bid = blockIdx.x;
    if constexpr (PH == 0) phase0(p, lds);
    else if constexpr (PH == 1) {
        { pg8::Gemm g{(const bf16_t*)(ws + WS_HMB), (const bf16_t*)(ws + WS_WTMKV), 2048, 2048, 1024}; pg8::StaticOrder S; S.init(2048, 2048, G, (bid + 64) % G);
          EpiMem E{p.out, (bf16_t*)(ws + WS_MKB), (bf16_t*)(ws + WS_MVT)}; pg8::gemm_phase<EpiMem, pg8::StaticOrder, false>(lds, g, S, E, nullptr); }
        __syncthreads();
        { pg8::Gemm g{(const bf16_t*)(ws + WS_HB), (const bf16_t*)(ws + WS_WTIN), MT, PIN, 1024}; pg8::StaticOrder S; S.init(MT, PIN, G, bid);
          EpiZ E{(bf16_t*)(ws + WS_Y3), (bf16_t*)(ws + WS_GV), (bf16_t*)(ws + WS_SZ), (bf16_t*)(ws + WS_Y3) + (size_t)2 * MT * 1024, (bf16_t*)(ws + WS_GT), p.out};
          pg8::gemm_phase<EpiZ, pg8::StaticOrder, false>(lds, g, S, E, nullptr); }
    }
    else if constexpr (PH == 2) { for (int it = bid; it < MT / 32; it += G) p2_item(p, lds, it); }
    else if constexpr (PH == 3) {
        if (bid < 128) { const int b = bid >> 4, h = bid & 15; scan_head(p, lds, b * 2048, 2048, h, nullptr, p.out + O_PWKV + (size_t)bid * 4096, nullptr); }
        unsigned* ctr = (unsigned*)(ws + WS_CTL); LAS unsigned* qw = (LAS unsigned*)(lds + QW_OFF);
        for (;;) {
            __syncthreads();
            if (threadIdx.x == 0) *qw = atomicAdd(ctr, 1u);
            __syncthreads();
            const int it = (int)*qw; if (it >= Q_END) break;
            if (it < Q_PATT) attn_sample_item(p, lds, it);
            else if (it < Q_SGP) attn_prompt_item(p, it - Q_PATT);
            else if (it < Q_SGS) sg_prompt_item(p, lds, it - Q_SGP);
            else if (it < Q_SSCAN) sg_sample_item(p, it - Q_SGS);
            else { const int bh = it - Q_SSCAN, b = bh >> 4, h = bh & 15;
                scan_head(p, lds, MP + b * 4, 4, h, p.in[I_SWKV] + (size_t)bh * 4096, p.out + O_SWKV + (size_t)bh * 4096, p.in[I_SSH] + (size_t)b * PSH); }
        }
    }
    else if constexpr (PH == 4) { pg8::Gemm g{(const bf16_t*)(ws + WS_Y3), (const bf16_t*)(ws + WS_WTBR), 3 * MT, 3072, 1024}; BranchOrder S{G, bid};
        EpiMerge E{(const bf16_t*)(ws + WS_GT), (float*)(ws + WS_MF), (bf16_t*)(ws + WS_MB)}; pg8::gemm_phase<EpiMerge, BranchOrder, false>(lds, g, S, E, nullptr); }
    else if constexpr (PH == 5) { pg8::Gemm g{(const bf16_t*)(ws + WS_MB), (const bf16_t*)(ws + WS_WTOUT), MT, 1024, 1024}; pg8::StaticOrder S; S.init(MT, 1024, G, bid);
        EpiRes E{p.in[I_XP], p.in[I_XS], (float*)(ws + WS_X1), (bf16_t*)(ws + WS_X1B), (float*)(ws + WS_SSQ1)}; pg8::gemm_phase<EpiRes, pg8::StaticOrder, false>(lds, g, S, E, nullptr); }
    else if constexpr (PH == 6) { pg8::Gemm g{(const bf16_t*)(ws + WS_X1B), (const bf16_t*)(ws + WS_WTUP), MT, DFF, 1024}; pg8::StaticOrder S; S.init(MT, DFF, G, bid);
        EpiUp E{(const float*)(ws + WS_SSQ1), (bf16_t*)(ws + WS_HID)}; pg8::gemm_phase<EpiUp, pg8::StaticOrder, false>(lds, g, S, E, nullptr); }
    else if constexpr (PH == 7) { pg8::Gemm g{(const bf16_t*)(ws + WS_HID), (const bf16_t*)(ws + WS_WTDN), MT, 1024, DFF}; pg8::StaticOrder S; S.init(MT, 1024, G, bid);
        const float* x1 = (const float*)(ws + WS_X1);
        EpiRes E{x1, x1 + (size_t)MP * 1024, (float*)(ws + WS_X2), nullptr, (float*)(ws + WS_SSQ2)}; pg8::gemm_phase<EpiRes, pg8::StaticOrder, false>(lds, g, S, E, nullptr); }
    else if constexpr (PH == 8) { const float* x2 = (const float*)(ws + WS_X2); const float* ssq = (const float*)(ws + WS_SSQ2); const float* gf = p.in[I_NFG];
        const int wid = threadIdx.x >> 6, lane = threadIdx.x & 63;
        for (int r = bid * 8 + wid; r < MT; r += G * 8) { const float rs = rsqrtf(ssq[r] * (1.f / 1024.f) + 1e-6f);
#pragma unroll
            for (int c = 0; c < 4; ++c) { const int col = c * 256 + lane * 4; const f32x4 v = *(const f32x4*)(x2 + (size_t)r * 1024 + col), g = *(const f32x4*)(gf + col);
                *(f32x4*)(p.out + (size_t)r * 1024 + col) = v * rs * g; } } }
}
#ifdef DIAG_PHASES
template <int PH> __global__ __launch_bounds__(512, 2) void diag_phase(Params p) {
    extern __shared__ __attribute__((aligned(16))) unsigned char shm[];
    run_phase<PH>(p, (LAS unsigned char*)shm);
}
template __global__ void diag_phase<0>(Params); template __global__ void diag_phase<1>(Params); template __global__ void diag_phase<2>(Params);
template __global__ void diag_phase<3>(Params); template __global__ void diag_phase<4>(Params); template __global__ void diag_phase<5>(Params);
template __global__ void diag_phase<6>(Params); template __global__ void diag_phase<7>(Params); template __global__ void diag_phase<8>(Params);
#endif
template <int PH> __device__ __forceinline__ void phase_step(int ph_lo, int ph_hi, LAS unsigned char* lds, cg::grid_group& grid) {
    if (ph_lo <= PH && PH < ph_hi) {
        if (PH > ph_lo) {
            asm volatile("s_waitcnt vmcnt(0)" ::: "memory");
            __syncthreads();
            if (threadIdx.x < 64) { __builtin_amdgcn_fence(__ATOMIC_RELEASE, "agent"); asm volatile("s_waitcnt vmcnt(0)" ::: "memory"); }
            __syncthreads();
            grid.sync();
            __builtin_amdgcn_fence(__ATOMIC_ACQUIRE, "agent");
            asm volatile("s_waitcnt vmcnt(0)" ::: "memory");
            __syncthreads();
        }
        const __attribute__((address_space(4))) Params* pp = (const __attribute__((address_space(4))) Params*)__builtin_amdgcn_kernarg_segment_ptr();
        asm volatile("" : "+s"(pp) :: "memory");
        Params p;
#pragma unroll
        for (int i = 0; i < 33; ++i) p.in[i] = (const float*)(__attribute__((address_space(1))) const float*)pp->in[i];
        p.out = (float*)(__attribute__((address_space(1))) float*)pp->out; p.ws = (unsigned char*)(__attribute__((address_space(1))) unsigned char*)pp->ws;
        run_phase<PH>(p, lds);
    }
}
template <> __device__ __forceinline__ void run_phase<9>(const Params& p, LAS unsigned char* lds) {
    unsigned char* ws = p.ws; const int G = gridDim.x, bid = blockIdx.x; const int wid = threadIdx.x >> 6, lane = threadIdx.x & 63;
    for (int r = bid * 8 + wid; r < MT; r += G * 8) {
#pragma unroll
        for (int c = 0; c < 4; ++c) { const int col = c * 256 + lane * 4; f32x4 o;
#if DBG == 1
            const bf16_t* y3 = (const bf16_t*)(ws + WS_Y3); float a[4], b[4], d[4];
            unpack4(*(const u32x2*)(y3 + (size_t)r * 1024 + col), a); unpack4(*(const u32x2*)(y3 + (size_t)(MT + r) * 1024 + col), b); unpack4(*(const u32x2*)(y3 + (size_t)(2 * MT + r) * 1024 + col), d);
            for (int q = 0; q < 4; ++q) o[q] = a[q] + 2.f * b[q] + 4.f * d[q];
#elif DBG == 2
            float a[4]; unpack4(*(const u32x2*)((const bf16_t*)(ws + WS_MB) + (size_t)r * 1024 + col), a); for (int q = 0; q < 4; ++q) o[q] = a[q];
#elif DBG == 3
            o = *(const f32x4*)((const float*)(ws + WS_X1) + (size_t)r * 1024 + col);
#elif DBG == 4
            float a[4], b[4]; unpack4(*(const u32x2*)((const bf16_t*)(ws + WS_HID) + (size_t)r * DFF + col), a); unpack4(*(const u32x2*)((const bf16_t*)(ws + WS_HID) + (size_t)r * DFF + 2048 + col), b); for (int q = 0; q < 4; ++q) o[q] = a[q] + b[q];
#elif DBG == 5
            const bf16_t* y3 = (const bf16_t*)(ws + WS_Y3) + (size_t)(DBGSEL * MT + r) * 1024 + col; float a[4]; unpack4(*(const u32x2*)y3, a); for (int q = 0; q < 4; ++q) o[q] = a[q];
#else
            o = (f32x4){0.f, 0.f, 0.f, 0.f};
#endif
            *(f32x4*)(p.out + (size_t)r * 1024 + col) = o; } }
}
__global__ __launch_bounds__(512, 2) void mega(Params p, int ph_lo, int ph_hi) {
    extern __shared__ __attribute__((aligned(16))) unsigned char shm[];
    LAS unsigned char* lds = (LAS unsigned char*)shm;
    cg::grid_group grid = cg::this_grid();
    phase_step<0>(ph_lo, ph_hi, lds, grid); phase_step<1>(ph_lo, ph_hi, lds, grid); phase_step<2>(ph_lo, ph_hi, lds, grid);
    phase_step<3>(ph_lo, ph_hi, lds, grid); phase_step<4>(ph_lo, ph_hi, lds, grid); phase_step<5>(ph_lo, ph_hi, lds, grid);
    phase_step<6>(ph_lo, ph_hi, lds, grid); phase_step<7>(ph_lo, ph_hi, lds, grid); phase_step<8>(ph_lo, ph_hi, lds, grid);
#if DBG
    phase_step<9>(ph_lo, 10, lds, grid);
#endif
}

extern "C" void kernel_launch(void* const* d_in, const int* in_sizes, int n_in, void* d_out, int out_size, void* d_ws, size_t ws_size, hipStream_t stream) {
    static int grid_blocks = 0;
    if (grid_blocks == 0) {
        if (n_in != 33 || out_size != (int)O_END || ws_size < WS_END) { fprintf(stderr, "kernel_launch: unexpected shapes (n_in %d out %d ws %zu, need ws %zu)\n", n_in, out_size, ws_size, (size_t)WS_END); grid_blocks = -1; return; }
        int dev = 0, cus = 0, per_cu = 0;
        hipGetDevice(&dev); hipDeviceGetAttribute(&cus, hipDeviceAttributeMultiprocessorCount, dev);
        hipFuncSetAttribute((const void*)mega, hipFuncAttributeMaxDynamicSharedMemorySize, LDS_BYTES);
        hipOccupancyMaxActiveBlocksPerMultiprocessor(&per_cu, (const void*)mega, 512, LDS_BYTES);
        if (per_cu < 1) { fprintf(stderr, "kernel_launch: occupancy query says %d blocks per CU\n", per_cu); grid_blocks = -1; return; }
        grid_blocks = cus * 1;
        if (grid_blocks < 128) { fprintf(stderr, "kernel_launch: needs >= 128 CUs\n"); grid_blocks = -1; return; }
    }
    if (grid_blocks < 0) return;
    Params p{};
    for (int i = 0; i < 33; ++i) p.in[i] = (const float*)d_in[i];
    p.out = (float*)d_out; p.ws = (unsigned char*)d_ws;
#if DBG
    int lo = 0, hi = DBG_HI;
#else
    int lo = 0, hi = 9;
#endif
    void* args[] = {&p, &lo, &hi};
    hipError_t e = hipLaunchCooperativeKernel((const void*)mega, dim3(grid_blocks), dim3(512), args, LDS_BYTES, stream);
    if (e != hipSuccess) fprintf(stderr, "cooperative launch failed: %s (grid %d)\n", hipGetErrorString(e), grid_blocks);
}
```

```cpp
#include <hip/hip_runtime.h>
#include <hip/hip_cooperative_groups.h>
#include <cstdio>
namespace cg = cooperative_groups;
namespace pg8 {
#define PG8_LAS __attribute__((address_space(3)))
typedef unsigned short bf16_t;
typedef short bf16x8 __attribute__((ext_vector_type(8)));
typedef float f32x4 __attribute__((ext_vector_type(4)));
typedef unsigned u32x4 __attribute__((ext_vector_type(4)));
constexpr int BM = 256, BK = 64, HALF = 128, HTB = HALF * BK * 2  , STAGE_BYTES = 8 * HTB, NXCD = 8, WGM = 8;

__host__ __device__ __forceinline__ int lds_byte(int r, int c) { const int st = (r >> 4) * 2 + (c >> 5), rr = r & 15, cc = c & 31, ob = rr * 64 + cc * 2; return st * 1024 + (ob ^ (((ob >> 9) & 1) << 5)); }
__host__ __device__ __forceinline__ void stage_rc(int b, int& R, int& C) { const int st = b / 1024, sb = b % 1024, swz = sb ^ (((sb >> 9) & 1) << 5); R = (st >> 1) * 16 + swz / 64; C = (st & 1) * 32 + (swz % 64) / 2; }
__host__ __device__ __forceinline__ int perm32(int rho) { const int n = rho >> 4, i = rho & 15; return 8 * (i >> 2) + 4 * n + (i & 3); }

struct Unit { int pm, pn; };
struct Gemm { const bf16_t* A; const bf16_t* Bt; int M, N, K; };

struct StaticOrder {
    int nM, nN, nwg, G, c;
    __host__ __device__ void init(int M, int N, int G_, int c_) { nM = M / BM; nN = N / BM; nwg = nM * nN; G = G_; c = c_; }
    __host__ __device__ bool next(int i, Unit& u) const {
        const long L = (long)i * G + c; if (L >= nwg) return false;
        int wgid = (int)L; { const int q = nwg / NXCD, r = nwg % NXCD, xcd = wgid % NXCD, off = wgid / NXCD; wgid = (xcd < r ? xcd * (q + 1) : r * (q + 1) + (xcd - r) * q) + off; }
        const int nig = WGM * nN, gid = wgid / nig, fm = gid * WGM, gsz = (nM - fm) < WGM ? (nM - fm) : WGM;
        u.pm = fm + ((wgid % nig) % gsz); u.pn = (wgid % nig) / gsz; return true;
    }
    __device__ __forceinline__ void a_ready(const Unit&) const {}
    __device__ __forceinline__ void done(const Unit&) const {}
};
__device__ __forceinline__ unsigned cvt_pk_bf16(float lo, float hi) { unsigned r; asm volatile("v_cvt_pk_bf16_f32 %0, %1, %2" : "=v"(r) : "v"(lo), "v"(hi)); return r; }
template <class Epi, class Sched, bool STAMP = false>
__device__ __forceinline__ void gemm_phase(PG8_LAS unsigned char* lds, const Gemm g, const Sched& S, const Epi& E, unsigned long long* stamps) {
    const int tid = threadIdx.x, wid = __builtin_amdgcn_readfirstlane(tid >> 6), lane = tid & 63, wr = wid >> 2, wc = wid & 3, fr = lane & 15, fq = lane >> 4;
    const int K = g.K, nt = K / BK;
    int ts_lo = 0, ts_hi = 0, nts = 0; const unsigned long long rt_entry = STAMP ? (unsigned long long)wall_clock64() : 0ull;
#define PG8_STAMP() do { if (STAMP && wid == 0 && nts < 64) { const unsigned long long _c = (unsigned long long)clock64(); \
        ts_lo = (lane == nts) ? (int)(unsigned)_c : ts_lo; ts_hi = (lane == nts) ? (int)(unsigned)(_c >> 32) : ts_hi; ++nts; } } while (0)
    PG8_STAMP();
    unsigned voffA[2], voffB[2];
#pragma unroll
    for (int i = 0; i < 2; ++i) { int R, C; stage_rc(tid * 16 + i * 8192, R, C); const int Rb = Epi::PERM ? ((R & ~31) + perm32(R & 31)) : R;
        voffA[i] = (unsigned)(R * K + C) * 2u; voffB[i] = (unsigned)(Rb * K + C) * 2u; }
    const size_t kstep = (size_t)(BK * 2);
    const size_t hstep = (size_t)HALF * K * 2;
    const size_t tstep = 2 * hstep;
    const unsigned ldsw = (unsigned)wid * 1024u;
    const int aoff = lds_byte(wr * 64 + fr, fq * 8), boff = lds_byte(wc * 32 + fr, fq * 8);
#define PG8_SA(b, h) (((b) * 2 + (h)) * HTB)
#define PG8_SB(b, h) ((4 + (b) * 2 + (h)) * HTB)
#define PG8_STAGE(bufoff, gbase, voff) do { _Pragma("unroll") for (int _i = 0; _i < 2; ++_i) \
        __builtin_amdgcn_global_load_lds((const unsigned*)((const char*)(gbase) + (voff)[_i]), (PG8_LAS unsigned*)(lds + (bufoff) + ldsw + _i * 8192), 16, 0, 0); } while (0)
#define PG8_LDA(dst, b, h) do { _Pragma("unroll") for (int m = 0; m < 4; ++m) _Pragma("unroll") for (int k = 0; k < 2; ++k) dst[m][k] = *(const PG8_LAS bf16x8*)(lds + PG8_SA(b, h) + aoff + m * 2048 + k * 1024); } while (0)
#define PG8_LDB(dst, b, h) do { _Pragma("unroll") for (int n = 0; n < 2; ++n) _Pragma("unroll") for (int k = 0; k < 2; ++k) dst[n][k] = *(const PG8_LAS bf16x8*)(lds + PG8_SB(b, h) + boff + n * 2048 + k * 1024); } while (0)
#define PG8_MMA(ai, bj, At, Bt) do { __builtin_amdgcn_s_setprio(1); _Pragma("unroll") for (int m = 0; m < 4; ++m) _Pragma("unroll") for (int n = 0; n < 2; ++n) _Pragma("unroll") for (int k = 0; k < 2; ++k) \
        acc[ai][bj][m][n] = __builtin_amdgcn_mfma_f32_16x16x32_bf16(Bt[n][k], At[m][k], acc[ai][bj][m][n], 0, 0, 0); __builtin_amdgcn_s_setprio(0); } while (0)
#define PG8_WAIT_V(n) asm volatile("s_waitcnt vmcnt(" #n ")" ::: "memory")
#define PG8_WAIT_L(n) asm volatile("s_waitcnt lgkmcnt(" #n ")" ::: "memory")
#define PG8_BAR __builtin_amdgcn_s_barrier()
#define PG8_SCHED __builtin_amdgcn_sched_barrier(0)
    Unit cur, nxt; int ui = 0;
    if (!S.next(0, cur)) return;
    f32x4 acc[2][2][4][2];
#pragma unroll
    for (int a = 0; a < 2; ++a)
#pragma unroll
        for (int b = 0; b < 2; ++b)
#pragma unroll
            for (int m = 0; m < 4; ++m)
#pragma unroll
                for (int n = 0; n < 2; ++n) acc[a][b][m][n] = (f32x4){0.f, 0.f, 0.f, 0.f};
    bf16x8 At[4][2], B0[2][2], B1[2][2];
    const char* cA = (const char*)g.A + (size_t)cur.pm * tstep; const char* cB = (const char*)g.Bt + (size_t)cur.pn * tstep;
    S.a_ready(cur);
    PG8_STAGE(PG8_SB(0, 0), cB, voffB); PG8_STAGE(PG8_SA(0, 0), cA, voffA); PG8_STAGE(PG8_SB(0, 1), cB + hstep, voffB); PG8_STAGE(PG8_SA(0, 1), cA + hstep, voffA);
    if (wr == 1) PG8_BAR;
    PG8_WAIT_V(4); PG8_BAR;
    PG8_STAGE(PG8_SB(1, 0), cB + kstep, voffB); PG8_STAGE(PG8_SA(1, 0), cA + kstep, voffA); PG8_STAGE(PG8_SB(1, 1), cB + hstep + kstep, voffB);
    PG8_WAIT_V(6); PG8_BAR;
    PG8_STAMP();
    for (;;) {
        const bool has_next = S.next(ui + 1, nxt);
        const char* nA = has_next ? (const char*)g.A + (size_t)nxt.pm * tstep : cA; const char* nB = has_next ? (const char*)g.Bt + (size_t)nxt.pn * tstep : cB;
        for (int t = 0; t < nt; t += 2) {
            const bool last = (t == nt - 2);
            const char* a1 = cA + (size_t)(t + 1) * kstep;
            const char* a2 = last ? nA : cA + (size_t)(t + 2) * kstep; const char* b2 = last ? nB : cB + (size_t)(t + 2) * kstep;
            const char* a3 = a2 + kstep; const char* b3 = b2 + kstep;
            if (last && has_next) S.a_ready(nxt);
            PG8_LDB(B0, 0, 0); PG8_SCHED; PG8_LDA(At, 0, 0); PG8_STAGE(PG8_SA(1, 1), a1 + hstep, voffA);
            PG8_WAIT_L(8); PG8_BAR; PG8_WAIT_L(0); PG8_MMA(0, 0, At, B0); PG8_BAR; PG8_SCHED;
            PG8_LDB(B1, 0, 1); PG8_STAGE(PG8_SB(0, 0), b2, voffB);
            PG8_BAR; PG8_WAIT_L(0); PG8_MMA(0, 1, At, B1); PG8_BAR;
            PG8_LDA(At, 0, 1); PG8_STAGE(PG8_SA(0, 0), a2, voffA);
            PG8_BAR; PG8_WAIT_L(0); PG8_MMA(1, 0, At, B0); PG8_BAR; PG8_SCHED;
            PG8_STAGE(PG8_SB(0, 1), b2 + hstep, voffB);
            PG8_WAIT_V(6); PG8_BAR; PG8_MMA(1, 1, At, B1); PG8_BAR;
            PG8_LDB(B0, 1, 0); PG8_SCHED; PG8_LDA(At, 1, 0); PG8_STAGE(PG8_SA(0, 1), a2 + hstep, voffA);
            PG8_WAIT_L(8); PG8_BAR; PG8_WAIT_L(0); PG8_MMA(0, 0, At, B0); PG8_BAR; PG8_SCHED;
            PG8_LDB(B1, 1, 1); PG8_STAGE(PG8_SB(1, 0), b3, voffB);
            PG8_BAR; PG8_WAIT_L(0); PG8_MMA(0, 1, At, B1); PG8_BAR;
            PG8_LDA(At, 1, 1); PG8_STAGE(PG8_SA(1, 0), a3, voffA);
            PG8_BAR; PG8_WAIT_L(0); PG8_MMA(1, 0, At, B0); PG8_BAR; PG8_SCHED;
            PG8_STAGE(PG8_SB(1, 1), b3 + hstep, voffB);
            PG8_WAIT_V(6); PG8_BAR; PG8_MMA(1, 1, At, B1); PG8_BAR;
        }
        PG8_STAMP();
        if constexpr (!Epi::AFTER_DRAIN) { E(acc, cur, wr, wc, fr, fq); S.done(cur); }
        PG8_STAMP();
        if (!has_next) break;
        if constexpr (!Epi::KEEP_ACC)
#pragma unroll
        for (int a = 0; a < 2; ++a)
#pragma unroll
            for (int b = 0; b < 2; ++b)
#pragma unroll
                for (int m = 0; m < 4; ++m)
#pragma unroll
                    for (int n = 0; n < 2; ++n) acc[a][b][m][n] = (f32x4){0.f, 0.f, 0.f, 0.f};
        cur = nxt; cA = nA; cB = nB; ++ui;
    }
    PG8_WAIT_V(0);
    if (wr == 0) PG8_BAR;
    PG8_BAR;
    if constexpr (Epi::AFTER_DRAIN) { E.fused(acc, cur, wr, wc, fr, fq, lds, wid, lane); S.done(cur); }
    PG8_STAMP();
    if (STAMP && wid == 0) { stamps[lane] = lane < nts ? (((unsigned long long)(unsigned)ts_hi << 32) | (unsigned)ts_lo) : 0ull;
        if (lane == 62) stamps[62] = rt_entry; if (lane == 63) stamps[63] = (unsigned long long)wall_clock64(); }
#undef PG8_STAMP
#undef PG8_SA
#undef PG8_SB
#undef PG8_STAGE
#undef PG8_LDA
#undef PG8_LDB
#undef PG8_MMA
#undef PG8_WAIT_V
#undef PG8_WAIT_L
#undef PG8_BAR
#undef PG8_SCHED
}
}

using pg8::bf16_t; using pg8::bf16x8; using pg8::f32x4; using pg8::u32x4;
typedef unsigned u32x2 __attribute__((ext_vector_type(2)));
typedef float f32x2 __attribute__((ext_vector_type(2)));
#define LAS __attribute__((address_space(3)))
#ifndef DBG
#define DBG 0
#endif
#ifndef DBGSEL
#define DBGSEL 0
#endif

constexpr int MP = 16384, MS = 512, MT = 16896, DM = 1024, PIN = 9472, PSH = 3328, DFF = 4096;
constexpr int NPANEL = MT / 256;
constexpr size_t O_YP = 0, O_YS = 16777216, O_PSH = 17301504, O_PWKV = 17328128, O_PMK = 17852416, O_PMV = 19949568,
                 O_SSH = 22046720, O_SWKV = 22472704, O_SGV = 30861312, O_END = 31385600;
constexpr size_t WS_CTL = 0, WS_CTL2 = 256, WS_SSQ1 = 256 + 8192, WS_SSQ2 = WS_SSQ1 + 67584, WS_WTIN = WS_SSQ2 + 67584,
    WS_WTBR = WS_WTIN + 19398656, WS_WTOUT = WS_WTBR + 6291456, WS_WTUP = WS_WTOUT + 2097152, WS_WTDN = WS_WTUP + 8388608,
    WS_WTMKV = WS_WTDN + 8388608, WS_WTW2 = WS_WTMKV + 4194304, WS_WTA2 = WS_WTW2 + 131072, WS_WTG2 = WS_WTA2 + 131072,
    WS_SGW = WS_WTG2 + 262144, WS_HMB = WS_SGW + 262144, WS_MKB = WS_HMB + 4194304, WS_MVT = WS_MKB + 4194304,
    WS_Y3 = WS_MVT + 4194304, WS_GV = WS_Y3 + 103809024, WS_SZ = WS_GV + 34603008, WS_GT = WS_SZ + 112459776,
    WS_HB = WS_GT + 103809024, WS_AV = WS_HB + 34603008, WS_GG = WS_AV + 34603008, WS_XL = WS_GG + 34603008, WS_WTLORA = WS_XL + 8650752, WS_END = WS_WTLORA + 1572864;
constexpr size_t WS_MF = WS_SZ, WS_MB = WS_GV, WS_X1 = WS_GT, WS_X1B = WS_HB, WS_HID = WS_Y3, WS_X2 = WS_SZ, WS_E = WS_HB;
constexpr int LDS_BYTES = 131072 + 256;
constexpr int QW_OFF = 131072;

struct Params { const float* in[33]; float* out; unsigned char* ws; };

enum { I_XP = 0, I_XS, I_MEM, I_CK, I_CV, I_SSH, I_SWKV, I_N1G, I_WIN, I_MU, I_LNG, I_LNB, I_SGW, I_SGB, I_W0, I_WW2, I_A0, I_WA2,
       I_WG2, I_KK, I_KA, I_RK, I_LXG, I_LXB, I_MNG, I_WMK, I_WMV, I_WBR, I_WOUT, I_N2G, I_WUP, I_WDN, I_NFG };

__device__ __forceinline__ float bflo(unsigned u) { return __uint_as_float(u << 16); }
__device__ __forceinline__ float bfhi(unsigned u) { return __uint_as_float(u & 0xffff0000u); }
typedef __bf16 bf2_t __attribute__((ext_vector_type(2)));
__device__ __forceinline__ unsigned pk2(float lo, float hi) { const f32x2 v = {lo, hi}; const bf2_t b = __builtin_convertvector(v, bf2_t); return __builtin_bit_cast(unsigned, b); }
__device__ __forceinline__ float rcpf(float x) { return __builtin_amdgcn_rcpf(x); }
__device__ __forceinline__ float sigmoidf_(float x) { return rcpf(1.f + __expf(-x)); }
__device__ __forceinline__ float gelu_tanh(float x) { const float t = 1.5957691216f * (x + 0.044715f * x * x * x); return x * sigmoidf_(t); }
__device__ __forceinline__ float tanhf_(float x) { return 1.f - 2.f * rcpf(__expf(2.f * x) + 1.f); }
template <int CTRL> __device__ __forceinline__ float dpp_mov(float x) { return __int_as_float(__builtin_amdgcn_update_dpp(0, __float_as_int(x), CTRL, 0xF, 0xF, true)); }
__device__ __forceinline__ float red8(float x) { x += dpp_mov<0xB1>(x); x += dpp_mov<0x4E>(x); x += dpp_mov<0x141>(x); return x; }
__device__ __forceinline__ float red16(float x) { x = red8(x); x += dpp_mov<0x140>(x); return x; }
__device__ __forceinline__ float wave_sum(float x) { x = red16(x); x += __shfl_xor(x, 16); x += __shfl_xor(x, 32); return x; }
__device__ __forceinline__ float wave_max(float x) {
#pragma unroll
    for (int o = 1; o < 64; o <<= 1) x = fmaxf(x, __shfl_xor(x, o));
    return x; }
__device__ __forceinline__ f32x4 mfma16(bf16x8 a, bf16x8 b, f32x4 c) { return __builtin_amdgcn_mfma_f32_16x16x32_bf16(a, b, c, 0, 0, 0); }
__device__ __forceinline__ void unpack4(u32x2 q, float (&o)[4]) { o[0] = bflo(q[0]); o[1] = bfhi(q[0]); o[2] = bflo(q[1]); o[3] = bfhi(q[1]); }

struct TJob { const float* src; bf16_t* dst; const float* gain; int K, N, ldd; };
__device__ __forceinline__ void transpose_tile(const TJob& j, int tile, LAS float* t) {
    const int tid = threadIdx.x; const int tn = j.N >> 6; const int k0 = (tile / tn) << 6, n0 = (tile % tn) << 6;
#pragma unroll
    for (int pp = 0; pp < 2; ++pp) { const int r = (tid >> 4) + pp * 32, c = (tid & 15) * 4;
        const f32x4 v = *(const f32x4*)(j.src + (size_t)(k0 + r) * j.N + n0 + c); const float g = j.gain ? j.gain[k0 + r] : 1.f;
        t[r * 65 + c] = v[0] * g; t[r * 65 + c + 1] = v[1] * g; t[r * 65 + c + 2] = v[2] * g; t[r * 65 + c + 3] = v[3] * g; }
    __syncthreads();
    { const int n = tid >> 3, k8 = (tid & 7) * 8; u32x4 o;
#pragma unroll
      for (int q = 0; q < 4; ++q) o[q] = pk2(t[(k8 + 2 * q) * 65 + n], t[(k8 + 2 * q + 1) * 65 + n]);
      *(u32x4*)(j.dst + (size_t)(n0 + n) * j.ldd + k0 + k8) = o; }
    __syncthreads();
}
__device__ __forceinline__ void phase0(const Params& p, LAS unsigned char* lds) {
    const int tid = threadIdx.x, wid = tid >> 6, lane = tid & 63; unsigned char* ws = p.ws;
    for (int it = blockIdx.x; it < 6016; it += gridDim.x) {
        TJob j; int base;
        if (it < 2368)      { j = {p.in[I_WIN], (bf16_t*)(ws + WS_WTIN), p.in[I_N1G], 1024, PIN, 1024}; base = 0; }
        else if (it < 3136) { const int n = (it - 2368) >> 8; j = {p.in[I_WBR] + (size_t)n * 1048576, (bf16_t*)(ws + WS_WTBR) + (size_t)n * 1048576, nullptr, 1024, 1024, 1024}; base = 2368 + n * 256; }
        else if (it < 3392) { j = {p.in[I_WOUT], (bf16_t*)(ws + WS_WTOUT), nullptr, 1024, 1024, 1024}; base = 3136; }
        else if (it < 4416) { j = {p.in[I_WUP], (bf16_t*)(ws + WS_WTUP), p.in[I_N2G], 1024, 4096, 1024}; base = 3392; }
        else if (it < 5440) { j = {p.in[I_WDN], (bf16_t*)(ws + WS_WTDN), nullptr, 4096, 1024, 4096}; base = 4416; }
        else if (it < 5696) { j = {p.in[I_WMK], (bf16_t*)(ws + WS_WTMKV), p.in[I_MNG], 1024, 1024, 1024}; base = 5440; }
        else if (it < 5952) { j = {p.in[I_WMV], (bf16_t*)(ws + WS_WTMKV) + 1048576, p.in[I_MNG], 1024, 1024, 1024}; base = 5696; }
        else if (it < 5968) { j = {p.in[I_WW2], (bf16_t*)(ws + WS_WTLORA), nullptr, 64, 1024, 256}; base = 5952; }
        else if (it < 5984) { j = {p.in[I_WA2], (bf16_t*)(ws + WS_WTLORA) + 1024 * 256 + 64, nullptr, 64, 1024, 256}; base = 5968; }
        else                { j = {p.in[I_WG2], (bf16_t*)(ws + WS_WTLORA) + 2048 * 256 + 128, nullptr, 128, 1024, 256}; base = 5984; }
        transpose_tile(j, it - base, (LAS float*)lds);
    }
    for (int r = blockIdx.x * 8 + wid; r < MT + 2048; r += gridDim.x * 8) {
        const float* src; bf16_t* dst;
        if (r < MP) { src = p.in[I_XP] + (size_t)r * 1024; dst = (bf16_t*)(ws + WS_HB) + (size_t)r * 1024; }
        else if (r < MT) { src = p.in[I_XS] + (size_t)(r - MP) * 1024; dst = (bf16_t*)(ws + WS_HB) + (size_t)r * 1024; }
        else { src = p.in[I_MEM] + (size_t)(r - MT) * 1024; dst = (bf16_t*)(ws + WS_HMB) + (size_t)(r - MT) * 1024; }
        f32x4 v[4]; float ss = 0.f;
#pragma unroll
        for (int c = 0; c < 4; ++c) { v[c] = *(const f32x4*)(src + c * 256 + lane * 4); ss += v[c][0] * v[c][0] + v[c][1] * v[c][1] + v[c][2] * v[c][2] + v[c][3] * v[c][3]; }
        ss = wave_sum(ss); const float rs = rsqrtf(ss * (1.f / 1024.f) + 1e-6f);
#pragma unroll
        for (int c = 0; c < 4; ++c) { u32x2 o; o[0] = pk2(v[c][0] * rs, v[c][1] * rs); o[1] = pk2(v[c][2] * rs, v[c][3] * rs); *(u32x2*)(dst + c * 256 + lane * 4) = o; }
    }
    { bf16_t* wl = (bf16_t*)(ws + WS_WTLORA);
      for (int i = blockIdx.x * 512 + tid; i < 3072 * 32; i += gridDim.x * 512) { const int row = i >> 5, cc = (i & 31) * 8, blk = row >> 10;
          const bool used = (blk == 0 && cc < 64) || (blk == 1 && cc >= 64 && cc < 128) || (blk == 2 && cc >= 128);
          if (!used) *(u32x4*)(wl + (size_t)row * 256 + cc) = (u32x4){0u, 0u, 0u, 0u}; } }
    { const float* sg = p.in[I_SGW]; bf16_t* d = (bf16_t*)(ws + WS_SGW);
      for (int i = blockIdx.x * 512 + tid; i < 8 * 128 * 128; i += gridDim.x * 512) { const int t = (i >> 7) & 127, s = i & 127; d[i] = (bf16_t)(pk2(s <= t ? sg[i] : 0.f, 0.f) & 0xffffu); } }
}

struct EpiZ {
    static constexpr bool PERM = true, AFTER_DRAIN = false, KEEP_ACC = false;
    bf16_t *U, *GVp, *SZp, *Qp, *GTp; float* out;
    __device__ __forceinline__ void operator()(const f32x4 (&acc)[2][2][4][2], const pg8::Unit& u, int wr, int wc, int fr, int fq) const {
        const int pn = u.pn; bf16_t* base; int ldc, colt, act;
        if (pn < 4) { base = U; ldc = 1024; colt = pn * 256; act = 1; }
        else if (pn < 8) { base = GVp; ldc = 1024; colt = (pn - 4) * 256; act = 1; }
        else if (pn < 21) { base = SZp; ldc = PSH; colt = (pn - 8) * 256; act = 0; }
        else if (pn < 25) { base = Qp; ldc = 1024; colt = (pn - 21) * 256; act = 3; }
        else { base = GTp; ldc = 3072; colt = (pn - 25) * 256; act = 2; }
        const int row0 = u.pm * 256 + wr * 64 + fr, col0 = colt + wc * 32 + 8 * fq;
#pragma unroll
        for (int ai = 0; ai < 2; ++ai)
#pragma unroll
            for (int m = 0; m < 4; ++m) { const int row = row0 + ai * 128 + m * 16; bf16_t* rowp = base + (size_t)row * ldc + col0;
#pragma unroll
                for (int bj = 0; bj < 2; ++bj) { f32x4 v0 = acc[ai][bj][m][0], v1 = acc[ai][bj][m][1];
                    if (act == 1) {
#pragma unroll
                        for (int q = 0; q < 4; ++q) { v0[q] = gelu_tanh(v0[q]); v1[q] = gelu_tanh(v1[q]); } }
                    else if (act == 2) {
#pragma unroll
                        for (int q = 0; q < 4; ++q) { v0[q] = sigmoidf_(v0[q]); v1[q] = sigmoidf_(v1[q]); } }
                    else if (act == 0) {
                        const bool lastp = row < MP ? ((row & 2047) == 2047) : (((row - MP) & 3) == 3);
                        if (lastp) { float* d = (row < MP ? out + O_PSH + (size_t)(row >> 11) * PSH : out + O_SSH + (size_t)((row - MP) >> 2) * PSH) + col0 + bj * 128;
                            *(f32x4*)d = v0; *(f32x4*)(d + 4) = v1; } }
                    u32x4 o; o[0] = pk2(v0[0], v0[1]); o[1] = pk2(v0[2], v0[3]); o[2] = pk2(v1[0], v1[1]); o[3] = pk2(v1[2], v1[3]);
                    *(u32x4*)(rowp + bj * 128) = o; } }
    }
};
struct EpiMem {
    static constexpr bool PERM = false, AFTER_DRAIN = false, KEEP_ACC = false;
    float* out; bf16_t *MKB, *MVT;
    __device__ __forceinline__ void operator()(const f32x4 (&acc)[2][2][4][2], const pg8::Unit& u, int wr, int wc, int fr, int fq) const {
        const int row0 = u.pm * 256 + wr * 64 + fr, col0 = u.pn * 256 + wc * 32 + 4 * fq; const bool isv = u.pn >= 4;
#pragma unroll
        for (int ai = 0; ai < 2; ++ai)
#pragma unroll
            for (int m = 0; m < 4; ++m) { const int row = row0 + ai * 128 + m * 16;
#pragma unroll
                for (int bj = 0; bj < 2; ++bj)
#pragma unroll
                    for (int n = 0; n < 2; ++n) { const f32x4 v = acc[ai][bj][m][n]; const int col = col0 + bj * 128 + n * 16;
                        if (!isv) { *(f32x4*)(out + O_PMK + (size_t)row * 1024 + col) = v; u32x2 o; o[0] = pk2(v[0], v[1]); o[1] = pk2(v[2], v[3]); *(u32x2*)(MKB + (size_t)row * 1024 + col) = o; }
                        else { const int c = col - 1024; *(f32x4*)(out + O_PMV + (size_t)row * 1024 + c) = v;
                            const int b = row >> 8, mem = row & 255, head = c >> 8, d = c & 255; bf16_t* dst = MVT + ((size_t)((b * 4 + head) * 256 + d)) * 256 + mem;
                            const unsigned p0 = pk2(v[0], v[1]), p1 = pk2(v[2], v[3]);
                            dst[0] = (bf16_t)(p0 & 0xffffu); dst[256] = (bf16_t)(p0 >> 16); dst[512] = (bf16_t)(p1 & 0xffffu); dst[768] = (bf16_t)(p1 >> 16); } } }
    }
};
struct BranchOrder {
    int G, c;
    __device__ bool next(int i, pg8::Unit& u) const { const int tile = (i / 3) * G + c, n = i % 3; if (tile >= (MP / 256) * 4) return false; u.pm = n * NPANEL + (tile >> 2); u.pn = n * 4 + (tile & 3); return true; }
    __device__ __forceinline__ void a_ready(const pg8::Unit&) const {}
    __device__ __forceinline__ void done(const pg8::Unit&) const {}
};
struct EpiMerge {
    static constexpr bool PERM = false, AFTER_DRAIN = false, KEEP_ACC = true;
    const bf16_t* GT; bf16_t* MB;
    __device__ __forceinline__ void operator()(const f32x4 (&acc_)[2][2][4][2], const pg8::Unit& u, int wr, int wc, int fr, int fq) const {
        f32x4 (&acc)[2][2][4][2] = const_cast<f32x4 (&)[2][2][4][2]>(acc_);
        const int n = u.pm / NPANEL, pm = u.pm - n * NPANEL, pn = u.pn & 3;
        const int row0 = pm * 256 + wr * 64 + fr, col0 = pn * 256 + wc * 32 + 4 * fq;
#pragma unroll
        for (int ai = 0; ai < 2; ++ai) { u32x2 ga[4][4], gb[4][4];
#pragma unroll
            for (int m = 0; m < 4; ++m) { const bf16_t* gp = GT + (size_t)(row0 + ai * 128 + m * 16) * 3072 + n * 1024 + col0;
#pragma unroll
                for (int x = 0; x < 4; ++x) { ga[m][x] = *(const u32x2*)(gp + (x >> 1) * 128 + (x & 1) * 16); if (n < 2) gb[m][x] = *(const u32x2*)(gp + 1024 + (x >> 1) * 128 + (x & 1) * 16); else gb[m][x] = ga[m][x]; } }
#pragma unroll
            for (int m = 0; m < 4; ++m) { const int row = row0 + ai * 128 + m * 16;
#pragma unroll
                for (int x = 0; x < 4; ++x) { float g0[4], g1[4]; unpack4(ga[m][x], g0); unpack4(gb[m][x], g1); f32x4 v = acc[ai][x >> 1][m][x & 1];
                    if (n < 2) {
#pragma unroll
                        for (int q = 0; q < 4; ++q) v[q] *= g0[q] * rcpf(fmaxf(g1[q], 1e-30f));
                        acc[ai][x >> 1][m][x & 1] = v; }
                    else { u32x2 w; w[0] = pk2(v[0] * g0[0], v[1] * g0[1]); w[1] = pk2(v[2] * g0[2], v[3] * g0[3]); *(u32x2*)(MB + (size_t)row * 1024 + col0 + (x >> 1) * 128 + (x & 1) * 16) = w; } } } }
    }
};
template <int KS, class Mid, class Fin>
__device__ __forceinline__ void thin_gemm(LAS unsigned char* lds, const bf16_t* A0, size_t a_bstride, const bf16_t* B0, size_t b_bstride, int nb, int N, int K, const Mid& mid, const Fin& fin) {
    const int wid = threadIdx.x >> 6, lane = threadIdx.x & 63, fr = lane & 15, fq = lane >> 4; const int ntask = 32 * (N >> 6);
    constexpr int TPB = 8 / KS; const int grp = wid / KS, kq = wid % KS, kspan = K / KS;
    LAS f32x4* red = (LAS f32x4*)lds;
    for (int t0 = blockIdx.x * TPB; t0 < ntask; t0 += gridDim.x * TPB) {
        const int t = t0 + grp; const bool valid = t < ntask;
        const int r0 = MP + (t & 31) * 16, c0 = (t >> 5) * 64;
        f32x4 tot[4];
#pragma unroll
        for (int j = 0; j < 4; ++j) tot[j] = (f32x4){0.f, 0.f, 0.f, 0.f};
        if (valid) for (int n = 0; n < nb; ++n) { f32x4 acc[4];
#pragma unroll
            for (int j = 0; j < 4; ++j) acc[j] = (f32x4){0.f, 0.f, 0.f, 0.f};
            const bf16_t* ap = A0 + (size_t)n * a_bstride + (size_t)(r0 + fr) * K + kq * kspan + fq * 8; const bf16_t* bp = B0 + (size_t)n * b_bstride + (size_t)(c0 + fr) * K + kq * kspan + fq * 8;
#pragma unroll 4
            for (int ks = 0; ks < (kspan >> 5); ++ks) { const bf16x8 a = *(const bf16x8*)(ap + ks * 32);
#pragma unroll
                for (int j = 0; j < 4; ++j) { const bf16x8 b = *(const bf16x8*)(bp + (size_t)j * 16 * K + ks * 32); acc[j] = mfma16(b, a, acc[j]); } }
            mid(n, acc, tot, r0 + fr, c0 + 4 * fq); }
        if (KS > 1) {
#pragma unroll
            for (int j = 0; j < 4; ++j) red[(wid * 4 + j) * 64 + lane] = tot[j];
            __syncthreads();
            if (kq == 0 && valid) {
#pragma unroll
                for (int q = 1; q < KS; ++q)
#pragma unroll
                    for (int j = 0; j < 4; ++j) tot[j] += red[((wid + q) * 4 + j) * 64 + lane];
                fin(tot, r0 + fr, c0 + 4 * fq); }
            __syncthreads();
        } else if (valid) fin(tot, r0 + fr, c0 + 4 * fq);
    }
}
struct EpiRes {
    static constexpr bool PERM = false, AFTER_DRAIN = false, KEEP_ACC = false;
    const float* resP; const float* resS; float* X; bf16_t* XB; float* ssq;
    __device__ __forceinline__ void operator()(const f32x4 (&acc)[2][2][4][2], const pg8::Unit& u, int wr, int wc, int fr, int fq) const {
        const int row0 = u.pm * 256 + wr * 64 + fr, col0 = u.pn * 256 + wc * 32 + 4 * fq;
#pragma unroll
        for (int ai = 0; ai < 2; ++ai) { f32x4 r[4][4];
#pragma unroll
            for (int m = 0; m < 4; ++m) { const int row = row0 + ai * 128 + m * 16; const float* rp = (row < MP ? resP + (size_t)row * 1024 : resS + (size_t)(row - MP) * 1024) + col0;
#pragma unroll
                for (int x = 0; x < 4; ++x) r[m][x] = *(const f32x4*)(rp + (x >> 1) * 128 + (x & 1) * 16); }
#pragma unroll
            for (int m = 0; m < 4; ++m) { const int row = row0 + ai * 128 + m * 16; float ss = 0.f;
#pragma unroll
                for (int x = 0; x < 4; ++x) { const int col = col0 + (x >> 1) * 128 + (x & 1) * 16; const f32x4 v = acc[ai][x >> 1][m][x & 1] + r[m][x];
                    *(f32x4*)(X + (size_t)row * 1024 + col) = v; ss += v[0] * v[0] + v[1] * v[1] + v[2] * v[2] + v[3] * v[3];
                    if (XB) { u32x2 w; w[0] = pk2(v[0], v[1]); w[1] = pk2(v[2], v[3]); *(u32x2*)(XB + (size_t)row * 1024 + col) = w; } }
                ss += __shfl_xor(ss, 16); ss += __shfl_xor(ss, 32);
                if (fq == 0) atomicAdd(ssq + row, ss); } }
    }
};
struct EpiUp {
    static constexpr bool PERM = true, AFTER_DRAIN = false, KEEP_ACC = false;
    const float* ssq; bf16_t* H;
    __device__ __forceinline__ void operator()(const f32x4 (&acc)[2][2][4][2], const pg8::Unit& u, int wr, int wc, int fr, int fq) const {
        const int row0 = u.pm * 256 + wr * 64 + fr, col0 = u.pn * 256 + wc * 32 + 8 * fq;
#pragma unroll
        for (int ai = 0; ai < 2; ++ai)
#pragma unroll
            for (int m = 0; m < 4; ++m) { const int row = row0 + ai * 128 + m * 16; const float rs = rsqrtf(ssq[row] * (1.f / 1024.f) + 1e-6f);
#pragma unroll
                for (int bj = 0; bj < 2; ++bj) { f32x4 v0 = acc[ai][bj][m][0], v1 = acc[ai][bj][m][1];
#pragma unroll
                    for (int q = 0; q < 4; ++q) { float a = fmaxf(v0[q] * rs, 0.f); v0[q] = a * a; float b = fmaxf(v1[q] * rs, 0.f); v1[q] = b * b; }
                    u32x4 o; o[0] = pk2(v0[0], v0[1]); o[1] = pk2(v0[2], v0[3]); o[2] = pk2(v1[0], v1[1]); o[3] = pk2(v1[2], v1[3]);
                    *(u32x4*)(H + (size_t)row * DFF + col0 + bj * 128) = o; } }
    }
};

template <int NR, bool DUMMY> __device__ __forceinline__ void p2_rows(const Params& p, const int (&mrow)[NR], int lane) {
    unsigned char* ws = p.ws; const float* lng = p.in[I_LNG]; const float* lnb = p.in[I_LNB];
    const int c4 = lane * 4;
    u32x4 q0[NR], q1[NR]; u32x2 cq[NR], pq[NR]; f32x4 sq[NR]; bool valid[NR], first[NR];
#pragma unroll
    for (int i = 0; i < NR; ++i) { const int m = mrow[i]; valid[i] = m < MT; const int mm = valid[i] ? m : 0;
        const bf16_t* row = (const bf16_t*)(ws + WS_GV) + (size_t)mm * 1024; q0[i] = *(const u32x4*)(row + lane * 8); q1[i] = *(const u32x4*)(row + 512 + lane * 8);
        const bf16_t* cur = (const bf16_t*)(ws + WS_SZ) + (size_t)mm * PSH + 3072 + c4; cq[i] = *(const u32x2*)cur;
        first[i] = mm < MP ? ((mm & 2047) == 0) : (((mm - MP) & 3) == 0);
        pq[i] = (u32x2){0u, 0u}; sq[i] = (f32x4){0.f, 0.f, 0.f, 0.f};
        if (!first[i]) pq[i] = *(const u32x2*)(cur - PSH);
        else if (mm >= MP) sq[i] = *(const f32x4*)(p.in[I_SSH] + (size_t)((mm - MP) >> 2) * PSH + 3072 + c4); }
    const f32x4 mu = *(const f32x4*)(p.in[I_MU] + 3072 + c4);
    f32x4 g0[2], g1[2], b0[2], b1[2];
#pragma unroll
    for (int c = 0; c < 2; ++c) { const int col = c * 512 + lane * 8; g0[c] = *(const f32x4*)(lng + col); g1[c] = *(const f32x4*)(lng + col + 4); b0[c] = *(const f32x4*)(lnb + col); b1[c] = *(const f32x4*)(lnb + col + 4); }
#pragma unroll
    for (int i = 0; i < NR; ++i) { if (!valid[i]) continue; const int m = mrow[i]; bf16_t* row = (bf16_t*)(ws + WS_GV) + (size_t)m * 1024; float x[16];
#pragma unroll
        for (int k = 0; k < 4; ++k) { x[2 * k] = bflo(q0[i][k]); x[2 * k + 1] = bfhi(q0[i][k]); x[8 + 2 * k] = bflo(q1[i][k]); x[8 + 2 * k + 1] = bfhi(q1[i][k]); }
        float s = 0.f;
#pragma unroll
        for (int k = 0; k < 16; ++k) s += x[k];
        s = wave_sum(s); const float mean = s * (1.f / 1024.f); float vs = 0.f;
#pragma unroll
        for (int k = 0; k < 16; ++k) { x[k] -= mean; vs += x[k] * x[k]; }
        vs = wave_sum(vs); const float rstd = rsqrtf(vs * (1.f / 1024.f) + 1e-5f);
#pragma unroll
        for (int c = 0; c < 2; ++c) { const int col = c * 512 + lane * 8; float y[8];
#pragma unroll
            for (int k = 0; k < 4; ++k) { y[k] = x[c * 8 + k] * rstd * g0[c][k] + b0[c][k]; y[4 + k] = x[c * 8 + 4 + k] * rstd * g1[c][k] + b1[c][k]; }
            u32x4 o; o[0] = pk2(y[0], y[1]); o[1] = pk2(y[2], y[3]); o[2] = pk2(y[4], y[5]); o[3] = pk2(y[6], y[7]); if (!DUMMY) *(u32x4*)(row + col) = o;
            if (m >= MP) { float* d = p.out + O_SGV + (size_t)(m - MP) * 1024 + col; *(f32x4*)d = (f32x4){y[0], y[1], y[2], y[3]}; *(f32x4*)(d + 4) = (f32x4){y[4], y[5], y[6], y[7]}; } }
        float cv[4], pv[4], o[4]; unpack4(cq[i], cv);
        if (!first[i]) unpack4(pq[i], pv); else { pv[0] = sq[i][0]; pv[1] = sq[i][1]; pv[2] = sq[i][2]; pv[3] = sq[i][3]; }
#pragma unroll
        for (int e = 0; e < 4; ++e) { const float ss = cv[e] + (pv[e] - cv[e]) * mu[e]; o[e] = lane < 16 ? tanhf_(ss) : (lane < 32 ? ss : sigmoidf_(ss)); }
        u32x2 w; w[0] = pk2(o[0], o[1]); w[1] = pk2(o[2], o[3]); *(u32x2*)((bf16_t*)(ws + WS_XL) + (size_t)m * 256 + c4) = w; }
}
struct EpiLora {
    static constexpr bool PERM = true, AFTER_DRAIN = false, KEEP_ACC = false;
    bf16_t *E, *A, *Gg; const float *w0, *a0;
    __device__ __forceinline__ void operator()(const f32x4 (&acc)[2][2][4][2], const pg8::Unit& u, int wr, int wc, int fr, int fq) const {
        const int seg = u.pn >> 2, colt = (u.pn & 3) * 256; bf16_t* base = E + (size_t)seg * 17301504;
        const int row0 = u.pm * 256 + wr * 64 + fr, col0 = colt + wc * 32 + 8 * fq;
        f32x4 bv[2][2];
#pragma unroll
        for (int bj = 0; bj < 2; ++bj) { if (seg == 0) { bv[bj][0] = *(const f32x4*)(w0 + col0 + bj * 128); bv[bj][1] = *(const f32x4*)(w0 + col0 + bj * 128 + 4); } else if (seg == 1) { bv[bj][0] = *(const f32x4*)(a0 + col0 + bj * 128); bv[bj][1] = *(const f32x4*)(a0 + col0 + bj * 128 + 4); } else { bv[bj][0] = (f32x4){0.f, 0.f, 0.f, 0.f}; bv[bj][1] = bv[bj][0]; } }
#pragma unroll
        for (int ai = 0; ai < 2; ++ai)
#pragma unroll
            for (int m = 0; m < 4; ++m) { const int row = row0 + ai * 128 + m * 16; bf16_t* rowp = base + (size_t)row * 1024 + col0;
#pragma unroll
                for (int bj = 0; bj < 2; ++bj) { f32x4 v0 = acc[ai][bj][m][0] + bv[bj][0], v1 = acc[ai][bj][m][1] + bv[bj][1];
                    if (seg == 0) {
#pragma unroll
                        for (int q = 0; q < 4; ++q) { v0[q] = 0.60653066f * sigmoidf_(v0[q]); v1[q] = 0.60653066f * sigmoidf_(v1[q]); } }
                    else if (seg == 1) {
#pragma unroll
                        for (int q = 0; q < 4; ++q) { v0[q] = sigmoidf_(v0[q]); v1[q] = sigmoidf_(v1[q]); } }
                    u32x4 o; o[0] = pk2(v0[0], v0[1]); o[1] = pk2(v0[2], v0[3]); o[2] = pk2(v1[0], v1[1]); o[3] = pk2(v1[2], v1[3]);
                    *(u32x4*)(rowp + bj * 128) = o; } }
    }
};

struct ScanPre { u32x2 cr, ck, cv, pr, pk, pv, e, a, g; };
__device__ __forceinline__ u32x2 pack4f(const float* s) { const f32x4 q = *(const f32x4*)s; u32x2 o; o[0] = pk2(q[0], q[1]); o[1] = pk2(q[2], q[3]); return o; }
__device__ __forceinline__ void scan_head(const Params& p, LAS unsigned char* lds, int row0, int T, int h, const float* s0, float* sfin, const float* shift0) {
    const int tid = threadIdx.x, wid = tid >> 6, lane = tid & 63; unsigned char* ws = p.ws;
    const bf16_t* SZp = (const bf16_t*)(ws + WS_SZ); const bf16_t* Ep = (const bf16_t*)(ws + WS_E); const bf16_t* Ap = (const bf16_t*)(ws + WS_AV); const bf16_t* Gp = (const bf16_t*)(ws + WS_GG);
    bf16_t* YB = (bf16_t*)(ws + WS_Y3) + (size_t)MT * 1024;
    LAS float* bufs = (LAS float*)lds;
    LAS float* Yl2 = (LAS float*)(lds + 98304);
    LAS float* BON = (LAS float*)(lds + 98304 + 16384);
    const bool helper = wid >= 4; const int htid = tid & 255;
    const int tth = htid >> 4, j4 = (htid & 15) * 4, ch = h * 64 + j4;
    const int si = (wid & 3) * 16 + (lane >> 3) * 2, jb = (lane & 7) * 8;
    f32x2 S0[4], S1[4];
    if (s0 && !helper) {
#pragma unroll
        for (int q = 0; q < 4; ++q) { S0[q] = *(const f32x2*)(s0 + si * 64 + jb + 2 * q); S1[q] = *(const f32x2*)(s0 + (si + 1) * 64 + jb + 2 * q); } }
    else {
#pragma unroll
        for (int q = 0; q < 4; ++q) { S0[q] = (f32x2){0.f, 0.f}; S1[q] = S0[q]; } }
    auto load_pre = [&](int t0, ScanPre (&P)[2]) {
#pragma unroll
        for (int pp = 0; pp < 2; ++pp) { const int t = t0 + tth + 16 * pp; ScanPre& Q = P[pp];
            if (t < T) { const size_t m = (size_t)(row0 + t); const bf16_t* c = SZp + m * PSH + ch;
                Q.cr = *(const u32x2*)c; Q.ck = *(const u32x2*)(c + 1024); Q.cv = *(const u32x2*)(c + 2048);
                if (t > 0) { Q.pr = *(const u32x2*)(c - PSH); Q.pk = *(const u32x2*)(c - PSH + 1024); Q.pv = *(const u32x2*)(c - PSH + 2048); }
                else if (shift0) { Q.pr = pack4f(shift0 + ch); Q.pk = pack4f(shift0 + 1024 + ch); Q.pv = pack4f(shift0 + 2048 + ch); }
                else { Q.pr = (u32x2){0u, 0u}; Q.pk = Q.pr; Q.pv = Q.pr; }
                Q.e = *(const u32x2*)(Ep + m * 1024 + ch); Q.a = *(const u32x2*)(Ap + m * 1024 + ch); Q.g = (u32x2){0u, 0u}; }
            else { Q.cr = (u32x2){0u, 0u}; Q.ck = Q.cr; Q.cv = Q.cr; Q.pr = Q.cr; Q.pk = Q.cr; Q.pv = Q.cr; Q.e = Q.cr; Q.a = Q.cr; Q.g = Q.cr; } }
    };
    auto store_pre = [&](const ScanPre (&P)[2], int nb) {
        const f32x4 mur = *(const f32x4*)(p.in[I_MU] + ch), muk = *(const f32x4*)(p.in[I_MU] + 1024 + ch), muv = *(const f32x4*)(p.in[I_MU] + 2048 + ch),
                    kkc = *(const f32x4*)(p.in[I_KK] + ch), kac = *(const f32x4*)(p.in[I_KA] + ch), rkc = *(const f32x4*)(p.in[I_RK] + ch);
#pragma unroll
        for (int pp = 0; pp < 2; ++pp) { const ScanPre& Q = P[pp]; const int tt = tth + 16 * pp;
            float cr[4], ck[4], cv[4], pr[4], pk[4], pv[4], e[4], a[4];
            unpack4(Q.cr, cr); unpack4(Q.ck, ck); unpack4(Q.cv, cv); unpack4(Q.pr, pr); unpack4(Q.pk, pk); unpack4(Q.pv, pv); unpack4(Q.e, e); unpack4(Q.a, a);
            f32x4 r, w, k, na, bb, v; float ssq = 0.f, bon = 0.f; float kkr[4];
#pragma unroll
            for (int q = 0; q < 4; ++q) { r[q] = cr[q] + (pr[q] - cr[q]) * mur[q]; const float kz = ck[q] + (pk[q] - ck[q]) * muk[q]; v[q] = cv[q] + (pv[q] - cv[q]) * muv[q];
                k[q] = kz * (1.f + (a[q] - 1.f) * kac[q]); kkr[q] = kz * kkc[q]; ssq += kkr[q] * kkr[q]; bon += r[q] * k[q] * rkc[q]; w[q] = __expf(-e[q]); }
            ssq = red16(ssq); bon = red16(bon); const float rn = rsqrtf(ssq + 1e-12f);
#pragma unroll
            for (int q = 0; q < 4; ++q) { const float kk = kkr[q] * rn; na[q] = -kk; bb[q] = kk * a[q]; }
            LAS float* b = bufs + nb * 12288 + tt * 64 + j4;
            *(LAS f32x4*)(b) = r; *(LAS f32x4*)(b + 2048) = w; *(LAS f32x4*)(b + 4096) = k; *(LAS f32x4*)(b + 6144) = na; *(LAS f32x4*)(b + 8192) = bb; *(LAS f32x4*)(b + 10240) = v;
            if ((htid & 15) == 0) BON[nb * 32 + tt] = bon; }
    };
    auto epilogue = [&](int c) {
        const int cb = c & 1, t0 = c * 32, nv = (T - t0) < 32 ? (T - t0) : 32;
        const f32x4 lg = *(const f32x4*)(p.in[I_LXG] + h * 64 + j4), lb = *(const f32x4*)(p.in[I_LXB] + h * 64 + j4);
        u32x2 gq[2];
#pragma unroll
        for (int pp = 0; pp < 2; ++pp) { const int tt = tth + 16 * pp; gq[pp] = (u32x2){0u, 0u}; if (tt < nv) gq[pp] = *(const u32x2*)(Gp + (size_t)(row0 + t0 + tt) * 1024 + ch); }
#pragma unroll
        for (int pp = 0; pp < 2; ++pp) { const int tt = tth + 16 * pp;
            if (tt < nv) { const size_t m = (size_t)(row0 + t0 + tt);
                const f32x4 y = *(const LAS f32x4*)(Yl2 + cb * 2048 + tt * 64 + j4); const f32x4 v = *(const LAS f32x4*)(bufs + cb * 12288 + 10240 + tt * 64 + j4); const float bon = BON[cb * 32 + tt];
                float s = y[0] + y[1] + y[2] + y[3]; s = red16(s); const float mean = s * (1.f / 64.f);
                float d[4], vs = 0.f;
#pragma unroll
                for (int q = 0; q < 4; ++q) { d[q] = y[q] - mean; vs += d[q] * d[q]; }
                vs = red16(vs); const float rstd = rsqrtf(vs * (1.f / 64.f) + 64e-5f);
                float g[4]; unpack4(gq[pp], g); float o[4];
#pragma unroll
                for (int q = 0; q < 4; ++q) o[q] = (d[q] * rstd * lg[q] + lb[q] + bon * v[q]) * g[q];
                u32x2 w; w[0] = pk2(o[0], o[1]); w[1] = pk2(o[2], o[3]); *(u32x2*)(YB + m * 1024 + h * 64 + j4) = w; } }
    };
    ScanPre P[2];
    if (helper) { load_pre(0, P); store_pre(P, 0); }
    __syncthreads();
    const int nch = (T + 31) >> 5;
    for (int c = 0; c < nch; ++c) {
        const int cb = c & 1, t0 = c * 32, nv = (T - t0) < 32 ? (T - t0) : 32;
        if (!helper) { const LAS float* b = bufs + cb * 12288 + jb; const LAS float* vb = bufs + cb * 12288 + 10240 + si; LAS float* Yl = Yl2 + cb * 2048;
          f32x4 R[2], W[2], K[2], A[2], B[2], nR[2], nW[2], nK[2], nA[2], nB[2]; f32x2 v, nvv;
#define SCAN_LOAD(R_, W_, K_, A_, B_, V_, t) { const LAS float* bt = b + (t) * 64; _Pragma("unroll") for (int x = 0; x < 2; ++x) { \
              A_[x] = *(const LAS f32x4*)(bt + 6144 + 4 * x); B_[x] = *(const LAS f32x4*)(bt + 8192 + 4 * x); W_[x] = *(const LAS f32x4*)(bt + 2048 + 4 * x); \
              K_[x] = *(const LAS f32x4*)(bt + 4096 + 4 * x); R_[x] = *(const LAS f32x4*)(bt + 4 * x); } V_ = *(const LAS f32x2*)(vb + (t) * 64); }
#define H2(X, q) ((f32x2){X[(q) >> 1][((q) & 1) * 2], X[(q) >> 1][((q) & 1) * 2 + 1]})
          SCAN_LOAD(R, W, K, A, B, v, 0)
#pragma unroll 4
          for (int t = 0; t < nv; ++t) {
              { const int tn = (t + 1 < 32) ? t + 1 : 31; SCAN_LOAD(nR, nW, nK, nA, nB, nvv, tn) }
              asm volatile("" ::: "memory");
              f32x2 d0 = S0[0] * H2(A, 0), d1 = S1[0] * H2(A, 0);
#pragma unroll
              for (int q = 1; q < 4; ++q) { d0 += S0[q] * H2(A, q); d1 += S1[q] * H2(A, q); }
              const float sa0 = red8(d0[0] + d0[1]), sa1 = red8(d1[0] + d1[1]);
              const f32x2 sa02 = {sa0, sa0}, sa12 = {sa1, sa1}, v02 = {v[0], v[0]}, v12 = {v[1], v[1]};
#pragma unroll
              for (int q = 0; q < 4; ++q) { S0[q] = S0[q] * H2(W, q) + (sa02 * H2(B, q) + v02 * H2(K, q)); S1[q] = S1[q] * H2(W, q) + (sa12 * H2(B, q) + v12 * H2(K, q)); }
              f32x2 y0 = S0[0] * H2(R, 0), y1 = S1[0] * H2(R, 0);
#pragma unroll
              for (int q = 1; q < 4; ++q) { y0 += S0[q] * H2(R, q); y1 += S1[q] * H2(R, q); }
              float yy0 = y0[0] + y0[1], yy1 = y1[0] + y1[1];
              asm("" : "+v"(yy0)); asm("" : "+v"(yy1));
              yy0 = red8(yy0); yy1 = red8(yy1);
              *(LAS f32x2*)(Yl + t * 64 + si) = (f32x2){yy0, yy1};
#pragma unroll
              for (int x = 0; x < 2; ++x) { R[x] = nR[x]; W[x] = nW[x]; K[x] = nK[x]; A[x] = nA[x]; B[x] = nB[x]; }
              v = nvv; }
#undef SCAN_LOAD
#undef H2
        } else {
            if (c + 1 < nch) load_pre(t0 + 32, P);
            if (c > 0) epilogue(c - 1);
            if (c + 1 < nch) store_pre(P, cb ^ 1);
        }
        __syncthreads();
    }
    if (helper) epilogue(nch - 1);
#pragma unroll
    for (int q = 0; q < 4; ++q) if (!helper) { *(f32x2*)(sfin + si * 64 + jb + 2 * q) = S0[q]; *(f32x2*)(sfin + (si + 1) * 64 + jb + 2 * q) = S1[q]; }
}

template <bool DUMMY> __device__ __forceinline__ void attn_prompt_item(const Params& p, LAS unsigned char* lds, int item) {
    const int tid = threadIdx.x, wid = tid >> 6, lane = tid & 63, fr = lane & 15, fq = lane >> 4; unsigned char* ws = p.ws;
    const int b = item >> 6, head = (item >> 4) & 3, qt = item & 15;
    bf16_t* Qp = (bf16_t*)(ws + WS_Y3) + (size_t)2 * MT * 1024; const bf16_t* MKB = (const bf16_t*)(ws + WS_MKB); const bf16_t* MVT = (const bf16_t*)(ws + WS_MVT);
    const int qrow = b * 2048 + qt * 128 + wid * 16;
    bf16x8 qf[8];
#pragma unroll
    for (int ks = 0; ks < 8; ++ks) qf[ks] = *(const bf16x8*)(Qp + (size_t)(qrow + fr) * 1024 + head * 256 + ks * 32 + fq * 8);
#pragma unroll 1
    for (int rnd = 0; rnd < 2; ++rnd) { u32x4 kv[8];
#pragma unroll
      for (int it = 0; it < 8; ++it) { const int idx = (rnd * 8 + it) * 512 + tid, row = idx >> 5, c = idx & 31; kv[it] = *(const u32x4*)(MKB + (size_t)(b * 256 + row) * 1024 + head * 256 + c * 8); }
#pragma unroll
      for (int it = 0; it < 8; ++it) { const int idx = (rnd * 8 + it) * 512 + tid, row = idx >> 5, c = idx & 31; *(LAS u32x4*)(lds + (row * 32 + (c ^ (row & 15))) * 16) = kv[it]; } }
    __syncthreads();
    u32x4 pf[8];
    { f32x4 s[16];
      int koff[8];
#pragma unroll
      for (int ks = 0; ks < 8; ++ks) koff[ks] = (fr * 32 + ((ks * 4 + fq) ^ fr)) * 16;
#pragma unroll
      for (int nt = 0; nt < 16; ++nt) { f32x4 acc = {0.f, 0.f, 0.f, 0.f};
#pragma unroll
          for (int ks = 0; ks < 8; ++ks) { const bf16x8 kf = *(const LAS bf16x8*)(lds + nt * 8192 + koff[ks]); acc = mfma16(kf, qf[ks], acc); }
          s[nt] = acc; }
      float mx = -3.0e38f;
#pragma unroll
      for (int nt = 0; nt < 16; ++nt) mx = fmaxf(fmaxf(fmaxf(s[nt][0], s[nt][1]), fmaxf(s[nt][2], s[nt][3])), mx);
      mx = fmaxf(mx, __shfl_xor(mx, 16)); mx = fmaxf(mx, __shfl_xor(mx, 32));
      float sum = 0.f;
#pragma unroll
      for (int nt = 0; nt < 16; ++nt)
#pragma unroll
          for (int q = 0; q < 4; ++q) { const float e = __expf((s[nt][q] - mx) * 0.0625f); s[nt][q] = e; sum += e; }
      sum += __shfl_xor(sum, 16); sum += __shfl_xor(sum, 32); const float inv = rcpf(sum);
#pragma unroll
      for (int ks = 0; ks < 8; ++ks) { pf[ks][0] = pk2(s[2 * ks][0] * inv, s[2 * ks][1] * inv); pf[ks][1] = pk2(s[2 * ks][2] * inv, s[2 * ks][3] * inv);
          pf[ks][2] = pk2(s[2 * ks + 1][0] * inv, s[2 * ks + 1][1] * inv); pf[ks][3] = pk2(s[2 * ks + 1][2] * inv, s[2 * ks + 1][3] * inv); } }
    __syncthreads();
#pragma unroll 1
    for (int rnd = 0; rnd < 2; ++rnd) { u32x4 kv[8];
#pragma unroll
      for (int it = 0; it < 8; ++it) { const int idx = (rnd * 8 + it) * 512 + tid, row = idx >> 5, c = idx & 31; kv[it] = *(const u32x4*)(MVT + ((size_t)((b * 4 + head) * 256 + row)) * 256 + c * 8); }
#pragma unroll
      for (int it = 0; it < 8; ++it) { const int idx = (rnd * 8 + it) * 512 + tid, row = idx >> 5, c = idx & 31; *(LAS u32x4*)(lds + (row * 32 + (c ^ (row & 15))) * 16) = kv[it]; } }
    __syncthreads();
    { int voff[8][2];
#pragma unroll
      for (int ks = 0; ks < 8; ++ks) { const int c1 = ks * 4 + (fq >> 1); voff[ks][0] = (fr * 32 + (c1 ^ fr)) * 16 + (fq & 1) * 8; voff[ks][1] = (fr * 32 + ((c1 + 2) ^ fr)) * 16 + (fq & 1) * 8; }
#pragma unroll 2
      for (int dt = 0; dt < 16; ++dt) { f32x4 acc = {0.f, 0.f, 0.f, 0.f};
#pragma unroll
          for (int ks = 0; ks < 8; ++ks) { const u32x2 lo = *(const LAS u32x2*)(lds + dt * 8192 + voff[ks][0]), hi = *(const LAS u32x2*)(lds + dt * 8192 + voff[ks][1]);
              u32x4 vv; vv[0] = lo[0]; vv[1] = lo[1]; vv[2] = hi[0]; vv[3] = hi[1]; acc = mfma16(__builtin_bit_cast(bf16x8, vv), __builtin_bit_cast(bf16x8, pf[ks]), acc); }
          u32x2 w; w[0] = pk2(acc[0], acc[1]); w[1] = pk2(acc[2], acc[3]);
          bf16_t* o = Qp + (size_t)(qrow + fr) * 1024 + head * 256 + dt * 16 + 4 * fq;
          if (!DUMMY) *(u32x2*)o = w; else if (w[0] == 0x12345678u) Qp[0] = 0; } }
    __syncthreads();
}

template <bool DUMMY> __device__ __forceinline__ void attn_sample_item(const Params& p, LAS unsigned char* lds, int item) {
    const int tid = threadIdx.x, wid = tid >> 6, lane = tid & 63, l16 = lane & 15, rg = lane >> 4; unsigned char* ws = p.ws;
    const int b = item >> 2, head = item & 3;
    bf16_t* Qp = (bf16_t*)(ws + WS_Y3) + (size_t)2 * MT * 1024 + (size_t)(MP + 4 * b) * 1024 + head * 256;
    const float* Kp = p.in[I_CK] + ((size_t)b * 256 * 4 + head) * 256; const float* Vp = p.in[I_CV] + ((size_t)b * 256 * 4 + head) * 256;
    LAS float* sc = (LAS float*)lds; LAS float* pr = (LAS float*)(lds + 4096); LAS float* part = (LAS float*)(lds + 8192);
    float qv[4][4][4];
#pragma unroll
    for (int t = 0; t < 4; ++t)
#pragma unroll
        for (int c = 0; c < 4; ++c) { const u32x2 q = *(const u32x2*)(Qp + t * 1024 + 64 * c + 4 * l16); unpack4(q, qv[t][c]); }
#pragma unroll 2
    for (int it = 0; it < 8; ++it) { const int mrow = wid * 32 + it * 4 + rg; const float* kr = Kp + (size_t)mrow * 1024 + 4 * l16; float d[4] = {0.f, 0.f, 0.f, 0.f};
#pragma unroll
        for (int c = 0; c < 4; ++c) { const f32x4 kv = *(const f32x4*)(kr + 64 * c);
#pragma unroll
            for (int t = 0; t < 4; ++t) d[t] += kv[0] * qv[t][c][0] + kv[1] * qv[t][c][1] + kv[2] * qv[t][c][2] + kv[3] * qv[t][c][3]; }
#pragma unroll
        for (int t = 0; t < 4; ++t) { const float r = red16(d[t]); if (l16 == 0) sc[t * 256 + mrow] = r * 0.0625f; } }
    __syncthreads();
    if (wid < 4) { const f32x4 x = *(const LAS f32x4*)(sc + wid * 256 + lane * 4); float mx = fmaxf(fmaxf(x[0], x[1]), fmaxf(x[2], x[3])); mx = wave_max(mx);
        float e[4], sum = 0.f;
#pragma unroll
        for (int q = 0; q < 4; ++q) { e[q] = __expf(x[q] - mx); sum += e[q]; }
        sum = wave_sum(sum); const float inv = rcpf(sum);
#pragma unroll
        for (int q = 0; q < 4; ++q) pr[(lane * 4 + q) * 4 + wid] = e[q] * inv; }
    __syncthreads();
    { f32x4 acc[4];
#pragma unroll
      for (int t = 0; t < 4; ++t) acc[t] = (f32x4){0.f, 0.f, 0.f, 0.f};
#pragma unroll 8
      for (int it = 0; it < 32; ++it) { const int mrow = wid * 32 + it; const f32x4 vv = *(const f32x4*)(Vp + (size_t)mrow * 1024 + lane * 4); const f32x4 pp = *(const LAS f32x4*)(pr + mrow * 4);
#pragma unroll
          for (int t = 0; t < 4; ++t) acc[t] += pp[t] * vv; }
#pragma unroll
      for (int t = 0; t < 4; ++t) *(LAS f32x4*)(part + (wid * 4 + t) * 256 + lane * 4) = acc[t]; }
    __syncthreads();
    { const int o = tid * 2, t = o >> 8, d = o & 255; float a0 = 0.f, a1 = 0.f;
#pragma unroll
      for (int w = 0; w < 8; ++w) { const f32x2 v = *(const LAS f32x2*)(part + (w * 4 + t) * 256 + d); a0 += v[0]; a1 += v[1]; }
      const unsigned wv = pk2(a0, a1); if (!DUMMY) *(unsigned*)(Qp + t * 1024 + d) = wv; else if (wv == 0x12345678u) Qp[0] = 0; }
    __syncthreads();
}

template <bool DUMMY> __device__ __forceinline__ void sg_prompt_item(const Params& p, LAS unsigned char* lds, int item) {
    const int tid = threadIdx.x, wid = tid >> 6, lane = tid & 63, fr = lane & 15, fq = lane >> 4; unsigned char* ws = p.ws;
    const int chn = item >> 3, g = item & 7, m0 = chn * 128;
    const bf16_t* VN = (const bf16_t*)(ws + WS_GV); const bf16_t* SGW = (const bf16_t*)(ws + WS_SGW) + g * 16384; bf16_t* U = (bf16_t*)(ws + WS_Y3);
    LAS bf16_t* VT = (LAS bf16_t*)lds;
    { const int s = tid >> 2, hq = (tid & 3) * 32; const bf16_t* src = VN + (size_t)(m0 + s) * 1024 + g * 128 + hq;
#pragma unroll
      for (int c = 0; c < 4; ++c) { const u32x4 q = *(const u32x4*)(src + c * 8);
#pragma unroll
          for (int k = 0; k < 4; ++k) { VT[(hq + c * 8 + 2 * k) * 136 + s] = (bf16_t)(q[k] & 0xffffu); VT[(hq + c * 8 + 2 * k + 1) * 136 + s] = (bf16_t)(q[k] >> 16); } } }
    const int h0 = wid * 16; bf16x8 xf[4];
    const float* sgb = p.in[I_SGB] + g * 128;
    bf16x8 yf[8][4]; u32x2 uq[8]; float bias[8];
#pragma unroll
    for (int mt = 0; mt < 8; ++mt) {
#pragma unroll
        for (int ks = 0; ks < 4; ++ks) if (32 * ks <= 16 * mt + 15) yf[mt][ks] = *(const bf16x8*)(SGW + (mt * 16 + fr) * 128 + ks * 32 + fq * 8);
        uq[mt] = *(const u32x2*)(U + (size_t)(m0 + mt * 16 + fr) * 1024 + g * 128 + h0 + 4 * fq); bias[mt] = sgb[mt * 16 + fr]; }
    __syncthreads();
#pragma unroll
    for (int ks = 0; ks < 4; ++ks) xf[ks] = *(const LAS bf16x8*)(VT + (h0 + fr) * 136 + ks * 32 + fq * 8);
#pragma unroll
    for (int mt = 0; mt < 8; ++mt) { f32x4 acc = {0.f, 0.f, 0.f, 0.f};
#pragma unroll
        for (int ks = 0; ks < 4; ++ks) if (32 * ks <= 16 * mt + 15) acc = mfma16(xf[ks], yf[mt][ks], acc);
        bf16_t* up = U + (size_t)(m0 + mt * 16 + fr) * 1024 + g * 128 + h0 + 4 * fq; float uf[4]; unpack4(uq[mt], uf);
        u32x2 w; w[0] = pk2(uf[0] * (acc[0] + bias[mt]), uf[1] * (acc[1] + bias[mt])); w[1] = pk2(uf[2] * (acc[2] + bias[mt]), uf[3] * (acc[3] + bias[mt])); if (!DUMMY) *(u32x2*)up = w; else if (w[0] == 0x12345678u) up[0] = 0; }
    __syncthreads();
}
__device__ __forceinline__ void sg_sample_item(const Params& p, int item) {
    const int tid = threadIdx.x; unsigned char* ws = p.ws; const bf16_t* VN = (const bf16_t*)(ws + WS_GV); bf16_t* U = (bf16_t*)(ws + WS_Y3);
    const float* sgw = p.in[I_SGW]; const float* sgb = p.in[I_SGB];
    for (int e = tid; e < 32 * 128; e += 512) { const int r = e >> 7, c8 = (e & 127) * 8; const int m = MP + item * 32 + r, t = r & 3, g = c8 >> 7; float a[8];
#pragma unroll
        for (int k = 0; k < 8; ++k) a[k] = sgb[g * 128 + t];
        for (int s = 0; s <= t; ++s) { const float w = sgw[(g * 128 + t) * 128 + s]; const u32x4 q = *(const u32x4*)(VN + (size_t)(m - t + s) * 1024 + c8);
#pragma unroll
            for (int k = 0; k < 4; ++k) { a[2 * k] += w * bflo(q[k]); a[2 * k + 1] += w * bfhi(q[k]); } }
        bf16_t* up = U + (size_t)m * 1024 + c8; const u32x4 uq = *(const u32x4*)up; u32x4 o;
#pragma unroll
        for (int k = 0; k < 4; ++k) o[k] = pk2(bflo(uq[k]) * a[2 * k], bfhi(uq[k]) * a[2 * k + 1]);
        *(u32x4*)up = o; }
}

constexpr int Q_SATT = 0, Q_PATT = 512, Q_SGP = 1024, Q_SGS = 2048, Q_SSCAN = 2064, Q_END = 2064 + 2048;

template <int PH, bool DUMMY = false> __device__ __forceinline__ void run_phase(const Params& p, LAS unsigned char* lds) {
    unsigned char* ws = p.ws; const int G = gridDim.x, bid = blockIdx.x;
    if constexpr (PH == 0) phase0(p, lds);
    else if constexpr (PH == 1) {
        { pg8::Gemm g{(const bf16_t*)(ws + WS_HMB), (const bf16_t*)(ws + WS_WTMKV), 2048, 2048, 1024}; pg8::StaticOrder S; S.init(2048, 2048, G, (bid + 64) % G);
          EpiMem E{p.out, (bf16_t*)(ws + WS_MKB), (bf16_t*)(ws + WS_MVT)}; pg8::gemm_phase<EpiMem, pg8::StaticOrder, false>(lds, g, S, E, nullptr); }
        __syncthreads();
        { pg8::Gemm g{(const bf16_t*)(ws + WS_HB), (const bf16_t*)(ws + WS_WTIN), MT, PIN, 1024}; pg8::StaticOrder S; S.init(MT, PIN, G, bid);
          EpiZ E{(bf16_t*)(ws + WS_Y3), (bf16_t*)(ws + WS_GV), (bf16_t*)(ws + WS_SZ), (bf16_t*)(ws + WS_Y3) + (size_t)2 * MT * 1024, (bf16_t*)(ws + WS_GT), p.out};
          pg8::gemm_phase<EpiZ, pg8::StaticOrder, false>(lds, g, S, E, nullptr); }
    }
    else if constexpr (PH == 2) { const int wid = threadIdx.x >> 6, lane = threadIdx.x & 63; for (int m = wid * G + bid; m < MT; m += 24 * G) { const int mr[3] = {m, m + 8 * G, m + 16 * G}; p2_rows<3, DUMMY>(p, mr, lane); } }
    else if constexpr (PH == 11) { int kk = 256; asm volatile("" : "+s"(kk));
        pg8::Gemm g{(const bf16_t*)(ws + WS_XL), (const bf16_t*)(ws + WS_WTLORA), MP, 3072, kk}; pg8::StaticOrder S; S.init(MP, 3072, G, bid);
        EpiLora E{(bf16_t*)(ws + WS_E), (bf16_t*)(ws + WS_AV), (bf16_t*)(ws + WS_GG), p.in[I_W0], p.in[I_A0]}; pg8::gemm_phase<EpiLora, pg8::StaticOrder, false>(lds, g, S, E, nullptr);
        bf16_t* Eb = (bf16_t*)(ws + WS_E); const float* w0 = p.in[I_W0]; const float* a0 = p.in[I_A0];
        thin_gemm<1>(lds, (const bf16_t*)(ws + WS_XL), 0, (const bf16_t*)(ws + WS_WTLORA), 0, 1, 3072, kk,
            [&](int, const f32x4 (&acc)[4], f32x4 (&tot)[4], int, int) {
#pragma unroll
                for (int j = 0; j < 4; ++j) tot[j] = acc[j]; },
            [&](const f32x4 (&tot)[4], int row, int col) { const int seg = col >> 10;
#pragma unroll
                for (int j = 0; j < 4; ++j) { const int cc = (col & 1023) + 16 * j; f32x4 v = tot[j];
                    if (seg == 0) { const f32x4 bq = *(const f32x4*)(w0 + cc);
#pragma unroll
                        for (int q = 0; q < 4; ++q) v[q] = 0.60653066f * sigmoidf_(v[q] + bq[q]); }
                    else if (seg == 1) { const f32x4 bq = *(const f32x4*)(a0 + cc);
#pragma unroll
                        for (int q = 0; q < 4; ++q) v[q] = sigmoidf_(v[q] + bq[q]); }
                    u32x2 w; w[0] = pk2(v[0], v[1]); w[1] = pk2(v[2], v[3]); *(u32x2*)(Eb + (size_t)seg * 17301504 + (size_t)row * 1024 + cc) = w; } }); }
    else if constexpr (PH == 3 || PH == 10) {
#ifndef P3SPLIT
#define P3SPLIT 0
#endif
#ifndef P3SUB
#define P3SUB 31
#endif
        constexpr int SUB = DUMMY ? P3SUB : 31;
        constexpr bool DO_SCAN = (PH == 3), DO_REST = P3SPLIT ? (PH == 10) : (PH == 3);
        if (DO_SCAN && (SUB & 1) && bid < 128) { const int b = bid >> 4, h = bid & 15; scan_head(p, lds, b * 2048, 2048, h, nullptr, p.out + O_PWKV + (size_t)bid * 4096, nullptr); }
        unsigned* ctr = (unsigned*)(ws + WS_CTL) + (PH == 10 ? 1 : 0) + (DUMMY ? 2 : 0); LAS unsigned* qw = (LAS unsigned*)(lds + QW_OFF);
        const int q_lo = DO_REST ? 0 : Q_SSCAN, q_hi = DO_SCAN ? Q_END : Q_SSCAN;
        unsigned nxt = 0; if (threadIdx.x == 0) nxt = atomicAdd(ctr, 1u);
        for (;;) {
            __syncthreads();
            if (threadIdx.x == 0) { *qw = nxt; nxt = atomicAdd(ctr, 1u); }
            __syncthreads();
            const int it = (int)*qw + q_lo; if (it >= q_hi) break;
            if (it < Q_PATT) { if (SUB & 2) attn_sample_item<DUMMY>(p, lds, it); }
            else if (it < Q_SGP) { if (SUB & 4) attn_prompt_item<DUMMY>(p, lds, it - Q_PATT); }
            else if (it < Q_SGS) { if (SUB & 8) sg_prompt_item<DUMMY>(p, lds, it - Q_SGP); }
            else if (it < Q_SSCAN) { if (!DUMMY) sg_sample_item(p, it - Q_SGS); }
            else if (SUB & 16) { const int bh = it - Q_SSCAN, b = bh >> 4, h = bh & 15;
                scan_head(p, lds, MP + b * 4, 4, h, p.in[I_SWKV] + (size_t)bh * 4096, p.out + O_SWKV + (size_t)bh * 4096, p.in[I_SSH] + (size_t)b * PSH); }
        }
    }
    else if constexpr (PH == 4) { pg8::Gemm g{(const bf16_t*)(ws + WS_Y3), (const bf16_t*)(ws + WS_WTBR), 3 * MT, 3072, 1024}; BranchOrder S{G, bid};
        EpiMerge E{(const bf16_t*)(ws + WS_GT), (bf16_t*)(ws + WS_MB)}; pg8::gemm_phase<EpiMerge, BranchOrder, false>(lds, g, S, E, nullptr);
        const bf16_t* GT = (const bf16_t*)(ws + WS_GT); bf16_t* MB = (bf16_t*)(ws + WS_MB);
        thin_gemm<4>(lds, (const bf16_t*)(ws + WS_Y3), (size_t)MT * 1024, (const bf16_t*)(ws + WS_WTBR), (size_t)1048576, 3, 1024, 1024,
            [&](int n, const f32x4 (&acc)[4], f32x4 (&tot)[4], int row, int col) {
#pragma unroll
                for (int j = 0; j < 4; ++j) { float gf[4]; unpack4(*(const u32x2*)(GT + (size_t)row * 3072 + n * 1024 + col + 16 * j), gf);
                    tot[j][0] += acc[j][0] * gf[0]; tot[j][1] += acc[j][1] * gf[1]; tot[j][2] += acc[j][2] * gf[2]; tot[j][3] += acc[j][3] * gf[3]; } },
            [&](const f32x4 (&tot)[4], int row, int col) {
#pragma unroll
                for (int j = 0; j < 4; ++j) { u32x2 w; w[0] = pk2(tot[j][0], tot[j][1]); w[1] = pk2(tot[j][2], tot[j][3]); *(u32x2*)(MB + (size_t)row * 1024 + col + 16 * j) = w; } }); }
    else if constexpr (PH == 5) { pg8::Gemm g{(const bf16_t*)(ws + WS_MB), (const bf16_t*)(ws + WS_WTOUT), MP, 1024, 1024}; pg8::StaticOrder S; S.init(MP, 1024, G, bid);
        EpiRes E{p.in[I_XP], p.in[I_XS], (float*)(ws + WS_X1), (bf16_t*)(ws + WS_X1B), (float*)(ws + (DUMMY ? WS_XL : WS_SSQ1))}; pg8::gemm_phase<EpiRes, pg8::StaticOrder, false>(lds, g, S, E, nullptr);
        const float* xs = p.in[I_XS]; float* X1 = (float*)(ws + WS_X1); bf16_t* X1B = (bf16_t*)(ws + WS_X1B); float* ssq = (float*)(ws + (DUMMY ? WS_XL : WS_SSQ1));
        thin_gemm<4>(lds, (const bf16_t*)(ws + WS_MB), 0, (const bf16_t*)(ws + WS_WTOUT), 0, 1, 1024, 1024,
            [&](int, const f32x4 (&acc)[4], f32x4 (&tot)[4], int, int) {
#pragma unroll
                for (int j = 0; j < 4; ++j) tot[j] = acc[j]; },
            [&](const f32x4 (&tot)[4], int row, int col) { float ss = 0.f;
#pragma unroll
                for (int j = 0; j < 4; ++j) { const f32x4 v = tot[j] + *(const f32x4*)(xs + (size_t)(row - MP) * 1024 + col + 16 * j); *(f32x4*)(X1 + (size_t)row * 1024 + col + 16 * j) = v;
                    u32x2 w; w[0] = pk2(v[0], v[1]); w[1] = pk2(v[2], v[3]); *(u32x2*)(X1B + (size_t)row * 1024 + col + 16 * j) = w; ss += v[0] * v[0] + v[1] * v[1] + v[2] * v[2] + v[3] * v[3]; }
                ss += __shfl_xor(ss, 16); ss += __shfl_xor(ss, 32); if ((threadIdx.x & 63) < 16) atomicAdd(ssq + row, ss); }); }
    else if constexpr (PH == 6) { pg8::Gemm g{(const bf16_t*)(ws + WS_X1B), (const bf16_t*)(ws + WS_WTUP), MP, DFF, 1024}; pg8::StaticOrder S; S.init(MP, DFF, G, bid);
        EpiUp E{(const float*)(ws + WS_SSQ1), (bf16_t*)(ws + WS_HID)}; pg8::gemm_phase<EpiUp, pg8::StaticOrder, false>(lds, g, S, E, nullptr);
        const float* ssq = (const float*)(ws + WS_SSQ1); bf16_t* H = (bf16_t*)(ws + WS_HID);
        thin_gemm<1>(lds, (const bf16_t*)(ws + WS_X1B), 0, (const bf16_t*)(ws + WS_WTUP), 0, 1, DFF, 1024,
            [&](int, const f32x4 (&acc)[4], f32x4 (&tot)[4], int, int) {
#pragma unroll
                for (int j = 0; j < 4; ++j) tot[j] = acc[j]; },
            [&](const f32x4 (&tot)[4], int row, int col) { const float rs = rsqrtf(ssq[row] * (1.f / 1024.f) + 1e-6f);
#pragma unroll
                for (int j = 0; j < 4; ++j) { float h[4];
#pragma unroll
                    for (int q = 0; q < 4; ++q) { const float a = fmaxf(tot[j][q] * rs, 0.f); h[q] = a * a; }
                    u32x2 w; w[0] = pk2(h[0], h[1]); w[1] = pk2(h[2], h[3]); *(u32x2*)(H + (size_t)row * DFF + col + 16 * j) = w; } }); }
    else if constexpr (PH == 7) { pg8::Gemm g{(const bf16_t*)(ws + WS_HID), (const bf16_t*)(ws + WS_WTDN), MP, 1024, DFF}; pg8::StaticOrder S; S.init(MP, 1024, G, bid);
        const float* x1 = (const float*)(ws + WS_X1);
        EpiRes E{x1, x1 + (size_t)MP * 1024, (float*)(ws + WS_X2), nullptr, (float*)(ws + (DUMMY ? WS_XL : WS_SSQ2))}; pg8::gemm_phase<EpiRes, pg8::StaticOrder, false>(lds, g, S, E, nullptr);
        float* X2 = (float*)(ws + WS_X2); float* ssq = (float*)(ws + (DUMMY ? WS_XL : WS_SSQ2));
        thin_gemm<4>(lds, (const bf16_t*)(ws + WS_HID), 0, (const bf16_t*)(ws + WS_WTDN), 0, 1, 1024, DFF,
            [&](int, const f32x4 (&acc)[4], f32x4 (&tot)[4], int, int) {
#pragma unroll
                for (int j = 0; j < 4; ++j) tot[j] = acc[j]; },
            [&](const f32x4 (&tot)[4], int row, int col) { float ss = 0.f;
#pragma unroll
                for (int j = 0; j < 4; ++j) { const f32x4 v = tot[j] + *(const f32x4*)(x1 + (size_t)row * 1024 + col + 16 * j); *(f32x4*)(X2 + (size_t)row * 1024 + col + 16 * j) = v;
                    ss += v[0] * v[0] + v[1] * v[1] + v[2] * v[2] + v[3] * v[3]; }
                ss += __shfl_xor(ss, 16); ss += __shfl_xor(ss, 32); if ((threadIdx.x & 63) < 16) atomicAdd(ssq + row, ss); }); }
    else if constexpr (PH == 8) { const float* x2 = (const float*)(ws + WS_X2); const float* ssq = (const float*)(ws + WS_SSQ2); const float* gf = p.in[I_NFG];
        const int wid = threadIdx.x >> 6, lane = threadIdx.x & 63;
        for (int r = bid * 8 + wid; r < MT; r += G * 8) { const float rs = rsqrtf(ssq[r] * (1.f / 1024.f) + 1e-6f);
#pragma unroll
            for (int c = 0; c < 4; ++c) { const int col = c * 256 + lane * 4; const f32x4 v = *(const f32x4*)(x2 + (size_t)r * 1024 + col), g = *(const f32x4*)(gf + col);
                *(f32x4*)(p.out + (size_t)r * 1024 + col) = v * rs * g; } } }
}
#ifdef DIAG_PHASES
template <int PH> __global__ __launch_bounds__(512, 2) void diag_phase(Params p) {
    extern __shared__ __attribute__((aligned(16))) unsigned char shm[];
    run_phase<PH>(p, (LAS unsigned char*)shm);
}
template __global__ void diag_phase<0>(Params); template __global__ void diag_phase<1>(Params); template __global__ void diag_phase<2>(Params);
template __global__ void diag_phase<3>(Params); template __global__ void diag_phase<4>(Params); template __global__ void diag_phase<5>(Params);
template __global__ void diag_phase<6>(Params); template __global__ void diag_phase<7>(Params); template __global__ void diag_phase<8>(Params);
#endif
template <int PH, bool DUMMY = false> __device__ __forceinline__ void phase_step(int ph_lo, int ph_hi, LAS unsigned char* lds, cg::grid_group& grid, unsigned& nbar) {
    constexpr int PE = (PH == 10) ? 3 : (PH == 11 ? 2 : PH);
    if (ph_lo <= PE && PE < ph_hi) {
        if (PH > ph_lo) {
            asm volatile("s_waitcnt vmcnt(0)" ::: "memory");
            __syncthreads();
            ++nbar;
            if (threadIdx.x == 0) {
                const __attribute__((address_space(4))) Params* pq = (const __attribute__((address_space(4))) Params*)__builtin_amdgcn_kernarg_segment_ptr();
                __attribute__((address_space(1))) unsigned char* wsb = (__attribute__((address_space(1))) unsigned char*)pq->ws;
                if (nbar == 1) {
                    __attribute__((address_space(1))) unsigned* bar = (__attribute__((address_space(1))) unsigned*)(wsb + WS_CTL + 128);
                    __builtin_amdgcn_fence(__ATOMIC_RELEASE, "agent"); asm volatile("s_waitcnt vmcnt(0)" ::: "memory");
                    __hip_atomic_fetch_add(bar, 1u, __ATOMIC_RELAXED, __HIP_MEMORY_SCOPE_AGENT);
                    while (__hip_atomic_load(bar, __ATOMIC_RELAXED, __HIP_MEMORY_SCOPE_AGENT) < gridDim.x) __builtin_amdgcn_s_sleep(2);
                    __builtin_amdgcn_fence(__ATOMIC_ACQUIRE, "agent"); asm volatile("s_waitcnt vmcnt(0)" ::: "memory");
                } else {
                    __attribute__((address_space(1))) unsigned* c2 = (__attribute__((address_space(1))) unsigned*)(wsb + WS_CTL2);
                    const unsigned xcc = (unsigned)__builtin_amdgcn_s_getreg((3 << 11) | 20) & 0xFu;
                    const unsigned nx = __hip_atomic_load(c2 + 1024 + xcc, __ATOMIC_RELAXED, __HIP_MEMORY_SCOPE_AGENT);
                    unsigned nxcc = 0;
                    for (int j = 0; j < 16; ++j) nxcc += __hip_atomic_load(c2 + 1024 + j, __ATOMIC_RELAXED, __HIP_MEMORY_SCOPE_AGENT) != 0u;
                    const unsigned k = nbar - 1;
                    const unsigned old = __hip_atomic_fetch_add(c2 + 64 * xcc, 1u, __ATOMIC_RELAXED, __HIP_MEMORY_SCOPE_AGENT);
                    if (old + 1 == k * nx) {
                        __builtin_amdgcn_fence(__ATOMIC_RELEASE, "agent"); asm volatile("s_waitcnt vmcnt(0)" ::: "memory");
                        const unsigned t = __hip_atomic_fetch_add(c2 + 1088, 1u, __ATOMIC_RELAXED, __HIP_MEMORY_SCOPE_AGENT);
                        if (t + 1 == k * nxcc) __hip_atomic_store(c2 + 1152, k, __ATOMIC_RELAXED, __HIP_MEMORY_SCOPE_AGENT);
                    }
                    while (__hip_atomic_load(c2 + 1152, __ATOMIC_RELAXED, __HIP_MEMORY_SCOPE_AGENT) < k) __builtin_amdgcn_s_sleep(1);
                    __builtin_amdgcn_fence(__ATOMIC_ACQUIRE, "agent"); asm volatile("s_waitcnt vmcnt(0)" ::: "memory");
                }
            }
            __syncthreads();
        }
        const __attribute__((address_space(4))) Params* pp = (const __attribute__((address_space(4))) Params*)__builtin_amdgcn_kernarg_segment_ptr();
        asm volatile("" : "+s"(pp) :: "memory");
        Params p;
#pragma unroll
        for (int i = 0; i < 33; ++i) p.in[i] = (const float*)(__attribute__((address_space(1))) const float*)pp->in[i];
        p.out = (float*)(__attribute__((address_space(1))) float*)pp->out; p.ws = (unsigned char*)(__attribute__((address_space(1))) unsigned char*)pp->ws;
        run_phase<PH, DUMMY>(p, lds);
    }
}
template <> __device__ __forceinline__ void run_phase<9, false>(const Params& p, LAS unsigned char* lds) {
    unsigned char* ws = p.ws; const int G = gridDim.x, bid = blockIdx.x; const int wid = threadIdx.x >> 6, lane = threadIdx.x & 63;
    for (int r = bid * 8 + wid; r < MT; r += G * 8) {
#pragma unroll
        for (int c = 0; c < 4; ++c) { const int col = c * 256 + lane * 4; f32x4 o;
#if DBG == 1
            const bf16_t* y3 = (const bf16_t*)(ws + WS_Y3); float a[4], b[4], d[4];
            unpack4(*(const u32x2*)(y3 + (size_t)r * 1024 + col), a); unpack4(*(const u32x2*)(y3 + (size_t)(MT + r) * 1024 + col), b); unpack4(*(const u32x2*)(y3 + (size_t)(2 * MT + r) * 1024 + col), d);
            for (int q = 0; q < 4; ++q) o[q] = a[q] + 2.f * b[q] + 4.f * d[q];
#elif DBG == 2
            float a[4]; unpack4(*(const u32x2*)((const bf16_t*)(ws + WS_MB) + (size_t)r * 1024 + col), a); for (int q = 0; q < 4; ++q) o[q] = a[q];
#elif DBG == 3
            o = *(const f32x4*)((const float*)(ws + WS_X1) + (size_t)r * 1024 + col);
#elif DBG == 4
            float a[4], b[4]; unpack4(*(const u32x2*)((const bf16_t*)(ws + WS_HID) + (size_t)r * DFF + col), a); unpack4(*(const u32x2*)((const bf16_t*)(ws + WS_HID) + (size_t)r * DFF + 2048 + col), b); for (int q = 0; q < 4; ++q) o[q] = a[q] + b[q];
#elif DBG == 5
            const bf16_t* y3 = (const bf16_t*)(ws + WS_Y3) + (size_t)(DBGSEL * MT + r) * 1024 + col; float a[4]; unpack4(*(const u32x2*)y3, a); for (int q = 0; q < 4; ++q) o[q] = a[q];
#else
            o = (f32x4){0.f, 0.f, 0.f, 0.f};
#endif
            *(f32x4*)(p.out + (size_t)r * 1024 + col) = o; } }
}
__global__ __launch_bounds__(512, 2) void mega(Params p, int ph_lo, int ph_hi) {
    extern __shared__ __attribute__((aligned(16))) unsigned char shm[];
    LAS unsigned char* lds = (LAS unsigned char*)shm;
    cg::grid_group grid = cg::this_grid();
#ifndef DUP
#define DUP -1
#endif
    unsigned nbar = 0;
    { const __attribute__((address_space(4))) Params* pq = (const __attribute__((address_space(4))) Params*)__builtin_amdgcn_kernarg_segment_ptr();
      __attribute__((address_space(1))) unsigned char* wsb = (__attribute__((address_space(1))) unsigned char*)pq->ws;
      if (ph_lo < 0) grid.sync();
      if (threadIdx.x == 0) { const unsigned xcc = (unsigned)__builtin_amdgcn_s_getreg((3 << 11) | 20) & 0xFu;
          __hip_atomic_fetch_add((__attribute__((address_space(1))) unsigned*)(wsb + WS_CTL2) + 1024 + xcc, 1u, __ATOMIC_RELAXED, __HIP_MEMORY_SCOPE_AGENT); } }
#define PSTEP(k) if (DUP == k) phase_step<k, true>(ph_lo, ph_hi, lds, grid, nbar); phase_step<k, false>(ph_lo, ph_hi, lds, grid, nbar);
    PSTEP(0) PSTEP(1) PSTEP(2) PSTEP(11) PSTEP(3)
#if P3SPLIT
    PSTEP(10)
#endif
    PSTEP(4) PSTEP(5) PSTEP(6) PSTEP(7) PSTEP(8)
#if DBG
    phase_step<9>(ph_lo, 10, lds, grid, nbar);
#endif
}

extern "C" void kernel_launch(void* const* d_in, const int* in_sizes, int n_in, void* d_out, int out_size, void* d_ws, size_t ws_size, hipStream_t stream) {
    static int grid_blocks = 0;
    if (grid_blocks == 0) {
        if (n_in != 33 || out_size != (int)O_END || ws_size < WS_END) { fprintf(stderr, "kernel_launch: unexpected shapes (n_in %d out %d ws %zu, need ws %zu)\n", n_in, out_size, ws_size, (size_t)WS_END); grid_blocks = -1; return; }
        int dev = 0, cus = 0, per_cu = 0;
        hipGetDevice(&dev); hipDeviceGetAttribute(&cus, hipDeviceAttributeMultiprocessorCount, dev);
        hipFuncSetAttribute((const void*)mega, hipFuncAttributeMaxDynamicSharedMemorySize, LDS_BYTES);
        hipOccupancyMaxActiveBlocksPerMultiprocessor(&per_cu, (const void*)mega, 512, LDS_BYTES);
        if (per_cu < 1) { fprintf(stderr, "kernel_launch: occupancy query says %d blocks per CU\n", per_cu); grid_blocks = -1; return; }
        grid_blocks = cus * 1;
        if (grid_blocks < 256) { fprintf(stderr, "kernel_launch: needs >= 256 CUs (the branch-merge phase keeps one 256x256 tile per workgroup in its accumulators)\n"); grid_blocks = -1; return; }
    }
    if (grid_blocks < 0) return;
    hipMemsetAsync((char*)d_ws + WS_CTL, 0, WS_WTIN - WS_CTL, stream);
    Params p{};
    for (int i = 0; i < 33; ++i) p.in[i] = (const float*)d_in[i];
    p.out = (float*)d_out; p.ws = (unsigned char*)d_ws;
#if DBG
    int lo = 0, hi = DBG_HI;
#else
    int lo = 0, hi = 9;
#endif
    void* args[] = {&p, &lo, &hi};
    hipError_t e = hipLaunchCooperativeKernel((const void*)mega, dim3(grid_blocks), dim3(512), args, LDS_BYTES, stream);
    if (e != hipSuccess) fprintf(stderr, "cooperative launch failed: %s (grid %d)\n", hipGetErrorString(e), grid_blocks);
}
```

```cpp
#include <hip/hip_runtime.h>
#include <hip/hip_cooperative_groups.h>
#include <cstdio>
namespace cg = cooperative_groups;
namespace pg8 {
#define PG8_LAS __attribute__((address_space(3)))
typedef unsigned short bf16_t;
typedef short bf16x8 __attribute__((ext_vector_type(8)));
typedef float f32x4 __attribute__((ext_vector_type(4)));
typedef unsigned u32x4 __attribute__((ext_vector_type(4)));
constexpr int BM = 256, BK = 64, HALF = 128, HTB = HALF * BK * 2  , STAGE_BYTES = 8 * HTB, NXCD = 8, WGM = 8;

__host__ __device__ __forceinline__ int lds_byte(int r, int c) { const int st = (r >> 4) * 2 + (c >> 5), rr = r & 15, cc = c & 31, ob = rr * 64 + cc * 2; return st * 1024 + (ob ^ (((ob >> 9) & 1) << 5)); }
__host__ __device__ __forceinline__ void stage_rc(int b, int& R, int& C) { const int st = b / 1024, sb = b % 1024, swz = sb ^ (((sb >> 9) & 1) << 5); R = (st >> 1) * 16 + swz / 64; C = (st & 1) * 32 + (swz % 64) / 2; }
__host__ __device__ __forceinline__ int perm32(int rho) { const int n = rho >> 4, i = rho & 15; return 8 * (i >> 2) + 4 * n + (i & 3); }

struct Unit { int pm, pn; };
struct Gemm { const bf16_t* A; const bf16_t* Bt; int M, N, K; };

struct StaticOrder {
    int nM, nN, nwg, G, c;
    __host__ __device__ void init(int M, int N, int G_, int c_) { nM = M / BM; nN = N / BM; nwg = nM * nN; G = G_; c = c_; }
    __host__ __device__ bool next(int i, Unit& u) const {
        const long L = (long)i * G + c; if (L >= nwg) return false;
        int wgid = (int)L; { const int q = nwg / NXCD, r = nwg % NXCD, xcd = wgid % NXCD, off = wgid / NXCD; wgid = (xcd < r ? xcd * (q + 1) : r * (q + 1) + (xcd - r) * q) + off; }
        const int nig = WGM * nN, gid = wgid / nig, fm = gid * WGM, gsz = (nM - fm) < WGM ? (nM - fm) : WGM;
        u.pm = fm + ((wgid % nig) % gsz); u.pn = (wgid % nig) / gsz; return true;
    }
    __device__ __forceinline__ void a_ready(const Unit&) const {}
    __device__ __forceinline__ void done(const Unit&) const {}
};
__device__ __forceinline__ unsigned cvt_pk_bf16(float lo, float hi) { unsigned r; asm volatile("v_cvt_pk_bf16_f32 %0, %1, %2" : "=v"(r) : "v"(lo), "v"(hi)); return r; }
template <class Epi, class Sched, bool STAMP = false>
__device__ __forceinline__ void gemm_phase(PG8_LAS unsigned char* lds, const Gemm g, const Sched& S, const Epi& E, unsigned long long* stamps) {
    const int tid = threadIdx.x, wid = __builtin_amdgcn_readfirstlane(tid >> 6), lane = tid & 63, wr = wid >> 2, wc = wid & 3, fr = lane & 15, fq = lane >> 4;
    const int K = g.K, nt = K / BK;
    int ts_lo = 0, ts_hi = 0, nts = 0; const unsigned long long rt_entry = STAMP ? (unsigned long long)wall_clock64() : 0ull;
#define PG8_STAMP() do { if (STAMP && wid == 0 && nts < 64) { const unsigned long long _c = (unsigned long long)clock64(); \
        ts_lo = (lane == nts) ? (int)(unsigned)_c : ts_lo; ts_hi = (lane == nts) ? (int)(unsigned)(_c >> 32) : ts_hi; ++nts; } } while (0)
    PG8_STAMP();
    unsigned voffA[2], voffB[2];
#pragma unroll
    for (int i = 0; i < 2; ++i) { int R, C; stage_rc(tid * 16 + i * 8192, R, C); const int Rb = Epi::PERM ? ((R & ~31) + perm32(R & 31)) : R;
        voffA[i] = (unsigned)(R * K + C) * 2u; voffB[i] = (unsigned)(Rb * K + C) * 2u; }
    const size_t kstep = (size_t)(BK * 2);
    const size_t hstep = (size_t)HALF * K * 2;
    const size_t tstep = 2 * hstep;
    const unsigned ldsw = (unsigned)wid * 1024u;
    const int aoff = lds_byte(wr * 64 + fr, fq * 8), boff = lds_byte(wc * 32 + fr, fq * 8);
#define PG8_SA(b, h) (((b) * 2 + (h)) * HTB)
#define PG8_SB(b, h) ((4 + (b) * 2 + (h)) * HTB)
#define PG8_STAGE(bufoff, gbase, voff) do { _Pragma("unroll") for (int _i = 0; _i < 2; ++_i) \
        __builtin_amdgcn_global_load_lds((const unsigned*)((const char*)(gbase) + (voff)[_i]), (PG8_LAS unsigned*)(lds + (bufoff) + ldsw + _i * 8192), 16, 0, 0); } while (0)
#define PG8_LDA(dst, b, h) do { _Pragma("unroll") for (int m = 0; m < 4; ++m) _Pragma("unroll") for (int k = 0; k < 2; ++k) dst[m][k] = *(const PG8_LAS bf16x8*)(lds + PG8_SA(b, h) + aoff + m * 2048 + k * 1024); } while (0)
#define PG8_LDB(dst, b, h) do { _Pragma("unroll") for (int n = 0; n < 2; ++n) _Pragma("unroll") for (int k = 0; k < 2; ++k) dst[n][k] = *(const PG8_LAS bf16x8*)(lds + PG8_SB(b, h) + boff + n * 2048 + k * 1024); } while (0)
#define PG8_MMA(ai, bj, At, Bt) do { __builtin_amdgcn_s_setprio(1); _Pragma("unroll") for (int m = 0; m < 4; ++m) _Pragma("unroll") for (int n = 0; n < 2; ++n) _Pragma("unroll") for (int k = 0; k < 2; ++k) \
        acc[ai][bj][m][n] = __builtin_amdgcn_mfma_f32_16x16x32_bf16(Bt[n][k], At[m][k], acc[ai][bj][m][n], 0, 0, 0); __builtin_amdgcn_s_setprio(0); } while (0)
#define PG8_WAIT_V(n) asm volatile("s_waitcnt vmcnt(" #n ")" ::: "memory")
#define PG8_WAIT_L(n) asm volatile("s_waitcnt lgkmcnt(" #n ")" ::: "memory")
#define PG8_BAR __builtin_amdgcn_s_barrier()
#define PG8_SCHED __builtin_amdgcn_sched_barrier(0)
    Unit cur, nxt; int ui = 0;
    if (!S.next(0, cur)) return;
    f32x4 acc[2][2][4][2];
#pragma unroll
    for (int a = 0; a < 2; ++a)
#pragma unroll
        for (int b = 0; b < 2; ++b)
#pragma unroll
            for (int m = 0; m < 4; ++m)
#pragma unroll
                for (int n = 0; n < 2; ++n) acc[a][b][m][n] = (f32x4){0.f, 0.f, 0.f, 0.f};
    bf16x8 At[4][2], B0[2][2], B1[2][2];
    const char* cA = (const char*)g.A + (size_t)cur.pm * tstep; const char* cB = (const char*)g.Bt + (size_t)cur.pn * tstep;
    S.a_ready(cur);
    PG8_STAGE(PG8_SB(0, 0), cB, voffB); PG8_STAGE(PG8_SA(0, 0), cA, voffA); PG8_STAGE(PG8_SB(0, 1), cB + hstep, voffB); PG8_STAGE(PG8_SA(0, 1), cA + hstep, voffA);
    if (wr == 1) PG8_BAR;
    PG8_WAIT_V(4); PG8_BAR;
    PG8_STAGE(PG8_SB(1, 0), cB + kstep, voffB); PG8_STAGE(PG8_SA(1, 0), cA + kstep, voffA); PG8_STAGE(PG8_SB(1, 1), cB + hstep + kstep, voffB);
    PG8_WAIT_V(6); PG8_BAR;
    PG8_STAMP();
    for (;;) {
        const bool has_next = S.next(ui + 1, nxt);
        const char* nA = has_next ? (const char*)g.A + (size_t)nxt.pm * tstep : cA; const char* nB = has_next ? (const char*)g.Bt + (size_t)nxt.pn * tstep : cB;
        for (int t = 0; t < nt; t += 2) {
            const bool last = (t == nt - 2);
            const char* a1 = cA + (size_t)(t + 1) * kstep;
            const char* a2 = last ? nA : cA + (size_t)(t + 2) * kstep; const char* b2 = last ? nB : cB + (size_t)(t + 2) * kstep;
            const char* a3 = a2 + kstep; const char* b3 = b2 + kstep;
            if (last && has_next) S.a_ready(nxt);
            PG8_LDB(B0, 0, 0); PG8_SCHED; PG8_LDA(At, 0, 0); PG8_STAGE(PG8_SA(1, 1), a1 + hstep, voffA);
            PG8_WAIT_L(8); PG8_BAR; PG8_WAIT_L(0); PG8_MMA(0, 0, At, B0); PG8_BAR; PG8_SCHED;
            PG8_LDB(B1, 0, 1); PG8_STAGE(PG8_SB(0, 0), b2, voffB);
            PG8_BAR; PG8_WAIT_L(0); PG8_MMA(0, 1, At, B1); PG8_BAR;
            PG8_LDA(At, 0, 1); PG8_STAGE(PG8_SA(0, 0), a2, voffA);
            PG8_BAR; PG8_WAIT_L(0); PG8_MMA(1, 0, At, B0); PG8_BAR; PG8_SCHED;
            PG8_STAGE(PG8_SB(0, 1), b2 + hstep, voffB);
            PG8_WAIT_V(6); PG8_BAR; PG8_MMA(1, 1, At, B1); PG8_BAR;
            PG8_LDB(B0, 1, 0); PG8_SCHED; PG8_LDA(At, 1, 0); PG8_STAGE(PG8_SA(0, 1), a2 + hstep, voffA);
            PG8_WAIT_L(8); PG8_BAR; PG8_WAIT_L(0); PG8_MMA(0, 0, At, B0); PG8_BAR; PG8_SCHED;
            PG8_LDB(B1, 1, 1); PG8_STAGE(PG8_SB(1, 0), b3, voffB);
            PG8_BAR; PG8_WAIT_L(0); PG8_MMA(0, 1, At, B1); PG8_BAR;
            PG8_LDA(At, 1, 1); PG8_STAGE(PG8_SA(1, 0), a3, voffA);
            PG8_BAR; PG8_WAIT_L(0); PG8_MMA(1, 0, At, B0); PG8_BAR; PG8_SCHED;
            PG8_STAGE(PG8_SB(1, 1), b3 + hstep, voffB);
            PG8_WAIT_V(6); PG8_BAR; PG8_MMA(1, 1, At, B1); PG8_BAR;
        }
        PG8_STAMP();
        if constexpr (!Epi::AFTER_DRAIN) { E(acc, cur, wr, wc, fr, fq); S.done(cur); }
        PG8_STAMP();
        if (!has_next) break;
#pragma unroll
        for (int a = 0; a < 2; ++a)
#pragma unroll
            for (int b = 0; b < 2; ++b)
#pragma unroll
                for (int m = 0; m < 4; ++m)
#pragma unroll
                    for (int n = 0; n < 2; ++n) acc[a][b][m][n] = (f32x4){0.f, 0.f, 0.f, 0.f};
        cur = nxt; cA = nA; cB = nB; ++ui;
    }
    PG8_WAIT_V(0);
    if (wr == 0) PG8_BAR;
    PG8_BAR;
    if constexpr (Epi::AFTER_DRAIN) { E.fused(acc, cur, wr, wc, fr, fq, lds, wid, lane); S.done(cur); }
    PG8_STAMP();
    if (STAMP && wid == 0) { stamps[lane] = lane < nts ? (((unsigned long long)(unsigned)ts_hi << 32) | (unsigned)ts_lo) : 0ull;
        if (lane == 62) stamps[62] = rt_entry; if (lane == 63) stamps[63] = (unsigned long long)wall_clock64(); }
#undef PG8_STAMP
#undef PG8_SA
#undef PG8_SB
#undef PG8_STAGE
#undef PG8_LDA
#undef PG8_LDB
#undef PG8_MMA
#undef PG8_WAIT_V
#undef PG8_WAIT_L
#undef PG8_BAR
#undef PG8_SCHED
}
}

using pg8::bf16_t; using pg8::bf16x8; using pg8::f32x4; using pg8::u32x4;
typedef unsigned u32x2 __attribute__((ext_vector_type(2)));
typedef float f32x2 __attribute__((ext_vector_type(2)));
#define LAS __attribute__((address_space(3)))
#ifndef DBG
#define DBG 0
#endif
#ifndef DBGSEL
#define DBGSEL 0
#endif

constexpr int MP = 16384, MS = 512, MT = 16896, DM = 1024, PIN = 9472, PSH = 3328, DFF = 4096;
constexpr int NPANEL = MT / 256;
constexpr size_t O_YP = 0, O_YS = 16777216, O_PSH = 17301504, O_PWKV = 17328128, O_PMK = 17852416, O_PMV = 19949568,
                 O_SSH = 22046720, O_SWKV = 22472704, O_SGV = 30861312, O_END = 31385600;
constexpr size_t WS_CTL = 0, WS_CTL2 = 256, WS_SSQ1 = 256 + 8192, WS_SSQ2 = WS_SSQ1 + 67584, WS_WTIN = WS_SSQ2 + 67584,
    WS_WTBR = WS_WTIN + 19398656, WS_WTOUT = WS_WTBR + 6291456, WS_WTUP = WS_WTOUT + 2097152, WS_WTDN = WS_WTUP + 8388608,
    WS_WTMKV = WS_WTDN + 8388608, WS_WTW2 = WS_WTMKV + 4194304, WS_WTA2 = WS_WTW2 + 131072, WS_WTG2 = WS_WTA2 + 131072,
    WS_SGW = WS_WTG2 + 262144, WS_HMB = WS_SGW + 262144, WS_MKB = WS_HMB + 4194304, WS_MVT = WS_MKB + 4194304,
    WS_Y3 = WS_MVT + 4194304, WS_GV = WS_Y3 + 103809024, WS_SZ = WS_GV + 34603008, WS_GT = WS_SZ + 112459776,
    WS_HB = WS_GT + 103809024, WS_AV = WS_HB + 34603008, WS_GG = WS_AV + 34603008, WS_XL = WS_GG + 34603008, WS_WTLORA = WS_XL + 8650752, WS_END = WS_WTLORA + 1572864;
constexpr size_t WS_MF = WS_SZ, WS_MB = WS_GV, WS_X1 = WS_GT, WS_X1B = WS_HB, WS_HID = WS_Y3, WS_X2 = WS_SZ, WS_E = WS_HB;
constexpr int LDS_BYTES = 131072 + 256;
constexpr int QW_OFF = 131072;

struct Params { const float* in[33]; float* out; unsigned char* ws; };

enum { I_XP = 0, I_XS, I_MEM, I_CK, I_CV, I_SSH, I_SWKV, I_N1G, I_WIN, I_MU, I_LNG, I_LNB, I_SGW, I_SGB, I_W0, I_WW2, I_A0, I_WA2,
       I_WG2, I_KK, I_KA, I_RK, I_LXG, I_LXB, I_MNG, I_WMK, I_WMV, I_WBR, I_WOUT, I_N2G, I_WUP, I_WDN, I_NFG };

__device__ __forceinline__ float bflo(unsigned u) { return __uint_as_float(u << 16); }
__device__ __forceinline__ float bfhi(unsigned u) { return __uint_as_float(u & 0xffff0000u); }
typedef __bf16 bf2_t __attribute__((ext_vector_type(2)));
__device__ __forceinline__ unsigned pk2(float lo, float hi) { const f32x2 v = {lo, hi}; const bf2_t b = __builtin_convertvector(v, bf2_t); return __builtin_bit_cast(unsigned, b); }
__device__ __forceinline__ float rcpf(float x) { return __builtin_amdgcn_rcpf(x); }
__device__ __forceinline__ float sigmoidf_(float x) { return rcpf(1.f + __expf(-x)); }
__device__ __forceinline__ float gelu_tanh(float x) { const float t = 1.5957691216f * (x + 0.044715f * x * x * x); return x * sigmoidf_(t); }
__device__ __forceinline__ float tanhf_(float x) { return 1.f - 2.f * rcpf(__expf(2.f * x) + 1.f); }
template <int CTRL> __device__ __forceinline__ float dpp_mov(float x) { return __int_as_float(__builtin_amdgcn_update_dpp(0, __float_as_int(x), CTRL, 0xF, 0xF, true)); }
__device__ __forceinline__ float red8(float x) { x += dpp_mov<0xB1>(x); x += dpp_mov<0x4E>(x); x += dpp_mov<0x141>(x); return x; }
__device__ __forceinline__ float red16(float x) { x = red8(x); x += dpp_mov<0x140>(x); return x; }
__device__ __forceinline__ float wave_sum(float x) { x = red16(x); x += __shfl_xor(x, 16); x += __shfl_xor(x, 32); return x; }
__device__ __forceinline__ float wave_max(float x) {
#pragma unroll
    for (int o = 1; o < 64; o <<= 1) x = fmaxf(x, __shfl_xor(x, o));
    return x; }
__device__ __forceinline__ f32x4 mfma16(bf16x8 a, bf16x8 b, f32x4 c) { return __builtin_amdgcn_mfma_f32_16x16x32_bf16(a, b, c, 0, 0, 0); }
__device__ __forceinline__ void unpack4(u32x2 q, float (&o)[4]) { o[0] = bflo(q[0]); o[1] = bfhi(q[0]); o[2] = bflo(q[1]); o[3] = bfhi(q[1]); }

struct TJob { const float* src; bf16_t* dst; const float* gain; int K, N, ldd; };
__device__ __forceinline__ void transpose_tile(const TJob& j, int tile, LAS float* t) {
    const int tid = threadIdx.x; const int tn = j.N >> 6; const int k0 = (tile / tn) << 6, n0 = (tile % tn) << 6;
#pragma unroll
    for (int pp = 0; pp < 2; ++pp) { const int r = (tid >> 4) + pp * 32, c = (tid & 15) * 4;
        const f32x4 v = *(const f32x4*)(j.src + (size_t)(k0 + r) * j.N + n0 + c); const float g = j.gain ? j.gain[k0 + r] : 1.f;
        t[r * 65 + c] = v[0] * g; t[r * 65 + c + 1] = v[1] * g; t[r * 65 + c + 2] = v[2] * g; t[r * 65 + c + 3] = v[3] * g; }
    __syncthreads();
    { const int n = tid >> 3, k8 = (tid & 7) * 8; u32x4 o;
#pragma unroll
      for (int q = 0; q < 4; ++q) o[q] = pk2(t[(k8 + 2 * q) * 65 + n], t[(k8 + 2 * q + 1) * 65 + n]);
      *(u32x4*)(j.dst + (size_t)(n0 + n) * j.ldd + k0 + k8) = o; }
    __syncthreads();
}
__device__ __forceinline__ void phase0(const Params& p, LAS unsigned char* lds) {
    const int tid = threadIdx.x, wid = tid >> 6, lane = tid & 63; unsigned char* ws = p.ws;
    for (int it = blockIdx.x; it < 6016; it += gridDim.x) {
        TJob j; int base;
        if (it < 2368)      { j = {p.in[I_WIN], (bf16_t*)(ws + WS_WTIN), p.in[I_N1G], 1024, PIN, 1024}; base = 0; }
        else if (it < 3136) { const int n = (it - 2368) >> 8; j = {p.in[I_WBR] + (size_t)n * 1048576, (bf16_t*)(ws + WS_WTBR) + (size_t)n * 1048576, nullptr, 1024, 1024, 1024}; base = 2368 + n * 256; }
        else if (it < 3392) { j = {p.in[I_WOUT], (bf16_t*)(ws + WS_WTOUT), nullptr, 1024, 1024, 1024}; base = 3136; }
        else if (it < 4416) { j = {p.in[I_WUP], (bf16_t*)(ws + WS_WTUP), p.in[I_N2G], 1024, 4096, 1024}; base = 3392; }
        else if (it < 5440) { j = {p.in[I_WDN], (bf16_t*)(ws + WS_WTDN), nullptr, 4096, 1024, 4096}; base = 4416; }
        else if (it < 5696) { j = {p.in[I_WMK], (bf16_t*)(ws + WS_WTMKV), p.in[I_MNG], 1024, 1024, 1024}; base = 5440; }
        else if (it < 5952) { j = {p.in[I_WMV], (bf16_t*)(ws + WS_WTMKV) + 1048576, p.in[I_MNG], 1024, 1024, 1024}; base = 5696; }
        else if (it < 5968) { j = {p.in[I_WW2], (bf16_t*)(ws + WS_WTLORA), nullptr, 64, 1024, 256}; base = 5952; }
        else if (it < 5984) { j = {p.in[I_WA2], (bf16_t*)(ws + WS_WTLORA) + 1024 * 256 + 64, nullptr, 64, 1024, 256}; base = 5968; }
        else                { j = {p.in[I_WG2], (bf16_t*)(ws + WS_WTLORA) + 2048 * 256 + 128, nullptr, 128, 1024, 256}; base = 5984; }
        transpose_tile(j, it - base, (LAS float*)lds);
    }
    for (int r = blockIdx.x * 8 + wid; r < MT + 2048; r += gridDim.x * 8) {
        const float* src; bf16_t* dst;
        if (r < MP) { src = p.in[I_XP] + (size_t)r * 1024; dst = (bf16_t*)(ws + WS_HB) + (size_t)r * 1024; }
        else if (r < MT) { src = p.in[I_XS] + (size_t)(r - MP) * 1024; dst = (bf16_t*)(ws + WS_HB) + (size_t)r * 1024; }
        else { src = p.in[I_MEM] + (size_t)(r - MT) * 1024; dst = (bf16_t*)(ws + WS_HMB) + (size_t)(r - MT) * 1024; }
        f32x4 v[4]; float ss = 0.f;
#pragma unroll
        for (int c = 0; c < 4; ++c) { v[c] = *(const f32x4*)(src + c * 256 + lane * 4); ss += v[c][0] * v[c][0] + v[c][1] * v[c][1] + v[c][2] * v[c][2] + v[c][3] * v[c][3]; }
        ss = wave_sum(ss); const float rs = rsqrtf(ss * (1.f / 1024.f) + 1e-6f);
#pragma unroll
        for (int c = 0; c < 4; ++c) { u32x2 o; o[0] = pk2(v[c][0] * rs, v[c][1] * rs); o[1] = pk2(v[c][2] * rs, v[c][3] * rs); *(u32x2*)(dst + c * 256 + lane * 4) = o; }
    }
    { bf16_t* wl = (bf16_t*)(ws + WS_WTLORA);
      for (int i = blockIdx.x * 512 + tid; i < 3072 * 32; i += gridDim.x * 512) { const int row = i >> 5, cc = (i & 31) * 8, blk = row >> 10;
          const bool used = (blk == 0 && cc < 64) || (blk == 1 && cc >= 64 && cc < 128) || (blk == 2 && cc >= 128);
          if (!used) *(u32x4*)(wl + (size_t)row * 256 + cc) = (u32x4){0u, 0u, 0u, 0u}; } }
    { const float* sg = p.in[I_SGW]; bf16_t* d = (bf16_t*)(ws + WS_SGW);
      for (int i = blockIdx.x * 512 + tid; i < 8 * 128 * 128; i += gridDim.x * 512) { const int t = (i >> 7) & 127, s = i & 127; d[i] = (bf16_t)(pk2(s <= t ? sg[i] : 0.f, 0.f) & 0xffffu); } }
}

struct EpiZ {
    static constexpr bool PERM = true, AFTER_DRAIN = false;
    bf16_t *U, *GVp, *SZp, *Qp, *GTp; float* out;
    __device__ __forceinline__ void operator()(const f32x4 (&acc)[2][2][4][2], const pg8::Unit& u, int wr, int wc, int fr, int fq) const {
        const int pn = u.pn; bf16_t* base; int ldc, colt, act;
        if (pn < 4) { base = U; ldc = 1024; colt = pn * 256; act = 1; }
        else if (pn < 8) { base = GVp; ldc = 1024; colt = (pn - 4) * 256; act = 1; }
        else if (pn < 21) { base = SZp; ldc = PSH; colt = (pn - 8) * 256; act = 0; }
        else if (pn < 25) { base = Qp; ldc = 1024; colt = (pn - 21) * 256; act = 3; }
        else { base = GTp; ldc = 3072; colt = (pn - 25) * 256; act = 2; }
        const int row0 = u.pm * 256 + wr * 64 + fr, col0 = colt + wc * 32 + 8 * fq;
#pragma unroll
        for (int ai = 0; ai < 2; ++ai)
#pragma unroll
            for (int m = 0; m < 4; ++m) { const int row = row0 + ai * 128 + m * 16; bf16_t* rowp = base + (size_t)row * ldc + col0;
#pragma unroll
                for (int bj = 0; bj < 2; ++bj) { f32x4 v0 = acc[ai][bj][m][0], v1 = acc[ai][bj][m][1];
                    if (act == 1) {
#pragma unroll
                        for (int q = 0; q < 4; ++q) { v0[q] = gelu_tanh(v0[q]); v1[q] = gelu_tanh(v1[q]); } }
                    else if (act == 2) {
#pragma unroll
                        for (int q = 0; q < 4; ++q) { v0[q] = sigmoidf_(v0[q]); v1[q] = sigmoidf_(v1[q]); } }
                    else if (act == 0) {
                        const bool lastp = row < MP ? ((row & 2047) == 2047) : (((row - MP) & 3) == 3);
                        if (lastp) { float* d = (row < MP ? out + O_PSH + (size_t)(row >> 11) * PSH : out + O_SSH + (size_t)((row - MP) >> 2) * PSH) + col0 + bj * 128;
                            *(f32x4*)d = v0; *(f32x4*)(d + 4) = v1; } }
                    u32x4 o; o[0] = pk2(v0[0], v0[1]); o[1] = pk2(v0[2], v0[3]); o[2] = pk2(v1[0], v1[1]); o[3] = pk2(v1[2], v1[3]);
                    *(u32x4*)(rowp + bj * 128) = o; } }
    }
};
struct EpiMem {
    static constexpr bool PERM = false, AFTER_DRAIN = false;
    float* out; bf16_t *MKB, *MVT;
    __device__ __forceinline__ void operator()(const f32x4 (&acc)[2][2][4][2], const pg8::Unit& u, int wr, int wc, int fr, int fq) const {
        const int row0 = u.pm * 256 + wr * 64 + fr, col0 = u.pn * 256 + wc * 32 + 4 * fq; const bool isv = u.pn >= 4;
#pragma unroll
        for (int ai = 0; ai < 2; ++ai)
#pragma unroll
            for (int m = 0; m < 4; ++m) { const int row = row0 + ai * 128 + m * 16;
#pragma unroll
                for (int bj = 0; bj < 2; ++bj)
#pragma unroll
                    for (int n = 0; n < 2; ++n) { const f32x4 v = acc[ai][bj][m][n]; const int col = col0 + bj * 128 + n * 16;
                        if (!isv) { *(f32x4*)(out + O_PMK + (size_t)row * 1024 + col) = v; u32x2 o; o[0] = pk2(v[0], v[1]); o[1] = pk2(v[2], v[3]); *(u32x2*)(MKB + (size_t)row * 1024 + col) = o; }
                        else { const int c = col - 1024; *(f32x4*)(out + O_PMV + (size_t)row * 1024 + c) = v;
                            const int b = row >> 8, mem = row & 255, head = c >> 8, d = c & 255; bf16_t* dst = MVT + ((size_t)((b * 4 + head) * 256 + d)) * 256 + mem;
                            const unsigned p0 = pk2(v[0], v[1]), p1 = pk2(v[2], v[3]);
                            dst[0] = (bf16_t)(p0 & 0xffffu); dst[256] = (bf16_t)(p0 >> 16); dst[512] = (bf16_t)(p1 & 0xffffu); dst[768] = (bf16_t)(p1 >> 16); } } }
    }
};
struct BranchOrder {
    int G, c;
    __device__ bool next(int i, pg8::Unit& u) const { const int tile = (i / 3) * G + c, n = i % 3; if (tile >= (MP / 256) * 4) return false;
        const int xcd = tile & 7, q = tile >> 3, pm = xcd * 8 + (q >> 2), pn = q & 3;
        u.pm = n * NPANEL + pm; u.pn = n * 4 + pn; return true; }
    __device__ __forceinline__ void a_ready(const pg8::Unit&) const {}
    __device__ __forceinline__ void done(const pg8::Unit&) const {}
};
struct EpiMerge {
    static constexpr bool PERM = false, AFTER_DRAIN = false;
    const bf16_t* GT; float* MF; bf16_t* MB;
    __device__ __forceinline__ void operator()(const f32x4 (&acc)[2][2][4][2], const pg8::Unit& u, int wr, int wc, int fr, int fq) const {
        const int n = u.pm / NPANEL, pm = u.pm - n * NPANEL, pn = u.pn & 3;
        const int row0 = pm * 256 + wr * 64 + fr, col0 = pn * 256 + wc * 32 + 4 * fq;
        u32x2 g[2][4]; f32x4 o[2][4];
        auto issue = [&](int grp, int slot) { const int row = row0 + (grp >> 2) * 128 + (grp & 3) * 16; const bf16_t* gp = GT + (size_t)row * 3072 + n * 1024 + col0; const float* mp = MF + (size_t)row * 1024 + col0;
#pragma unroll
            for (int x = 0; x < 4; ++x) { g[slot][x] = *(const u32x2*)(gp + (x >> 1) * 128 + (x & 1) * 16); if (n > 0) o[slot][x] = *(const f32x4*)(mp + (x >> 1) * 128 + (x & 1) * 16); else o[slot][x] = (f32x4){0.f, 0.f, 0.f, 0.f}; } };
        issue(0, 0);
#pragma unroll
        for (int grp = 0; grp < 8; ++grp) { const int slot = grp & 1, ai = grp >> 2, m = grp & 3; const int row = row0 + ai * 128 + m * 16;
            if (grp < 7) issue(grp + 1, slot ^ 1);
            float* mp = MF + (size_t)row * 1024 + col0;
#pragma unroll
            for (int x = 0; x < 4; ++x) { float gf[4]; unpack4(g[slot][x], gf); f32x4 v = acc[ai][x >> 1][m][x & 1];
                v[0] = v[0] * gf[0] + o[slot][x][0]; v[1] = v[1] * gf[1] + o[slot][x][1]; v[2] = v[2] * gf[2] + o[slot][x][2]; v[3] = v[3] * gf[3] + o[slot][x][3];
                if (n < 2) *(f32x4*)(mp + (x >> 1) * 128 + (x & 1) * 16) = v;
                else { u32x2 w; w[0] = pk2(v[0], v[1]); w[1] = pk2(v[2], v[3]); *(u32x2*)(MB + (size_t)row * 1024 + col0 + (x >> 1) * 128 + (x & 1) * 16) = w; } } }
    }
};
template <int KS, class Mid, class Fin>
__device__ __forceinline__ void thin_gemm(LAS unsigned char* lds, const bf16_t* A0, size_t a_bstride, const bf16_t* B0, size_t b_bstride, int nb, int N, int K, const Mid& mid, const Fin& fin) {
    const int wid = threadIdx.x >> 6, lane = threadIdx.x & 63, fr = lane & 15, fq = lane >> 4; const int ntask = 32 * (N >> 6);
    constexpr int TPB = 8 / KS; const int grp = wid / KS, kq = wid % KS, kspan = K / KS;
    LAS f32x4* red = (LAS f32x4*)lds;
    for (int t0 = blockIdx.x * TPB; t0 < ntask; t0 += gridDim.x * TPB) {
        const int t = t0 + grp; const bool valid = t < ntask;
        const int r0 = MP + (t & 31) * 16, c0 = (t >> 5) * 64;
        f32x4 tot[4];
#pragma unroll
        for (int j = 0; j < 4; ++j) tot[j] = (f32x4){0.f, 0.f, 0.f, 0.f};
        if (valid) for (int n = 0; n < nb; ++n) { f32x4 acc[4];
#pragma unroll
            for (int j = 0; j < 4; ++j) acc[j] = (f32x4){0.f, 0.f, 0.f, 0.f};
            const bf16_t* ap = A0 + (size_t)n * a_bstride + (size_t)(r0 + fr) * K + kq * kspan + fq * 8; const bf16_t* bp = B0 + (size_t)n * b_bstride + (size_t)(c0 + fr) * K + kq * kspan + fq * 8;
#pragma unroll 4
            for (int ks = 0; ks < (kspan >> 5); ++ks) { const bf16x8 a = *(const bf16x8*)(ap + ks * 32);
#pragma unroll
                for (int j = 0; j < 4; ++j) { const bf16x8 b = *(const bf16x8*)(bp + (size_t)j * 16 * K + ks * 32); acc[j] = mfma16(b, a, acc[j]); } }
            mid(n, acc, tot, r0 + fr, c0 + 4 * fq); }
        if (KS > 1) {
#pragma unroll
            for (int j = 0; j < 4; ++j) red[(wid * 4 + j) * 64 + lane] = tot[j];
            __syncthreads();
            if (kq == 0 && valid) {
#pragma unroll
                for (int q = 1; q < KS; ++q)
#pragma unroll
                    for (int j = 0; j < 4; ++j) tot[j] += red[((wid + q) * 4 + j) * 64 + lane];
                fin(tot, r0 + fr, c0 + 4 * fq); }
            __syncthreads();
        } else if (valid) fin(tot, r0 + fr, c0 + 4 * fq);
    }
}
struct EpiRes {
    static constexpr bool PERM = false, AFTER_DRAIN = false;
    const float* resP; const float* resS; float* X; bf16_t* XB; float* ssq;
    __device__ __forceinline__ void operator()(const f32x4 (&acc)[2][2][4][2], const pg8::Unit& u, int wr, int wc, int fr, int fq) const {
        const int row0 = u.pm * 256 + wr * 64 + fr, col0 = u.pn * 256 + wc * 32 + 4 * fq;
#pragma unroll
        for (int ai = 0; ai < 2; ++ai) { f32x4 r[4][4];
#pragma unroll
            for (int m = 0; m < 4; ++m) { const int row = row0 + ai * 128 + m * 16; const float* rp = (row < MP ? resP + (size_t)row * 1024 : resS + (size_t)(row - MP) * 1024) + col0;
#pragma unroll
                for (int x = 0; x < 4; ++x) r[m][x] = *(const f32x4*)(rp + (x >> 1) * 128 + (x & 1) * 16); }
#pragma unroll
            for (int m = 0; m < 4; ++m) { const int row = row0 + ai * 128 + m * 16; float ss = 0.f;
#pragma unroll
                for (int x = 0; x < 4; ++x) { const int col = col0 + (x >> 1) * 128 + (x & 1) * 16; const f32x4 v = acc[ai][x >> 1][m][x & 1] + r[m][x];
                    *(f32x4*)(X + (size_t)row * 1024 + col) = v; ss += v[0] * v[0] + v[1] * v[1] + v[2] * v[2] + v[3] * v[3];
                    if (XB) { u32x2 w; w[0] = pk2(v[0], v[1]); w[1] = pk2(v[2], v[3]); *(u32x2*)(XB + (size_t)row * 1024 + col) = w; } }
                ss += __shfl_xor(ss, 16); ss += __shfl_xor(ss, 32);
                if (fq == 0) atomicAdd(ssq + row, ss); } }
    }
};
struct EpiUp {
    static constexpr bool PERM = true, AFTER_DRAIN = false;
    const float* ssq; bf16_t* H;
    __device__ __forceinline__ void operator()(const f32x4 (&acc)[2][2][4][2], const pg8::Unit& u, int wr, int wc, int fr, int fq) const {
        const int row0 = u.pm * 256 + wr * 64 + fr, col0 = u.pn * 256 + wc * 32 + 8 * fq;
#pragma unroll
        for (int ai = 0; ai < 2; ++ai)
#pragma unroll
            for (int m = 0; m < 4; ++m) { const int row = row0 + ai * 128 + m * 16; const float rs = rsqrtf(ssq[row] * (1.f / 1024.f) + 1e-6f);
#pragma unroll
                for (int bj = 0; bj < 2; ++bj) { f32x4 v0 = acc[ai][bj][m][0], v1 = acc[ai][bj][m][1];
#pragma unroll
                    for (int q = 0; q < 4; ++q) { float a = fmaxf(v0[q] * rs, 0.f); v0[q] = a * a; float b = fmaxf(v1[q] * rs, 0.f); v1[q] = b * b; }
                    u32x4 o; o[0] = pk2(v0[0], v0[1]); o[1] = pk2(v0[2], v0[3]); o[2] = pk2(v1[0], v1[1]); o[3] = pk2(v1[2], v1[3]);
                    *(u32x4*)(H + (size_t)row * DFF + col0 + bj * 128) = o; } }
    }
};

template <int NR, bool DUMMY> __device__ __forceinline__ void p2_rows(const Params& p, const int (&mrow)[NR], int lane) {
    unsigned char* ws = p.ws; const float* lng = p.in[I_LNG]; const float* lnb = p.in[I_LNB];
    const int c4 = lane * 4;
    u32x4 q0[NR], q1[NR]; u32x2 cq[NR], pq[NR]; f32x4 sq[NR]; bool valid[NR], first[NR];
#pragma unroll
    for (int i = 0; i < NR; ++i) { const int m = mrow[i]; valid[i] = m < MT; const int mm = valid[i] ? m : 0;
        const bf16_t* row = (const bf16_t*)(ws + WS_GV) + (size_t)mm * 1024; q0[i] = *(const u32x4*)(row + lane * 8); q1[i] = *(const u32x4*)(row + 512 + lane * 8);
        const bf16_t* cur = (const bf16_t*)(ws + WS_SZ) + (size_t)mm * PSH + 3072 + c4; cq[i] = *(const u32x2*)cur;
        first[i] = mm < MP ? ((mm & 2047) == 0) : (((mm - MP) & 3) == 0);
        pq[i] = (u32x2){0u, 0u}; sq[i] = (f32x4){0.f, 0.f, 0.f, 0.f};
        if (!first[i]) pq[i] = *(const u32x2*)(cur - PSH);
        else if (mm >= MP) sq[i] = *(const f32x4*)(p.in[I_SSH] + (size_t)((mm - MP) >> 2) * PSH + 3072 + c4); }
    const f32x4 mu = *(const f32x4*)(p.in[I_MU] + 3072 + c4);
    f32x4 g0[2], g1[2], b0[2], b1[2];
#pragma unroll
    for (int c = 0; c < 2; ++c) { const int col = c * 512 + lane * 8; g0[c] = *(const f32x4*)(lng + col); g1[c] = *(const f32x4*)(lng + col + 4); b0[c] = *(const f32x4*)(lnb + col); b1[c] = *(const f32x4*)(lnb + col + 4); }
#pragma unroll
    for (int i = 0; i < NR; ++i) { if (!valid[i]) continue; const int m = mrow[i]; bf16_t* row = (bf16_t*)(ws + WS_GV) + (size_t)m * 1024; float x[16];
#pragma unroll
        for (int k = 0; k < 4; ++k) { x[2 * k] = bflo(q0[i][k]); x[2 * k + 1] = bfhi(q0[i][k]); x[8 + 2 * k] = bflo(q1[i][k]); x[8 + 2 * k + 1] = bfhi(q1[i][k]); }
        float s = 0.f;
#pragma unroll
        for (int k = 0; k < 16; ++k) s += x[k];
        s = wave_sum(s); const float mean = s * (1.f / 1024.f); float vs = 0.f;
#pragma unroll
        for (int k = 0; k < 16; ++k) { x[k] -= mean; vs += x[k] * x[k]; }
        vs = wave_sum(vs); const float rstd = rsqrtf(vs * (1.f / 1024.f) + 1e-5f);
#pragma unroll
        for (int c = 0; c < 2; ++c) { const int col = c * 512 + lane * 8; float y[8];
#pragma unroll
            for (int k = 0; k < 4; ++k) { y[k] = x[c * 8 + k] * rstd * g0[c][k] + b0[c][k]; y[4 + k] = x[c * 8 + 4 + k] * rstd * g1[c][k] + b1[c][k]; }
            u32x4 o; o[0] = pk2(y[0], y[1]); o[1] = pk2(y[2], y[3]); o[2] = pk2(y[4], y[5]); o[3] = pk2(y[6], y[7]); if (!DUMMY) *(u32x4*)(row + col) = o;
            if (m >= MP) { float* d = p.out + O_SGV + (size_t)(m - MP) * 1024 + col; *(f32x4*)d = (f32x4){y[0], y[1], y[2], y[3]}; *(f32x4*)(d + 4) = (f32x4){y[4], y[5], y[6], y[7]}; } }
        float cv[4], pv[4], o[4]; unpack4(cq[i], cv);
        if (!first[i]) unpack4(pq[i], pv); else { pv[0] = sq[i][0]; pv[1] = sq[i][1]; pv[2] = sq[i][2]; pv[3] = sq[i][3]; }
#pragma unroll
        for (int e = 0; e < 4; ++e) { const float ss = cv[e] + (pv[e] - cv[e]) * mu[e]; o[e] = lane < 16 ? tanhf_(ss) : (lane < 32 ? ss : sigmoidf_(ss)); }
        u32x2 w; w[0] = pk2(o[0], o[1]); w[1] = pk2(o[2], o[3]); *(u32x2*)((bf16_t*)(ws + WS_XL) + (size_t)m * 256 + c4) = w; }
}
struct EpiLora {
    static constexpr bool PERM = true, AFTER_DRAIN = false;
    bf16_t *E, *A, *Gg; const float *w0, *a0;
    __device__ __forceinline__ void operator()(const f32x4 (&acc)[2][2][4][2], const pg8::Unit& u, int wr, int wc, int fr, int fq) const {
        const int seg = u.pn >> 2, colt = (u.pn & 3) * 256; bf16_t* base = E + (size_t)seg * 17301504;
        const int row0 = u.pm * 256 + wr * 64 + fr, col0 = colt + wc * 32 + 8 * fq;
        f32x4 bv[2][2];
#pragma unroll
        for (int bj = 0; bj < 2; ++bj) { if (seg == 0) { bv[bj][0] = *(const f32x4*)(w0 + col0 + bj * 128); bv[bj][1] = *(const f32x4*)(w0 + col0 + bj * 128 + 4); } else if (seg == 1) { bv[bj][0] = *(const f32x4*)(a0 + col0 + bj * 128); bv[bj][1] = *(const f32x4*)(a0 + col0 + bj * 128 + 4); } else { bv[bj][0] = (f32x4){0.f, 0.f, 0.f, 0.f}; bv[bj][1] = bv[bj][0]; } }
#pragma unroll
        for (int ai = 0; ai < 2; ++ai)
#pragma unroll
            for (int m = 0; m < 4; ++m) { const int row = row0 + ai * 128 + m * 16; bf16_t* rowp = base + (size_t)row * 1024 + col0;
#pragma unroll
                for (int bj = 0; bj < 2; ++bj) { f32x4 v0 = acc[ai][bj][m][0] + bv[bj][0], v1 = acc[ai][bj][m][1] + bv[bj][1];
                    if (seg == 0) {
#pragma unroll
                        for (int q = 0; q < 4; ++q) { v0[q] = 0.60653066f * sigmoidf_(v0[q]); v1[q] = 0.60653066f * sigmoidf_(v1[q]); } }
                    else if (seg == 1) {
#pragma unroll
                        for (int q = 0; q < 4; ++q) { v0[q] = sigmoidf_(v0[q]); v1[q] = sigmoidf_(v1[q]); } }
                    u32x4 o; o[0] = pk2(v0[0], v0[1]); o[1] = pk2(v0[2], v0[3]); o[2] = pk2(v1[0], v1[1]); o[3] = pk2(v1[2], v1[3]);
                    *(u32x4*)(rowp + bj * 128) = o; } }
    }
};

struct ScanPre { u32x2 cr, ck, cv, pr, pk, pv, e, a, g; };
__device__ __forceinline__ u32x2 pack4f(const float* s) { const f32x4 q = *(const f32x4*)s; u32x2 o; o[0] = pk2(q[0], q[1]); o[1] = pk2(q[2], q[3]); return o; }
__device__ __forceinline__ void scan_head(const Params& p, LAS unsigned char* lds, int row0, int T, int h, const float* s0, float* sfin, const float* shift0) {
    const int tid = threadIdx.x, wid = tid >> 6, lane = tid & 63; unsigned char* ws = p.ws;
    const bf16_t* SZp = (const bf16_t*)(ws + WS_SZ); const bf16_t* Ep = (const bf16_t*)(ws + WS_E); const bf16_t* Ap = (const bf16_t*)(ws + WS_AV); const bf16_t* Gp = (const bf16_t*)(ws + WS_GG);
    bf16_t* YB = (bf16_t*)(ws + WS_Y3) + (size_t)MT * 1024;
    LAS float* bufs = (LAS float*)lds;
    LAS float* Yl2 = (LAS float*)(lds + 98304);
    LAS float* BON = (LAS float*)(lds + 98304 + 16384);
    const bool helper = wid >= 4; const int htid = tid & 255;
    const int tth = htid >> 4, j4 = (htid & 15) * 4, ch = h * 64 + j4;
    const int si = (wid & 3) * 16 + (lane >> 3) * 2, jb = (lane & 7) * 8;
    f32x2 S0[4], S1[4];
    if (s0 && !helper) {
#pragma unroll
        for (int q = 0; q < 4; ++q) { S0[q] = *(const f32x2*)(s0 + si * 64 + jb + 2 * q); S1[q] = *(const f32x2*)(s0 + (si + 1) * 64 + jb + 2 * q); } }
    else {
#pragma unroll
        for (int q = 0; q < 4; ++q) { S0[q] = (f32x2){0.f, 0.f}; S1[q] = S0[q]; } }
    auto load_pre = [&](int t0, ScanPre (&P)[2]) {
#pragma unroll
        for (int pp = 0; pp < 2; ++pp) { const int t = t0 + tth + 16 * pp; ScanPre& Q = P[pp];
            if (t < T) { const size_t m = (size_t)(row0 + t); const bf16_t* c = SZp + m * PSH + ch;
                Q.cr = *(const u32x2*)c; Q.ck = *(const u32x2*)(c + 1024); Q.cv = *(const u32x2*)(c + 2048);
                if (t > 0) { Q.pr = *(const u32x2*)(c - PSH); Q.pk = *(const u32x2*)(c - PSH + 1024); Q.pv = *(const u32x2*)(c - PSH + 2048); }
                else if (shift0) { Q.pr = pack4f(shift0 + ch); Q.pk = pack4f(shift0 + 1024 + ch); Q.pv = pack4f(shift0 + 2048 + ch); }
                else { Q.pr = (u32x2){0u, 0u}; Q.pk = Q.pr; Q.pv = Q.pr; }
                Q.e = *(const u32x2*)(Ep + m * 1024 + ch); Q.a = *(const u32x2*)(Ap + m * 1024 + ch); Q.g = (u32x2){0u, 0u}; }
            else { Q.cr = (u32x2){0u, 0u}; Q.ck = Q.cr; Q.cv = Q.cr; Q.pr = Q.cr; Q.pk = Q.cr; Q.pv = Q.cr; Q.e = Q.cr; Q.a = Q.cr; Q.g = Q.cr; } }
    };
    auto store_pre = [&](const ScanPre (&P)[2], int nb) {
        const f32x4 mur = *(const f32x4*)(p.in[I_MU] + ch), muk = *(const f32x4*)(p.in[I_MU] + 1024 + ch), muv = *(const f32x4*)(p.in[I_MU] + 2048 + ch),
                    kkc = *(const f32x4*)(p.in[I_KK] + ch), kac = *(const f32x4*)(p.in[I_KA] + ch), rkc = *(const f32x4*)(p.in[I_RK] + ch);
#pragma unroll
        for (int pp = 0; pp < 2; ++pp) { const ScanPre& Q = P[pp]; const int tt = tth + 16 * pp;
            float cr[4], ck[4], cv[4], pr[4], pk[4], pv[4], e[4], a[4];
            unpack4(Q.cr, cr); unpack4(Q.ck, ck); unpack4(Q.cv, cv); unpack4(Q.pr, pr); unpack4(Q.pk, pk); unpack4(Q.pv, pv); unpack4(Q.e, e); unpack4(Q.a, a);
            f32x4 r, w, k, na, bb, v; float ssq = 0.f, bon = 0.f; float kkr[4];
#pragma unroll
            for (int q = 0; q < 4; ++q) { r[q] = cr[q] + (pr[q] - cr[q]) * mur[q]; const float kz = ck[q] + (pk[q] - ck[q]) * muk[q]; v[q] = cv[q] + (pv[q] - cv[q]) * muv[q];
                k[q] = kz * (1.f + (a[q] - 1.f) * kac[q]); kkr[q] = kz * kkc[q]; ssq += kkr[q] * kkr[q]; bon += r[q] * k[q] * rkc[q]; w[q] = __expf(-e[q]); }
            ssq = red16(ssq); bon = red16(bon); const float rn = rsqrtf(ssq + 1e-12f);
#pragma unroll
            for (int q = 0; q < 4; ++q) { const float kk = kkr[q] * rn; na[q] = -kk; bb[q] = kk * a[q]; }
            LAS float* b = bufs + nb * 12288 + tt * 64 + j4;
            *(LAS f32x4*)(b) = r; *(LAS f32x4*)(b + 2048) = w; *(LAS f32x4*)(b + 4096) = k; *(LAS f32x4*)(b + 6144) = na; *(LAS f32x4*)(b + 8192) = bb; *(LAS f32x4*)(b + 10240) = v;
            if ((htid & 15) == 0) BON[nb * 32 + tt] = bon; }
    };
    auto epilogue = [&](int c) {
        const int cb = c & 1, t0 = c * 32, nv = (T - t0) < 32 ? (T - t0) : 32;
        const f32x4 lg = *(const f32x4*)(p.in[I_LXG] + h * 64 + j4), lb = *(const f32x4*)(p.in[I_LXB] + h * 64 + j4);
        u32x2 gq[2];
#pragma unroll
        for (int pp = 0; pp < 2; ++pp) { const int tt = tth + 16 * pp; gq[pp] = (u32x2){0u, 0u}; if (tt < nv) gq[pp] = *(const u32x2*)(Gp + (size_t)(row0 + t0 + tt) * 1024 + ch); }
#pragma unroll
        for (int pp = 0; pp < 2; ++pp) { const int tt = tth + 16 * pp;
            if (tt < nv) { const size_t m = (size_t)(row0 + t0 + tt);
                const f32x4 y = *(const LAS f32x4*)(Yl2 + cb * 2048 + tt * 64 + j4); const f32x4 v = *(const LAS f32x4*)(bufs + cb * 12288 + 10240 + tt * 64 + j4); const float bon = BON[cb * 32 + tt];
                float s = y[0] + y[1] + y[2] + y[3]; s = red16(s); const float mean = s * (1.f / 64.f);
                float d[4], vs = 0.f;
#pragma unroll
                for (int q = 0; q < 4; ++q) { d[q] = y[q] - mean; vs += d[q] * d[q]; }
                vs = red16(vs); const float rstd = rsqrtf(vs * (1.f / 64.f) + 64e-5f);
                float g[4]; unpack4(gq[pp], g); float o[4];
#pragma unroll
                for (int q = 0; q < 4; ++q) o[q] = (d[q] * rstd * lg[q] + lb[q] + bon * v[q]) * g[q];
                u32x2 w; w[0] = pk2(o[0], o[1]); w[1] = pk2(o[2], o[3]); *(u32x2*)(YB + m * 1024 + h * 64 + j4) = w; } }
    };
    ScanPre P[2];
    if (helper) { load_pre(0, P); store_pre(P, 0); }
    __syncthreads();
    const int nch = (T + 31) >> 5;
    for (int c = 0; c < nch; ++c) {
        const int cb = c & 1, t0 = c * 32, nv = (T - t0) < 32 ? (T - t0) : 32;
        if (!helper) { const LAS float* b = bufs + cb * 12288 + jb; const LAS float* vb = bufs + cb * 12288 + 10240 + si; LAS float* Yl = Yl2 + cb * 2048;
          f32x4 R[2], W[2], K[2], A[2], B[2], nR[2], nW[2], nK[2], nA[2], nB[2]; f32x2 v, nvv;
#define SCAN_LOAD(R_, W_, K_, A_, B_, V_, t) { const LAS float* bt = b + (t) * 64; _Pragma("unroll") for (int x = 0; x < 2; ++x) { \
              A_[x] = *(const LAS f32x4*)(bt + 6144 + 4 * x); B_[x] = *(const LAS f32x4*)(bt + 8192 + 4 * x); W_[x] = *(const LAS f32x4*)(bt + 2048 + 4 * x); \
              K_[x] = *(const LAS f32x4*)(bt + 4096 + 4 * x); R_[x] = *(const LAS f32x4*)(bt + 4 * x); } V_ = *(const LAS f32x2*)(vb + (t) * 64); }
#define H2(X, q) ((f32x2){X[(q) >> 1][((q) & 1) * 2], X[(q) >> 1][((q) & 1) * 2 + 1]})
          SCAN_LOAD(R, W, K, A, B, v, 0)
#pragma unroll 4
          for (int t = 0; t < nv; ++t) {
              { const int tn = (t + 1 < 32) ? t + 1 : 31; SCAN_LOAD(nR, nW, nK, nA, nB, nvv, tn) }
              asm volatile("" ::: "memory");
              f32x2 d0 = S0[0] * H2(A, 0), d1 = S1[0] * H2(A, 0);
#pragma unroll
              for (int q = 1; q < 4; ++q) { d0 += S0[q] * H2(A, q); d1 += S1[q] * H2(A, q); }
              const float sa0 = red8(d0[0] + d0[1]), sa1 = red8(d1[0] + d1[1]);
              const f32x2 sa02 = {sa0, sa0}, sa12 = {sa1, sa1}, v02 = {v[0], v[0]}, v12 = {v[1], v[1]};
#pragma unroll
              for (int q = 0; q < 4; ++q) { S0[q] = S0[q] * H2(W, q) + (sa02 * H2(B, q) + v02 * H2(K, q)); S1[q] = S1[q] * H2(W, q) + (sa12 * H2(B, q) + v12 * H2(K, q)); }
              f32x2 y0 = S0[0] * H2(R, 0), y1 = S1[0] * H2(R, 0);
#pragma unroll
              for (int q = 1; q < 4; ++q) { y0 += S0[q] * H2(R, q); y1 += S1[q] * H2(R, q); }
              float yy0 = y0[0] + y0[1], yy1 = y1[0] + y1[1];
              asm("" : "+v"(yy0)); asm("" : "+v"(yy1));
              yy0 = red8(yy0); yy1 = red8(yy1);
              *(LAS f32x2*)(Yl + t * 64 + si) = (f32x2){yy0, yy1};
#pragma unroll
              for (int x = 0; x < 2; ++x) { R[x] = nR[x]; W[x] = nW[x]; K[x] = nK[x]; A[x] = nA[x]; B[x] = nB[x]; }
              v = nvv; }
#undef SCAN_LOAD
#undef H2
        } else {
            if (c + 1 < nch) load_pre(t0 + 32, P);
            if (c > 0) epilogue(c - 1);
            if (c + 1 < nch) store_pre(P, cb ^ 1);
        }
        __syncthreads();
    }
    if (helper) epilogue(nch - 1);
#pragma unroll
    for (int q = 0; q < 4; ++q) if (!helper) { *(f32x2*)(sfin + si * 64 + jb + 2 * q) = S0[q]; *(f32x2*)(sfin + (si + 1) * 64 + jb + 2 * q) = S1[q]; }
}

template <bool DUMMY> __device__ __forceinline__ void attn_prompt_item(const Params& p, LAS unsigned char* lds, int item) {
    const int tid = threadIdx.x, wid = tid >> 6, lane = tid & 63, fr = lane & 15, fq = lane >> 4; unsigned char* ws = p.ws;
    const int b = item >> 6, head = (item >> 4) & 3, qt = item & 15;
    bf16_t* Qp = (bf16_t*)(ws + WS_Y3) + (size_t)2 * MT * 1024; const bf16_t* MKB = (const bf16_t*)(ws + WS_MKB); const bf16_t* MVT = (const bf16_t*)(ws + WS_MVT);
    const int qrow = b * 2048 + qt * 128 + wid * 16;
    bf16x8 qf[8];
#pragma unroll
    for (int ks = 0; ks < 8; ++ks) qf[ks] = *(const bf16x8*)(Qp + (size_t)(qrow + fr) * 1024 + head * 256 + ks * 32 + fq * 8);
#pragma unroll 1
    for (int rnd = 0; rnd < 2; ++rnd) { u32x4 kv[8];
#pragma unroll
      for (int it = 0; it < 8; ++it) { const int idx = (rnd * 8 + it) * 512 + tid, row = idx >> 5, c = idx & 31; kv[it] = *(const u32x4*)(MKB + (size_t)(b * 256 + row) * 1024 + head * 256 + c * 8); }
#pragma unroll
      for (int it = 0; it < 8; ++it) { const int idx = (rnd * 8 + it) * 512 + tid, row = idx >> 5, c = idx & 31; *(LAS u32x4*)(lds + (row * 32 + (c ^ (row & 15))) * 16) = kv[it]; } }
    __syncthreads();
    u32x4 pf[8];
    { f32x4 s[16];
      int koff[8];
#pragma unroll
      for (int ks = 0; ks < 8; ++ks) koff[ks] = (fr * 32 + ((ks * 4 + fq) ^ fr)) * 16;
#pragma unroll
      for (int nt = 0; nt < 16; ++nt) { f32x4 acc = {0.f, 0.f, 0.f, 0.f};
#pragma unroll
          for (int ks = 0; ks < 8; ++ks) { const bf16x8 kf = *(const LAS bf16x8*)(lds + nt * 8192 + koff[ks]); acc = mfma16(kf, qf[ks], acc); }
          s[nt] = acc; }
      float mx = -3.0e38f;
#pragma unroll
      for (int nt = 0; nt < 16; ++nt) mx = fmaxf(fmaxf(fmaxf(s[nt][0], s[nt][1]), fmaxf(s[nt][2], s[nt][3])), mx);
      mx = fmaxf(mx, __shfl_xor(mx, 16)); mx = fmaxf(mx, __shfl_xor(mx, 32));
      float sum = 0.f;
#pragma unroll
      for (int nt = 0; nt < 16; ++nt)
#pragma unroll
          for (int q = 0; q < 4; ++q) { const float e = __expf((s[nt][q] - mx) * 0.0625f); s[nt][q] = e; sum += e; }
      sum += __shfl_xor(sum, 16); sum += __shfl_xor(sum, 32); const float inv = rcpf(sum);
#pragma unroll
      for (int ks = 0; ks < 8; ++ks) { pf[ks][0] = pk2(s[2 * ks][0] * inv, s[2 * ks][1] * inv); pf[ks][1] = pk2(s[2 * ks][2] * inv, s[2 * ks][3] * inv);
          pf[ks][2] = pk2(s[2 * ks + 1][0] * inv, s[2 * ks + 1][1] * inv); pf[ks][3] = pk2(s[2 * ks + 1][2] * inv, s[2 * ks + 1][3] * inv); } }
    __syncthreads();
#pragma unroll 1
    for (int rnd = 0; rnd < 2; ++rnd) { u32x4 kv[8];
#pragma unroll
      for (int it = 0; it < 8; ++it) { const int idx = (rnd * 8 + it) * 512 + tid, row = idx >> 5, c = idx & 31; kv[it] = *(const u32x4*)(MVT + ((size_t)((b * 4 + head) * 256 + row)) * 256 + c * 8); }
#pragma unroll
      for (int it = 0; it < 8; ++it) { const int idx = (rnd * 8 + it) * 512 + tid, row = idx >> 5, c = idx & 31; *(LAS u32x4*)(lds + (row * 32 + (c ^ (row & 15))) * 16) = kv[it]; } }
    __syncthreads();
    { int voff[8][2];
#pragma unroll
      for (int ks = 0; ks < 8; ++ks) { const int c1 = ks * 4 + (fq >> 1); voff[ks][0] = (fr * 32 + (c1 ^ fr)) * 16 + (fq & 1) * 8; voff[ks][1] = (fr * 32 + ((c1 + 2) ^ fr)) * 16 + (fq & 1) * 8; }
#pragma unroll 2
      for (int dt = 0; dt < 16; ++dt) { f32x4 acc = {0.f, 0.f, 0.f, 0.f};
#pragma unroll
          for (int ks = 0; ks < 8; ++ks) { const u32x2 lo = *(const LAS u32x2*)(lds + dt * 8192 + voff[ks][0]), hi = *(const LAS u32x2*)(lds + dt * 8192 + voff[ks][1]);
              u32x4 vv; vv[0] = lo[0]; vv[1] = lo[1]; vv[2] = hi[0]; vv[3] = hi[1]; acc = mfma16(__builtin_bit_cast(bf16x8, vv), __builtin_bit_cast(bf16x8, pf[ks]), acc); }
          u32x2 w; w[0] = pk2(acc[0], acc[1]); w[1] = pk2(acc[2], acc[3]);
          bf16_t* o = Qp + (size_t)(qrow + fr) * 1024 + head * 256 + dt * 16 + 4 * fq;
          if (!DUMMY) *(u32x2*)o = w; else if (w[0] == 0x12345678u) Qp[0] = 0; } }
    __syncthreads();
}

template <bool DUMMY> __device__ __forceinline__ void attn_sample_item(const Params& p, LAS unsigned char* lds, int item) {
    const int tid = threadIdx.x, wid = tid >> 6, lane = tid & 63, l16 = lane & 15, rg = lane >> 4; unsigned char* ws = p.ws;
    const int b = item >> 2, head = item & 3;
    bf16_t* Qp = (bf16_t*)(ws + WS_Y3) + (size_t)2 * MT * 1024 + (size_t)(MP + 4 * b) * 1024 + head * 256;
    const float* Kp = p.in[I_CK] + ((size_t)b * 256 * 4 + head) * 256; const float* Vp = p.in[I_CV] + ((size_t)b * 256 * 4 + head) * 256;
    LAS float* sc = (LAS float*)lds; LAS float* pr = (LAS float*)(lds + 4096); LAS float* part = (LAS float*)(lds + 8192);
    float qv[4][4][4];
#pragma unroll
    for (int t = 0; t < 4; ++t)
#pragma unroll
        for (int c = 0; c < 4; ++c) { const u32x2 q = *(const u32x2*)(Qp + t * 1024 + 64 * c + 4 * l16); unpack4(q, qv[t][c]); }
#pragma unroll 2
    for (int it = 0; it < 8; ++it) { const int mrow = wid * 32 + it * 4 + rg; const float* kr = Kp + (size_t)mrow * 1024 + 4 * l16; float d[4] = {0.f, 0.f, 0.f, 0.f};
#pragma unroll
        for (int c = 0; c < 4; ++c) { const f32x4 kv = *(const f32x4*)(kr + 64 * c);
#pragma unroll
            for (int t = 0; t < 4; ++t) d[t] += kv[0] * qv[t][c][0] + kv[1] * qv[t][c][1] + kv[2] * qv[t][c][2] + kv[3] * qv[t][c][3]; }
#pragma unroll
        for (int t = 0; t < 4; ++t) { const float r = red16(d[t]); if (l16 == 0) sc[t * 256 + mrow] = r * 0.0625f; } }
    __syncthreads();
    if (wid < 4) { const f32x4 x = *(const LAS f32x4*)(sc + wid * 256 + lane * 4); float mx = fmaxf(fmaxf(x[0], x[1]), fmaxf(x[2], x[3])); mx = wave_max(mx);
        float e[4], sum = 0.f;
#pragma unroll
        for (int q = 0; q < 4; ++q) { e[q] = __expf(x[q] - mx); sum += e[q]; }
        sum = wave_sum(sum); const float inv = rcpf(sum);
#pragma unroll
        for (int q = 0; q < 4; ++q) pr[(lane * 4 + q) * 4 + wid] = e[q] * inv; }
    __syncthreads();
    { f32x4 acc[4];
#pragma unroll
      for (int t = 0; t < 4; ++t) acc[t] = (f32x4){0.f, 0.f, 0.f, 0.f};
#pragma unroll 8
      for (int it = 0; it < 32; ++it) { const int mrow = wid * 32 + it; const f32x4 vv = *(const f32x4*)(Vp + (size_t)mrow * 1024 + lane * 4); const f32x4 pp = *(const LAS f32x4*)(pr + mrow * 4);
#pragma unroll
          for (int t = 0; t < 4; ++t) acc[t] += pp[t] * vv; }
#pragma unroll
      for (int t = 0; t < 4; ++t) *(LAS f32x4*)(part + (wid * 4 + t) * 256 + lane * 4) = acc[t]; }
    __syncthreads();
    { const int o = tid * 2, t = o >> 8, d = o & 255; float a0 = 0.f, a1 = 0.f;
#pragma unroll
      for (int w = 0; w < 8; ++w) { const f32x2 v = *(const LAS f32x2*)(part + (w * 4 + t) * 256 + d); a0 += v[0]; a1 += v[1]; }
      const unsigned wv = pk2(a0, a1); if (!DUMMY) *(unsigned*)(Qp + t * 1024 + d) = wv; else if (wv == 0x12345678u) Qp[0] = 0; }
    __syncthreads();
}

template <bool DUMMY> __device__ __forceinline__ void sg_prompt_item(const Params& p, LAS unsigned char* lds, int item) {
    const int tid = threadIdx.x, wid = tid >> 6, lane = tid & 63, fr = lane & 15, fq = lane >> 4; unsigned char* ws = p.ws;
    const int chn = item >> 3, g = item & 7, m0 = chn * 128;
    const bf16_t* VN = (const bf16_t*)(ws + WS_GV); const bf16_t* SGW = (const bf16_t*)(ws + WS_SGW) + g * 16384; bf16_t* U = (bf16_t*)(ws + WS_Y3);
    LAS bf16_t* VT = (LAS bf16_t*)lds;
    { const int s = tid >> 2, hq = (tid & 3) * 32; const bf16_t* src = VN + (size_t)(m0 + s) * 1024 + g * 128 + hq;
#pragma unroll
      for (int c = 0; c < 4; ++c) { const u32x4 q = *(const u32x4*)(src + c * 8);
#pragma unroll
          for (int k = 0; k < 4; ++k) { VT[(hq + c * 8 + 2 * k) * 136 + s] = (bf16_t)(q[k] & 0xffffu); VT[(hq + c * 8 + 2 * k + 1) * 136 + s] = (bf16_t)(q[k] >> 16); } } }
    const int h0 = wid * 16; bf16x8 xf[4];
    const float* sgb = p.in[I_SGB] + g * 128;
    bf16x8 yf[8][4]; u32x2 uq[8]; float bias[8];
#pragma unroll
    for (int mt = 0; mt < 8; ++mt) {
#pragma unroll
        for (int ks = 0; ks < 4; ++ks) if (32 * ks <= 16 * mt + 15) yf[mt][ks] = *(const bf16x8*)(SGW + (mt * 16 + fr) * 128 + ks * 32 + fq * 8);
        uq[mt] = *(const u32x2*)(U + (size_t)(m0 + mt * 16 + fr) * 1024 + g * 128 + h0 + 4 * fq); bias[mt] = sgb[mt * 16 + fr]; }
    __syncthreads();
#pragma unroll
    for (int ks = 0; ks < 4; ++ks) xf[ks] = *(const LAS bf16x8*)(VT + (h0 + fr) * 136 + ks * 32 + fq * 8);
#pragma unroll
    for (int mt = 0; mt < 8; ++mt) { f32x4 acc = {0.f, 0.f, 0.f, 0.f};
#pragma unroll
        for (int ks = 0; ks < 4; ++ks) if (32 * ks <= 16 * mt + 15) acc = mfma16(xf[ks], yf[mt][ks], acc);
        bf16_t* up = U + (size_t)(m0 + mt * 16 + fr) * 1024 + g * 128 + h0 + 4 * fq; float uf[4]; unpack4(uq[mt], uf);
        u32x2 w; w[0] = pk2(uf[0] * (acc[0] + bias[mt]), uf[1] * (acc[1] + bias[mt])); w[1] = pk2(uf[2] * (acc[2] + bias[mt]), uf[3] * (acc[3] + bias[mt])); if (!DUMMY) *(u32x2*)up = w; else if (w[0] == 0x12345678u) up[0] = 0; }
    __syncthreads();
}
__device__ __forceinline__ void sg_sample_item(const Params& p, int item) {
    const int tid = threadIdx.x; unsigned char* ws = p.ws; const bf16_t* VN = (const bf16_t*)(ws + WS_GV); bf16_t* U = (bf16_t*)(ws + WS_Y3);
    const float* sgw = p.in[I_SGW]; const float* sgb = p.in[I_SGB];
    for (int e = tid; e < 32 * 128; e += 512) { const int r = e >> 7, c8 = (e & 127) * 8; const int m = MP + item * 32 + r, t = r & 3, g = c8 >> 7; float a[8];
#pragma unroll
        for (int k = 0; k < 8; ++k) a[k] = sgb[g * 128 + t];
        for (int s = 0; s <= t; ++s) { const float w = sgw[(g * 128 + t) * 128 + s]; const u32x4 q = *(const u32x4*)(VN + (size_t)(m - t + s) * 1024 + c8);
#pragma unroll
            for (int k = 0; k < 4; ++k) { a[2 * k] += w * bflo(q[k]); a[2 * k + 1] += w * bfhi(q[k]); } }
        bf16_t* up = U + (size_t)m * 1024 + c8; const u32x4 uq = *(const u32x4*)up; u32x4 o;
#pragma unroll
        for (int k = 0; k < 4; ++k) o[k] = pk2(bflo(uq[k]) * a[2 * k], bfhi(uq[k]) * a[2 * k + 1]);
        *(u32x4*)up = o; }
}

constexpr int Q_SATT = 0, Q_PATT = 512, Q_SGP = 1024, Q_SGS = 2048, Q_SSCAN = 2064, Q_END = 2064 + 2048;

template <int PH, bool DUMMY = false> __device__ __forceinline__ void run_phase(const Params& p, LAS unsigned char* lds) {
    unsigned char* ws = p.ws; const int G = gridDim.x, bid = blockIdx.x;
    if constexpr (PH == 0) phase0(p, lds);
    else if constexpr (PH == 1) {
        { pg8::Gemm g{(const bf16_t*)(ws + WS_HMB), (const bf16_t*)(ws + WS_WTMKV), 2048, 2048, 1024}; pg8::StaticOrder S; S.init(2048, 2048, G, (bid + 64) % G);
          EpiMem E{p.out, (bf16_t*)(ws + WS_MKB), (bf16_t*)(ws + WS_MVT)}; pg8::gemm_phase<EpiMem, pg8::StaticOrder, false>(lds, g, S, E, nullptr); }
        __syncthreads();
        { pg8::Gemm g{(const bf16_t*)(ws + WS_HB), (const bf16_t*)(ws + WS_WTIN), MT, PIN, 1024}; pg8::StaticOrder S; S.init(MT, PIN, G, bid);
          EpiZ E{(bf16_t*)(ws + WS_Y3), (bf16_t*)(ws + WS_GV), (bf16_t*)(ws + WS_SZ), (bf16_t*)(ws + WS_Y3) + (size_t)2 * MT * 1024, (bf16_t*)(ws + WS_GT), p.out};
          pg8::gemm_phase<EpiZ, pg8::StaticOrder, false>(lds, g, S, E, nullptr); }
    }
    else if constexpr (PH == 2) { const int wid = threadIdx.x >> 6, lane = threadIdx.x & 63; for (int m = wid * G + bid; m < MT; m += 24 * G) { const int mr[3] = {m, m + 8 * G, m + 16 * G}; p2_rows<3, DUMMY>(p, mr, lane); } }
    else if constexpr (PH == 11) { int kk = 256; asm volatile("" : "+s"(kk));
        pg8::Gemm g{(const bf16_t*)(ws + WS_XL), (const bf16_t*)(ws + WS_WTLORA), MP, 3072, kk}; pg8::StaticOrder S; S.init(MP, 3072, G, bid);
        EpiLora E{(bf16_t*)(ws + WS_E), (bf16_t*)(ws + WS_AV), (bf16_t*)(ws + WS_GG), p.in[I_W0], p.in[I_A0]}; pg8::gemm_phase<EpiLora, pg8::StaticOrder, false>(lds, g, S, E, nullptr);
        bf16_t* Eb = (bf16_t*)(ws + WS_E); const float* w0 = p.in[I_W0]; const float* a0 = p.in[I_A0];
        thin_gemm<1>(lds, (const bf16_t*)(ws + WS_XL), 0, (const bf16_t*)(ws + WS_WTLORA), 0, 1, 3072, kk,
            [&](int, const f32x4 (&acc)[4], f32x4 (&tot)[4], int, int) {
#pragma unroll
                for (int j = 0; j < 4; ++j) tot[j] = acc[j]; },
            [&](const f32x4 (&tot)[4], int row, int col) { const int seg = col >> 10;
#pragma unroll
                for (int j = 0; j < 4; ++j) { const int cc = (col & 1023) + 16 * j; f32x4 v = tot[j];
                    if (seg == 0) { const f32x4 bq = *(const f32x4*)(w0 + cc);
#pragma unroll
                        for (int q = 0; q < 4; ++q) v[q] = 0.60653066f * sigmoidf_(v[q] + bq[q]); }
                    else if (seg == 1) { const f32x4 bq = *(const f32x4*)(a0 + cc);
#pragma unroll
                        for (int q = 0; q < 4; ++q) v[q] = sigmoidf_(v[q] + bq[q]); }
                    u32x2 w; w[0] = pk2(v[0], v[1]); w[1] = pk2(v[2], v[3]); *(u32x2*)(Eb + (size_t)seg * 17301504 + (size_t)row * 1024 + cc) = w; } }); }
    else if constexpr (PH == 3 || PH == 10) {
#ifndef P3SPLIT
#define P3SPLIT 0
#endif
#ifndef P3SUB
#define P3SUB 31
#endif
        constexpr int SUB = DUMMY ? P3SUB : 31;
        constexpr bool DO_SCAN = (PH == 3), DO_REST = P3SPLIT ? (PH == 10) : (PH == 3);
        if (DO_SCAN && (SUB & 1) && bid < 128) { const int b = bid >> 4, h = bid & 15; scan_head(p, lds, b * 2048, 2048, h, nullptr, p.out + O_PWKV + (size_t)bid * 4096, nullptr); }
        unsigned* ctr = (unsigned*)(ws + WS_CTL) + (PH == 10 ? 1 : 0) + (DUMMY ? 2 : 0); LAS unsigned* qw = (LAS unsigned*)(lds + QW_OFF);
        const int q_lo = DO_REST ? 0 : Q_SSCAN, q_hi = DO_SCAN ? Q_END : Q_SSCAN;
        unsigned nxt = 0; if (threadIdx.x == 0) nxt = atomicAdd(ctr, 1u);
        for (;;) {
            __syncthreads();
            if (threadIdx.x == 0) { *qw = nxt; nxt = atomicAdd(ctr, 1u); }
            __syncthreads();
            const int it = (int)*qw + q_lo; if (it >= q_hi) break;
            if (it < Q_PATT) { if (SUB & 2) attn_sample_item<DUMMY>(p, lds, it); }
            else if (it < Q_SGP) { if (SUB & 4) attn_prompt_item<DUMMY>(p, lds, it - Q_PATT); }
            else if (it < Q_SGS) { if (SUB & 8) sg_prompt_item<DUMMY>(p, lds, it - Q_SGP); }
            else if (it < Q_SSCAN) { if (!DUMMY) sg_sample_item(p, it - Q_SGS); }
            else if (SUB & 16) { const int bh = it - Q_SSCAN, b = bh >> 4, h = bh & 15;
                scan_head(p, lds, MP + b * 4, 4, h, p.in[I_SWKV] + (size_t)bh * 4096, p.out + O_SWKV + (size_t)bh * 4096, p.in[I_SSH] + (size_t)b * PSH); }
        }
    }
    else if constexpr (PH == 4) { pg8::Gemm g{(const bf16_t*)(ws + WS_Y3), (const bf16_t*)(ws + WS_WTBR), 3 * MT, 3072, 1024}; BranchOrder S{G, bid};
        EpiMerge E{(const bf16_t*)(ws + WS_GT), (float*)(ws + WS_MF), (bf16_t*)(ws + WS_MB)}; pg8::gemm_phase<EpiMerge, BranchOrder, false>(lds, g, S, E, nullptr);
        const bf16_t* GT = (const bf16_t*)(ws + WS_GT); bf16_t* MB = (bf16_t*)(ws + WS_MB);
        thin_gemm<4>(lds, (const bf16_t*)(ws + WS_Y3), (size_t)MT * 1024, (const bf16_t*)(ws + WS_WTBR), (size_t)1048576, 3, 1024, 1024,
            [&](int n, const f32x4 (&acc)[4], f32x4 (&tot)[4], int row, int col) {
#pragma unroll
                for (int j = 0; j < 4; ++j) { float gf[4]; unpack4(*(const u32x2*)(GT + (size_t)row * 3072 + n * 1024 + col + 16 * j), gf);
                    tot[j][0] += acc[j][0] * gf[0]; tot[j][1] += acc[j][1] * gf[1]; tot[j][2] += acc[j][2] * gf[2]; tot[j][3] += acc[j][3] * gf[3]; } },
            [&](const f32x4 (&tot)[4], int row, int col) {
#pragma unroll
                for (int j = 0; j < 4; ++j) { u32x2 w; w[0] = pk2(tot[j][0], tot[j][1]); w[1] = pk2(tot[j][2], tot[j][3]); *(u32x2*)(MB + (size_t)row * 1024 + col + 16 * j) = w; } }); }
    else if constexpr (PH == 5) { pg8::Gemm g{(const bf16_t*)(ws + WS_MB), (const bf16_t*)(ws + WS_WTOUT), MP, 1024, 1024}; pg8::StaticOrder S; S.init(MP, 1024, G, bid);
        EpiRes E{p.in[I_XP], p.in[I_XS], (float*)(ws + WS_X1), (bf16_t*)(ws + WS_X1B), (float*)(ws + (DUMMY ? WS_XL : WS_SSQ1))}; pg8::gemm_phase<EpiRes, pg8::StaticOrder, false>(lds, g, S, E, nullptr);
        const float* xs = p.in[I_XS]; float* X1 = (float*)(ws + WS_X1); bf16_t* X1B = (bf16_t*)(ws + WS_X1B); float* ssq = (float*)(ws + (DUMMY ? WS_XL : WS_SSQ1));
        thin_gemm<4>(lds, (const bf16_t*)(ws + WS_MB), 0, (const bf16_t*)(ws + WS_WTOUT), 0, 1, 1024, 1024,
            [&](int, const f32x4 (&acc)[4], f32x4 (&tot)[4], int, int) {
#pragma unroll
                for (int j = 0; j < 4; ++j) tot[j] = acc[j]; },
            [&](const f32x4 (&tot)[4], int row, int col) { float ss = 0.f;
#pragma unroll
                for (int j = 0; j < 4; ++j) { const f32x4 v = tot[j] + *(const f32x4*)(xs + (size_t)(row - MP) * 1024 + col + 16 * j); *(f32x4*)(X1 + (size_t)row * 1024 + col + 16 * j) = v;
                    u32x2 w; w[0] = pk2(v[0], v[1]); w[1] = pk2(v[2], v[3]); *(u32x2*)(X1B + (size_t)row * 1024 + col + 16 * j) = w; ss += v[0] * v[0] + v[1] * v[1] + v[2] * v[2] + v[3] * v[3]; }
                ss += __shfl_xor(ss, 16); ss += __shfl_xor(ss, 32); if ((threadIdx.x & 63) < 16) atomicAdd(ssq + row, ss); }); }
    else if constexpr (PH == 6) { pg8::Gemm g{(const bf16_t*)(ws + WS_X1B), (const bf16_t*)(ws + WS_WTUP), MP, DFF, 1024}; pg8::StaticOrder S; S.init(MP, DFF, G, bid);
        EpiUp E{(const float*)(ws + WS_SSQ1), (bf16_t*)(ws + WS_HID)}; pg8::gemm_phase<EpiUp, pg8::StaticOrder, false>(lds, g, S, E, nullptr);
        const float* ssq = (const float*)(ws + WS_SSQ1); bf16_t* H = (bf16_t*)(ws + WS_HID);
        thin_gemm<1>(lds, (const bf16_t*)(ws + WS_X1B), 0, (const bf16_t*)(ws + WS_WTUP), 0, 1, DFF, 1024,
            [&](int, const f32x4 (&acc)[4], f32x4 (&tot)[4], int, int) {
#pragma unroll
                for (int j = 0; j < 4; ++j) tot[j] = acc[j]; },
            [&](const f32x4 (&tot)[4], int row, int col) { const float rs = rsqrtf(ssq[row] * (1.f / 1024.f) + 1e-6f);
#pragma unroll
                for (int j = 0; j < 4; ++j) { float h[4];
#pragma unroll
                    for (int q = 0; q < 4; ++q) { const float a = fmaxf(tot[j][q] * rs, 0.f); h[q] = a * a; }
                    u32x2 w; w[0] = pk2(h[0], h[1]); w[1] = pk2(h[2], h[3]); *(u32x2*)(H + (size_t)row * DFF + col + 16 * j) = w; } }); }
    else if constexpr (PH == 7) { pg8::Gemm g{(const bf16_t*)(ws + WS_HID), (const bf16_t*)(ws + WS_WTDN), MP, 1024, DFF}; pg8::StaticOrder S; S.init(MP, 1024, G, bid);
        const float* x1 = (const float*)(ws + WS_X1);
        EpiRes E{x1, x1 + (size_t)MP * 1024, (float*)(ws + WS_X2), nullptr, (float*)(ws + (DUMMY ? WS_XL : WS_SSQ2))}; pg8::gemm_phase<EpiRes, pg8::StaticOrder, false>(lds, g, S, E, nullptr);
        float* X2 = (float*)(ws + WS_X2); float* ssq = (float*)(ws + (DUMMY ? WS_XL : WS_SSQ2));
        thin_gemm<4>(lds, (const bf16_t*)(ws + WS_HID), 0, (const bf16_t*)(ws + WS_WTDN), 0, 1, 1024, DFF,
            [&](int, const f32x4 (&acc)[4], f32x4 (&tot)[4], int, int) {
#pragma unroll
                for (int j = 0; j < 4; ++j) tot[j] = acc[j]; },
            [&](const f32x4 (&tot)[4], int row, int col) { float ss = 0.f;
#pragma unroll
                for (int j = 0; j < 4; ++j) { const f32x4 v = tot[j] + *(const f32x4*)(x1 + (size_t)row * 1024 + col + 16 * j); *(f32x4*)(X2 + (size_t)row * 1024 + col + 16 * j) = v;
                    ss += v[0] * v[0] + v[1] * v[1] + v[2] * v[2] + v[3] * v[3]; }
                ss += __shfl_xor(ss, 16); ss += __shfl_xor(ss, 32); if ((threadIdx.x & 63) < 16) atomicAdd(ssq + row, ss); }); }
    else if constexpr (PH == 8) { const float* x2 = (const float*)(ws + WS_X2); const float* ssq = (const float*)(ws + WS_SSQ2); const float* gf = p.in[I_NFG];
        const int wid = threadIdx.x >> 6, lane = threadIdx.x & 63;
        for (int r = bid * 8 + wid; r < MT; r += G * 8) { const float rs = rsqrtf(ssq[r] * (1.f / 1024.f) + 1e-6f);
#pragma unroll
            for (int c = 0; c < 4; ++c) { const int col = c * 256 + lane * 4; const f32x4 v = *(const f32x4*)(x2 + (size_t)r * 1024 + col), g = *(const f32x4*)(gf + col);
                *(f32x4*)(p.out + (size_t)r * 1024 + col) = v * rs * g; } } }
}
#ifdef DIAG_PHASES
template <int PH> __global__ __launch_bounds__(512, 2) void diag_phase(Params p) {
    extern __shared__ __attribute__((aligned(16))) unsigned char shm[];
    run_phase<PH>(p, (LAS unsigned char*)shm);
}
template __global__ void diag_phase<0>(Params); template __global__ void diag_phase<1>(Params); template __global__ void diag_phase<2>(Params);
template __global__ void diag_phase<3>(Params); template __global__ void diag_phase<4>(Params); template __global__ void diag_phase<5>(Params);
template __global__ void diag_phase<6>(Params); template __global__ void diag_phase<7>(Params); template __global__ void diag_phase<8>(Params);
#endif
template <int PH, bool DUMMY = false> __device__ __forceinline__ void phase_step(int ph_lo, int ph_hi, LAS unsigned char* lds, cg::grid_group& grid, unsigned& nbar) {
    constexpr int PE = (PH == 10) ? 3 : (PH == 11 ? 2 : PH);
    if (ph_lo <= PE && PE < ph_hi) {
        if (PH > ph_lo) {
            asm volatile("s_waitcnt vmcnt(0)" ::: "memory");
            __syncthreads();
            ++nbar;
            if (threadIdx.x == 0) {
                const __attribute__((address_space(4))) Params* pq = (const __attribute__((address_space(4))) Params*)__builtin_amdgcn_kernarg_segment_ptr();
                __attribute__((address_space(1))) unsigned char* wsb = (__attribute__((address_space(1))) unsigned char*)pq->ws;
                if (nbar == 1) {
                    __attribute__((address_space(1))) unsigned* bar = (__attribute__((address_space(1))) unsigned*)(wsb + WS_CTL + 128);
                    __builtin_amdgcn_fence(__ATOMIC_RELEASE, "agent"); asm volatile("s_waitcnt vmcnt(0)" ::: "memory");
                    __hip_atomic_fetch_add(bar, 1u, __ATOMIC_RELAXED, __HIP_MEMORY_SCOPE_AGENT);
                    while (__hip_atomic_load(bar, __ATOMIC_RELAXED, __HIP_MEMORY_SCOPE_AGENT) < gridDim.x) __builtin_amdgcn_s_sleep(2);
                    __builtin_amdgcn_fence(__ATOMIC_ACQUIRE, "agent"); asm volatile("s_waitcnt vmcnt(0)" ::: "memory");
                } else {
                    __attribute__((address_space(1))) unsigned* c2 = (__attribute__((address_space(1))) unsigned*)(wsb + WS_CTL2);
                    const unsigned xcc = (unsigned)__builtin_amdgcn_s_getreg((3 << 11) | 20) & 0xFu;
                    const unsigned nx = __hip_atomic_load(c2 + 1024 + xcc, __ATOMIC_RELAXED, __HIP_MEMORY_SCOPE_AGENT);
                    unsigned nxcc = 0;
                    for (int j = 0; j < 16; ++j) nxcc += __hip_atomic_load(c2 + 1024 + j, __ATOMIC_RELAXED, __HIP_MEMORY_SCOPE_AGENT) != 0u;
                    const unsigned k = nbar - 1;
                    const unsigned old = __hip_atomic_fetch_add(c2 + 64 * xcc, 1u, __ATOMIC_RELAXED, __HIP_MEMORY_SCOPE_AGENT);
                    if (old + 1 == k * nx) {
                        __builtin_amdgcn_fence(__ATOMIC_RELEASE, "agent"); asm volatile("s_waitcnt vmcnt(0)" ::: "memory");
                        const unsigned t = __hip_atomic_fetch_add(c2 + 1088, 1u, __ATOMIC_RELAXED, __HIP_MEMORY_SCOPE_AGENT);
                        if (t + 1 == k * nxcc) __hip_atomic_store(c2 + 1152, k, __ATOMIC_RELAXED, __HIP_MEMORY_SCOPE_AGENT);
                    }
                    while (__hip_atomic_load(c2 + 1152, __ATOMIC_RELAXED, __HIP_MEMORY_SCOPE_AGENT) < k) __builtin_amdgcn_s_sleep(1);
                    __builtin_amdgcn_fence(__ATOMIC_ACQUIRE, "agent"); asm volatile("s_waitcnt vmcnt(0)" ::: "memory");
                }
            }
            __syncthreads();
        }
        const __attribute__((address_space(4))) Params* pp = (const __attribute__((address_space(4))) Params*)__builtin_amdgcn_kernarg_segment_ptr();
        asm volatile("" : "+s"(pp) :: "memory");
        Params p;
#pragma unroll
        for (int i = 0; i < 33; ++i) p.in[i] = (const float*)(__attribute__((address_space(1))) const float*)pp->in[i];
        p.out = (float*)(__attribute__((address_space(1))) float*)pp->out; p.ws = (unsigned char*)(__attribute__((address_space(1))) unsigned char*)pp->ws;
        run_phase<PH, DUMMY>(p, lds);
    }
}
template <> __device__ __forceinline__ void run_phase<9, false>(const Params& p, LAS unsigned char* lds) {
    unsigned char* ws = p.ws; const int G = gridDim.x, bid = blockIdx.x; const int wid = threadIdx.x >> 6, lane = threadIdx.x & 63;
    for (int r = bid * 8 + wid; r < MT; r += G * 8) {
#pragma unroll
        for (int c = 0; c < 4; ++c) { const int col = c * 256 + lane * 4; f32x4 o;
#if DBG == 1
            const bf16_t* y3 = (const bf16_t*)(ws + WS_Y3); float a[4], b[4], d[4];
            unpack4(*(const u32x2*)(y3 + (size_t)r * 1024 + col), a); unpack4(*(const u32x2*)(y3 + (size_t)(MT + r) * 1024 + col), b); unpack4(*(const u32x2*)(y3 + (size_t)(2 * MT + r) * 1024 + col), d);
            for (int q = 0; q < 4; ++q) o[q] = a[q] + 2.f * b[q] + 4.f * d[q];
#elif DBG == 2
            float a[4]; unpack4(*(const u32x2*)((const bf16_t*)(ws + WS_MB) + (size_t)r * 1024 + col), a); for (int q = 0; q < 4; ++q) o[q] = a[q];
#elif DBG == 3
            o = *(const f32x4*)((const float*)(ws + WS_X1) + (size_t)r * 1024 + col);
#elif DBG == 4
            float a[4], b[4]; unpack4(*(const u32x2*)((const bf16_t*)(ws + WS_HID) + (size_t)r * DFF + col), a); unpack4(*(const u32x2*)((const bf16_t*)(ws + WS_HID) + (size_t)r * DFF + 2048 + col), b); for (int q = 0; q < 4; ++q) o[q] = a[q] + b[q];
#elif DBG == 5
            const bf16_t* y3 = (const bf16_t*)(ws + WS_Y3) + (size_t)(DBGSEL * MT + r) * 1024 + col; float a[4]; unpack4(*(const u32x2*)y3, a); for (int q = 0; q < 4; ++q) o[q] = a[q];
#else
            o = (f32x4){0.f, 0.f, 0.f, 0.f};
#endif
            *(f32x4*)(p.out + (size_t)r * 1024 + col) = o; } }
}
__global__ __launch_bounds__(512, 2) void mega(Params p, int ph_lo, int ph_hi) {
    extern __shared__ __attribute__((aligned(16))) unsigned char shm[];
    LAS unsigned char* lds = (LAS unsigned char*)shm;
    cg::grid_group grid = cg::this_grid();
#ifndef DUP
#define DUP -1
#endif
    unsigned nbar = 0;
    { const __attribute__((address_space(4))) Params* pq = (const __attribute__((address_space(4))) Params*)__builtin_amdgcn_kernarg_segment_ptr();
      __attribute__((address_space(1))) unsigned char* wsb = (__attribute__((address_space(1))) unsigned char*)pq->ws;
      if (ph_lo < 0) grid.sync();
      if (threadIdx.x == 0) { const unsigned xcc = (unsigned)__builtin_amdgcn_s_getreg((3 << 11) | 20) & 0xFu;
          __hip_atomic_fetch_add((__attribute__((address_space(1))) unsigned*)(wsb + WS_CTL2) + 1024 + xcc, 1u, __ATOMIC_RELAXED, __HIP_MEMORY_SCOPE_AGENT); } }
#define PSTEP(k) if (DUP == k) phase_step<k, true>(ph_lo, ph_hi, lds, grid, nbar); phase_step<k, false>(ph_lo, ph_hi, lds, grid, nbar);
    PSTEP(0) PSTEP(1) PSTEP(2) PSTEP(11) PSTEP(3)
#if P3SPLIT
    PSTEP(10)
#endif
    PSTEP(4) PSTEP(5) PSTEP(6) PSTEP(7) PSTEP(8)
#if DBG
    phase_step<9>(ph_lo, 10, lds, grid, nbar);
#endif
}

extern "C" void kernel_launch(void* const* d_in, const int* in_sizes, int n_in, void* d_out, int out_size, void* d_ws, size_t ws_size, hipStream_t stream) {
    static int grid_blocks = 0;
    if (grid_blocks == 0) {
        if (n_in != 33 || out_size != (int)O_END || ws_size < WS_END) { fprintf(stderr, "kernel_launch: unexpected shapes (n_in %d out %d ws %zu, need ws %zu)\n", n_in, out_size, ws_size, (size_t)WS_END); grid_blocks = -1; return; }
        int dev = 0, cus = 0, per_cu = 0;
        hipGetDevice(&dev); hipDeviceGetAttribute(&cus, hipDeviceAttributeMultiprocessorCount, dev);
        hipFuncSetAttribute((const void*)mega, hipFuncAttributeMaxDynamicSharedMemorySize, LDS_BYTES);
        hipOccupancyMaxActiveBlocksPerMultiprocessor(&per_cu, (const void*)mega, 512, LDS_BYTES);
        if (per_cu < 1) { fprintf(stderr, "kernel_launch: occupancy query says %d blocks per CU\n", per_cu); grid_blocks = -1; return; }
        grid_blocks = cus * 1;
        if (grid_blocks < 128) { fprintf(stderr, "kernel_launch: needs >= 128 CUs\n"); grid_blocks = -1; return; }
    }
    if (grid_blocks < 0) return;
    hipMemsetAsync((char*)d_ws + WS_CTL, 0, WS_WTIN - WS_CTL, stream);
    Params p{};
    for (int i = 0; i < 33; ++i) p.in[i] = (const float*)d_in[i];
    p.out = (float*)d_out; p.ws = (unsigned char*)d_ws;
#if DBG
    int lo = 0, hi = DBG_HI;
#else
    int lo = 0, hi = 9;
#endif
    void* args[] = {&p, &lo, &hi};
    hipError_t e = hipLaunchCooperativeKernel((const void*)mega, dim3(grid_blocks), dim3(512), args, LDS_BYTES, stream);
    if (e != hipSuccess) fprintf(stderr, "cooperative launch failed: %s (grid %d)\n", hipGetErrorString(e), grid_blocks);
}
```

```cpp
#include <hip/hip_runtime.h>
#include <hip/hip_cooperative_groups.h>
#include <cstdio>
namespace cg = cooperative_groups;
namespace pg8 {
#define PG8_LAS __attribute__((address_space(3)))
typedef unsigned short bf16_t;
typedef short bf16x8 __attribute__((ext_vector_type(8)));
typedef float f32x4 __attribute__((ext_vector_type(4)));
typedef unsigned u32x4 __attribute__((ext_vector_type(4)));
constexpr int BM = 256, BK = 64, HALF = 128, HTB = HALF * BK * 2  , STAGE_BYTES = 8 * HTB, NXCD = 8, WGM = 8;

__host__ __device__ __forceinline__ int lds_byte(int r, int c) { const int st = (r >> 4) * 2 + (c >> 5), rr = r & 15, cc = c & 31, ob = rr * 64 + cc * 2; return st * 1024 + (ob ^ (((ob >> 9) & 1) << 5)); }
__host__ __device__ __forceinline__ void stage_rc(int b, int& R, int& C) { const int st = b / 1024, sb = b % 1024, swz = sb ^ (((sb >> 9) & 1) << 5); R = (st >> 1) * 16 + swz / 64; C = (st & 1) * 32 + (swz % 64) / 2; }
__host__ __device__ __forceinline__ int perm32(int rho) { const int n = rho >> 4, i = rho & 15; return 8 * (i >> 2) + 4 * n + (i & 3); }

struct Unit { int pm, pn; };
struct Gemm { const bf16_t* A; const bf16_t* Bt; int M, N, K; };

struct StaticOrder {
    int nM, nN, nwg, G, c;
    __host__ __device__ void init(int M, int N, int G_, int c_) { nM = M / BM; nN = N / BM; nwg = nM * nN; G = G_; c = c_; }
    __host__ __device__ bool next(int i, Unit& u) const {
        const long L = (long)i * G + c; if (L >= nwg) return false;
        int wgid = (int)L; { const int q = nwg / NXCD, r = nwg % NXCD, xcd = wgid % NXCD, off = wgid / NXCD; wgid = (xcd < r ? xcd * (q + 1) : r * (q + 1) + (xcd - r) * q) + off; }
        const int nig = WGM * nN, gid = wgid / nig, fm = gid * WGM, gsz = (nM - fm) < WGM ? (nM - fm) : WGM;
        u.pm = fm + ((wgid % nig) % gsz); u.pn = (wgid % nig) / gsz; return true;
    }
    __device__ __forceinline__ void a_ready(const Unit&) const {}
    __device__ __forceinline__ void done(const Unit&) const {}
};
__device__ __forceinline__ unsigned cvt_pk_bf16(float lo, float hi) { unsigned r; asm volatile("v_cvt_pk_bf16_f32 %0, %1, %2" : "=v"(r) : "v"(lo), "v"(hi)); return r; }
template <class Epi, class Sched, bool STAMP = false>
__device__ __forceinline__ void gemm_phase(PG8_LAS unsigned char* lds, const Gemm g, const Sched& S, const Epi& E, unsigned long long* stamps) {
    const int tid = threadIdx.x, wid = __builtin_amdgcn_readfirstlane(tid >> 6), lane = tid & 63, wr = wid >> 2, wc = wid & 3, fr = lane & 15, fq = lane >> 4;
    const int K = g.K, nt = K / BK;
    int ts_lo = 0, ts_hi = 0, nts = 0; const unsigned long long rt_entry = STAMP ? (unsigned long long)wall_clock64() : 0ull;
#define PG8_STAMP() do { if (STAMP && wid == 0 && nts < 64) { const unsigned long long _c = (unsigned long long)clock64(); \
        ts_lo = (lane == nts) ? (int)(unsigned)_c : ts_lo; ts_hi = (lane == nts) ? (int)(unsigned)(_c >> 32) : ts_hi; ++nts; } } while (0)
    PG8_STAMP();
    unsigned voffA[2], voffB[2];
#pragma unroll
    for (int i = 0; i < 2; ++i) { int R, C; stage_rc(tid * 16 + i * 8192, R, C); const int Rb = Epi::PERM ? ((R & ~31) + perm32(R & 31)) : R;
        voffA[i] = (unsigned)(R * K + C) * 2u; voffB[i] = (unsigned)(Rb * K + C) * 2u; }
    const size_t kstep = (size_t)(BK * 2);
    const size_t hstep = (size_t)HALF * K * 2;
    const size_t tstep = 2 * hstep;
    const unsigned ldsw = (unsigned)wid * 1024u;
    const int aoff = lds_byte(wr * 64 + fr, fq * 8), boff = lds_byte(wc * 32 + fr, fq * 8);
#define PG8_SA(b, h) (((b) * 2 + (h)) * HTB)
#define PG8_SB(b, h) ((4 + (b) * 2 + (h)) * HTB)
#define PG8_STAGE(bufoff, gbase, voff) do { _Pragma("unroll") for (int _i = 0; _i < 2; ++_i) \
        __builtin_amdgcn_global_load_lds((const unsigned*)((const char*)(gbase) + (voff)[_i]), (PG8_LAS unsigned*)(lds + (bufoff) + ldsw + _i * 8192), 16, 0, 0); } while (0)
#define PG8_LDA(dst, b, h) do { _Pragma("unroll") for (int m = 0; m < 4; ++m) _Pragma("unroll") for (int k = 0; k < 2; ++k) dst[m][k] = *(const PG8_LAS bf16x8*)(lds + PG8_SA(b, h) + aoff + m * 2048 + k * 1024); } while (0)
#define PG8_LDB(dst, b, h) do { _Pragma("unroll") for (int n = 0; n < 2; ++n) _Pragma("unroll") for (int k = 0; k < 2; ++k) dst[n][k] = *(const PG8_LAS bf16x8*)(lds + PG8_SB(b, h) + boff + n * 2048 + k * 1024); } while (0)
#define PG8_MMA(ai, bj, At, Bt) do { __builtin_amdgcn_s_setprio(1); _Pragma("unroll") for (int m = 0; m < 4; ++m) _Pragma("unroll") for (int n = 0; n < 2; ++n) _Pragma("unroll") for (int k = 0; k < 2; ++k) \
        acc[ai][bj][m][n] = __builtin_amdgcn_mfma_f32_16x16x32_bf16(Bt[n][k], At[m][k], acc[ai][bj][m][n], 0, 0, 0); __builtin_amdgcn_s_setprio(0); } while (0)
#define PG8_WAIT_V(n) asm volatile("s_waitcnt vmcnt(" #n ")" ::: "memory")
#define PG8_WAIT_L(n) asm volatile("s_waitcnt lgkmcnt(" #n ")" ::: "memory")
#define PG8_BAR __builtin_amdgcn_s_barrier()
#define PG8_SCHED __builtin_amdgcn_sched_barrier(0)
    Unit cur, nxt; int ui = 0;
    if (!S.next(0, cur)) return;
    f32x4 acc[2][2][4][2];
#pragma unroll
    for (int a = 0; a < 2; ++a)
#pragma unroll
        for (int b = 0; b < 2; ++b)
#pragma unroll
            for (int m = 0; m < 4; ++m)
#pragma unroll
                for (int n = 0; n < 2; ++n) acc[a][b][m][n] = (f32x4){0.f, 0.f, 0.f, 0.f};
    bf16x8 At[4][2], B0[2][2], B1[2][2];
    const char* cA = (const char*)g.A + (size_t)cur.pm * tstep; const char* cB = (const char*)g.Bt + (size_t)cur.pn * tstep;
    S.a_ready(cur);
    PG8_STAGE(PG8_SB(0, 0), cB, voffB); PG8_STAGE(PG8_SA(0, 0), cA, voffA); PG8_STAGE(PG8_SB(0, 1), cB + hstep, voffB); PG8_STAGE(PG8_SA(0, 1), cA + hstep, voffA);
    if (wr == 1) PG8_BAR;
    PG8_WAIT_V(4); PG8_BAR;
    PG8_STAGE(PG8_SB(1, 0), cB + kstep, voffB); PG8_STAGE(PG8_SA(1, 0), cA + kstep, voffA); PG8_STAGE(PG8_SB(1, 1), cB + hstep + kstep, voffB);
    PG8_WAIT_V(6); PG8_BAR;
    PG8_STAMP();
    for (;;) {
        const bool has_next = S.next(ui + 1, nxt);
        const char* nA = has_next ? (const char*)g.A + (size_t)nxt.pm * tstep : cA; const char* nB = has_next ? (const char*)g.Bt + (size_t)nxt.pn * tstep : cB;
        for (int t = 0; t < nt; t += 2) {
            const bool last = (t == nt - 2);
            const char* a1 = cA + (size_t)(t + 1) * kstep;
            const char* a2 = last ? nA : cA + (size_t)(t + 2) * kstep; const char* b2 = last ? nB : cB + (size_t)(t + 2) * kstep;
            const char* a3 = a2 + kstep; const char* b3 = b2 + kstep;
            if (last && has_next) S.a_ready(nxt);
            PG8_LDB(B0, 0, 0); PG8_SCHED; PG8_LDA(At, 0, 0); PG8_STAGE(PG8_SA(1, 1), a1 + hstep, voffA);
            PG8_WAIT_L(8); PG8_BAR; PG8_WAIT_L(0); PG8_MMA(0, 0, At, B0); PG8_BAR; PG8_SCHED;
            PG8_LDB(B1, 0, 1); PG8_STAGE(PG8_SB(0, 0), b2, voffB);
            PG8_BAR; PG8_WAIT_L(0); PG8_MMA(0, 1, At, B1); PG8_BAR;
            PG8_LDA(At, 0, 1); PG8_STAGE(PG8_SA(0, 0), a2, voffA);
            PG8_BAR; PG8_WAIT_L(0); PG8_MMA(1, 0, At, B0); PG8_BAR; PG8_SCHED;
            PG8_STAGE(PG8_SB(0, 1), b2 + hstep, voffB);
            PG8_WAIT_V(6); PG8_BAR; PG8_MMA(1, 1, At, B1); PG8_BAR;
            PG8_LDB(B0, 1, 0); PG8_SCHED; PG8_LDA(At, 1, 0); PG8_STAGE(PG8_SA(0, 1), a2 + hstep, voffA);
            PG8_WAIT_L(8); PG8_BAR; PG8_WAIT_L(0); PG8_MMA(0, 0, At, B0); PG8_BAR; PG8_SCHED;
            PG8_LDB(B1, 1, 1); PG8_STAGE(PG8_SB(1, 0), b3, voffB);
            PG8_BAR; PG8_WAIT_L(0); PG8_MMA(0, 1, At, B1); PG8_BAR;
            PG8_LDA(At, 1, 1); PG8_STAGE(PG8_SA(1, 0), a3, voffA);
            PG8_BAR; PG8_WAIT_L(0); PG8_MMA(1, 0, At, B0); PG8_BAR; PG8_SCHED;
            PG8_STAGE(PG8_SB(1, 1), b3 + hstep, voffB);
            PG8_WAIT_V(6); PG8_BAR; PG8_MMA(1, 1, At, B1); PG8_BAR;
        }
        PG8_STAMP();
        if constexpr (!Epi::AFTER_DRAIN) { E(acc, cur, wr, wc, fr, fq); S.done(cur); }
        PG8_STAMP();
        if (!has_next) break;
#pragma unroll
        for (int a = 0; a < 2; ++a)
#pragma unroll
            for (int b = 0; b < 2; ++b)
#pragma unroll
                for (int m = 0; m < 4; ++m)
#pragma unroll
                    for (int n = 0; n < 2; ++n) acc[a][b][m][n] = (f32x4){0.f, 0.f, 0.f, 0.f};
        cur = nxt; cA = nA; cB = nB; ++ui;
    }
    PG8_WAIT_V(0);
    if (wr == 0) PG8_BAR;
    PG8_BAR;
    if constexpr (Epi::AFTER_DRAIN) { E.fused(acc, cur, wr, wc, fr, fq, lds, wid, lane); S.done(cur); }
    PG8_STAMP();
    if (STAMP && wid == 0) { stamps[lane] = lane < nts ? (((unsigned long long)(unsigned)ts_hi << 32) | (unsigned)ts_lo) : 0ull;
        if (lane == 62) stamps[62] = rt_entry; if (lane == 63) stamps[63] = (unsigned long long)wall_clock64(); }
#undef PG8_STAMP
#undef PG8_SA
#undef PG8_SB
#undef PG8_STAGE
#undef PG8_LDA
#undef PG8_LDB
#undef PG8_MMA
#undef PG8_WAIT_V
#undef PG8_WAIT_L
#undef PG8_BAR
#undef PG8_SCHED
}
}

using pg8::bf16_t; using pg8::bf16x8; using pg8::f32x4; using pg8::u32x4;
typedef unsigned u32x2 __attribute__((ext_vector_type(2)));
typedef float f32x2 __attribute__((ext_vector_type(2)));
#define LAS __attribute__((address_space(3)))
#ifndef DBG
#define DBG 0
#endif
#ifndef DBGSEL
#define DBGSEL 0
#endif

constexpr int MP = 16384, MS = 512, MT = 16896, DM = 1024, PIN = 9472, PSH = 3328, DFF = 4096;
constexpr int NPANEL = MT / 256;
constexpr size_t O_YP = 0, O_YS = 16777216, O_PSH = 17301504, O_PWKV = 17328128, O_PMK = 17852416, O_PMV = 19949568,
                 O_SSH = 22046720, O_SWKV = 22472704, O_SGV = 30861312, O_END = 31385600;
constexpr size_t WS_CTL = 0, WS_CTL2 = 256, WS_SSQ1 = 256 + 8192, WS_SSQ2 = WS_SSQ1 + 67584, WS_WTIN = WS_SSQ2 + 67584,
    WS_WTBR = WS_WTIN + 19398656, WS_WTOUT = WS_WTBR + 6291456, WS_WTUP = WS_WTOUT + 2097152, WS_WTDN = WS_WTUP + 8388608,
    WS_WTMKV = WS_WTDN + 8388608, WS_WTW2 = WS_WTMKV + 4194304, WS_WTA2 = WS_WTW2 + 131072, WS_WTG2 = WS_WTA2 + 131072,
    WS_SGW = WS_WTG2 + 262144, WS_HMB = WS_SGW + 262144, WS_MKB = WS_HMB + 4194304, WS_MVT = WS_MKB + 4194304,
    WS_Y3 = WS_MVT + 4194304, WS_GV = WS_Y3 + 103809024, WS_SZ = WS_GV + 34603008, WS_GT = WS_SZ + 112459776,
    WS_HB = WS_GT + 103809024, WS_AV = WS_HB + 34603008, WS_GG = WS_AV + 34603008, WS_XL = WS_GG + 34603008, WS_WTLORA = WS_XL + 8650752, WS_END = WS_WTLORA + 1572864;
constexpr size_t WS_MF = WS_SZ, WS_MB = WS_GV, WS_X1 = WS_GT, WS_X1B = WS_HB, WS_HID = WS_Y3, WS_X2 = WS_SZ, WS_E = WS_HB;
constexpr int LDS_BYTES = 131072 + 256;
constexpr int QW_OFF = 131072;

struct Params { const float* in[33]; float* out; unsigned char* ws; };

enum { I_XP = 0, I_XS, I_MEM, I_CK, I_CV, I_SSH, I_SWKV, I_N1G, I_WIN, I_MU, I_LNG, I_LNB, I_SGW, I_SGB, I_W0, I_WW2, I_A0, I_WA2,
       I_WG2, I_KK, I_KA, I_RK, I_LXG, I_LXB, I_MNG, I_WMK, I_WMV, I_WBR, I_WOUT, I_N2G, I_WUP, I_WDN, I_NFG };

__device__ __forceinline__ float bflo(unsigned u) { return __uint_as_float(u << 16); }
__device__ __forceinline__ float bfhi(unsigned u) { return __uint_as_float(u & 0xffff0000u); }
typedef __bf16 bf2_t __attribute__((ext_vector_type(2)));
__device__ __forceinline__ unsigned pk2(float lo, float hi) { const f32x2 v = {lo, hi}; const bf2_t b = __builtin_convertvector(v, bf2_t); return __builtin_bit_cast(unsigned, b); }
__device__ __forceinline__ float rcpf(float x) { return __builtin_amdgcn_rcpf(x); }
__device__ __forceinline__ float sigmoidf_(float x) { return rcpf(1.f + __expf(-x)); }
__device__ __forceinline__ float gelu_tanh(float x) { const float t = 1.5957691216f * (x + 0.044715f * x * x * x); return x * sigmoidf_(t); }
__device__ __forceinline__ float tanhf_(float x) { return 1.f - 2.f * rcpf(__expf(2.f * x) + 1.f); }
template <int CTRL> __device__ __forceinline__ float dpp_mov(float x) { return __int_as_float(__builtin_amdgcn_update_dpp(0, __float_as_int(x), CTRL, 0xF, 0xF, true)); }
__device__ __forceinline__ float red8(float x) { x += dpp_mov<0xB1>(x); x += dpp_mov<0x4E>(x); x += dpp_mov<0x141>(x); return x; }
__device__ __forceinline__ float red16(float x) { x = red8(x); x += dpp_mov<0x140>(x); return x; }
__device__ __forceinline__ float wave_sum(float x) { x = red16(x); x += __shfl_xor(x, 16); x += __shfl_xor(x, 32); return x; }
__device__ __forceinline__ float wave_max(float x) {
#pragma unroll
    for (int o = 1; o < 64; o <<= 1) x = fmaxf(x, __shfl_xor(x, o));
    return x; }
__device__ __forceinline__ f32x4 mfma16(bf16x8 a, bf16x8 b, f32x4 c) { return __builtin_amdgcn_mfma_f32_16x16x32_bf16(a, b, c, 0, 0, 0); }
__device__ __forceinline__ void unpack4(u32x2 q, float (&o)[4]) { o[0] = bflo(q[0]); o[1] = bfhi(q[0]); o[2] = bflo(q[1]); o[3] = bfhi(q[1]); }

struct TJob { const float* src; bf16_t* dst; const float* gain; int K, N, ldd; };
__device__ __forceinline__ void transpose_tile(const TJob& j, int tile, LAS float* t) {
    const int tid = threadIdx.x; const int tn = j.N >> 6; const int k0 = (tile / tn) << 6, n0 = (tile % tn) << 6;
#pragma unroll
    for (int pp = 0; pp < 2; ++pp) { const int r = (tid >> 4) + pp * 32, c = (tid & 15) * 4;
        const f32x4 v = *(const f32x4*)(j.src + (size_t)(k0 + r) * j.N + n0 + c); const float g = j.gain ? j.gain[k0 + r] : 1.f;
        t[r * 65 + c] = v[0] * g; t[r * 65 + c + 1] = v[1] * g; t[r * 65 + c + 2] = v[2] * g; t[r * 65 + c + 3] = v[3] * g; }
    __syncthreads();
    { const int n = tid >> 3, k8 = (tid & 7) * 8; u32x4 o;
#pragma unroll
      for (int q = 0; q < 4; ++q) o[q] = pk2(t[(k8 + 2 * q) * 65 + n], t[(k8 + 2 * q + 1) * 65 + n]);
      *(u32x4*)(j.dst + (size_t)(n0 + n) * j.ldd + k0 + k8) = o; }
    __syncthreads();
}
__device__ __forceinline__ void phase0(const Params& p, LAS unsigned char* lds) {
    const int tid = threadIdx.x, wid = tid >> 6, lane = tid & 63; unsigned char* ws = p.ws;
    for (int it = blockIdx.x; it < 6016; it += gridDim.x) {
        TJob j; int base;
        if (it < 2368)      { j = {p.in[I_WIN], (bf16_t*)(ws + WS_WTIN), p.in[I_N1G], 1024, PIN, 1024}; base = 0; }
        else if (it < 3136) { const int n = (it - 2368) >> 8; j = {p.in[I_WBR] + (size_t)n * 1048576, (bf16_t*)(ws + WS_WTBR) + (size_t)n * 1048576, nullptr, 1024, 1024, 1024}; base = 2368 + n * 256; }
        else if (it < 3392) { j = {p.in[I_WOUT], (bf16_t*)(ws + WS_WTOUT), nullptr, 1024, 1024, 1024}; base = 3136; }
        else if (it < 4416) { j = {p.in[I_WUP], (bf16_t*)(ws + WS_WTUP), p.in[I_N2G], 1024, 4096, 1024}; base = 3392; }
        else if (it < 5440) { j = {p.in[I_WDN], (bf16_t*)(ws + WS_WTDN), nullptr, 4096, 1024, 4096}; base = 4416; }
        else if (it < 5696) { j = {p.in[I_WMK], (bf16_t*)(ws + WS_WTMKV), p.in[I_MNG], 1024, 1024, 1024}; base = 5440; }
        else if (it < 5952) { j = {p.in[I_WMV], (bf16_t*)(ws + WS_WTMKV) + 1048576, p.in[I_MNG], 1024, 1024, 1024}; base = 5696; }
        else if (it < 5968) { j = {p.in[I_WW2], (bf16_t*)(ws + WS_WTLORA), nullptr, 64, 1024, 256}; base = 5952; }
        else if (it < 5984) { j = {p.in[I_WA2], (bf16_t*)(ws + WS_WTLORA) + 1024 * 256 + 64, nullptr, 64, 1024, 256}; base = 5968; }
        else                { j = {p.in[I_WG2], (bf16_t*)(ws + WS_WTLORA) + 2048 * 256 + 128, nullptr, 128, 1024, 256}; base = 5984; }
        transpose_tile(j, it - base, (LAS float*)lds);
    }
    for (int r = blockIdx.x * 8 + wid; r < MT + 2048; r += gridDim.x * 8) {
        const float* src; bf16_t* dst;
        if (r < MP) { src = p.in[I_XP] + (size_t)r * 1024; dst = (bf16_t*)(ws + WS_HB) + (size_t)r * 1024; }
        else if (r < MT) { src = p.in[I_XS] + (size_t)(r - MP) * 1024; dst = (bf16_t*)(ws + WS_HB) + (size_t)r * 1024; }
        else { src = p.in[I_MEM] + (size_t)(r - MT) * 1024; dst = (bf16_t*)(ws + WS_HMB) + (size_t)(r - MT) * 1024; }
        f32x4 v[4]; float ss = 0.f;
#pragma unroll
        for (int c = 0; c < 4; ++c) { v[c] = *(const f32x4*)(src + c * 256 + lane * 4); ss += v[c][0] * v[c][0] + v[c][1] * v[c][1] + v[c][2] * v[c][2] + v[c][3] * v[c][3]; }
        ss = wave_sum(ss); const float rs = rsqrtf(ss * (1.f / 1024.f) + 1e-6f);
#pragma unroll
        for (int c = 0; c < 4; ++c) { u32x2 o; o[0] = pk2(v[c][0] * rs, v[c][1] * rs); o[1] = pk2(v[c][2] * rs, v[c][3] * rs); *(u32x2*)(dst + c * 256 + lane * 4) = o; }
    }
    { bf16_t* wl = (bf16_t*)(ws + WS_WTLORA);
      for (int i = blockIdx.x * 512 + tid; i < 3072 * 32; i += gridDim.x * 512) { const int row = i >> 5, cc = (i & 31) * 8, blk = row >> 10;
          const bool used = (blk == 0 && cc < 64) || (blk == 1 && cc >= 64 && cc < 128) || (blk == 2 && cc >= 128);
          if (!used) *(u32x4*)(wl + (size_t)row * 256 + cc) = (u32x4){0u, 0u, 0u, 0u}; } }
    { const float* sg = p.in[I_SGW]; bf16_t* d = (bf16_t*)(ws + WS_SGW);
      for (int i = blockIdx.x * 512 + tid; i < 8 * 128 * 128; i += gridDim.x * 512) { const int t = (i >> 7) & 127, s = i & 127; d[i] = (bf16_t)(pk2(s <= t ? sg[i] : 0.f, 0.f) & 0xffffu); } }
}

struct EpiZ {
    static constexpr bool PERM = true, AFTER_DRAIN = false;
    bf16_t *U, *GVp, *SZp, *Qp, *GTp; float* out;
    __device__ __forceinline__ void operator()(const f32x4 (&acc)[2][2][4][2], const pg8::Unit& u, int wr, int wc, int fr, int fq) const {
        const int pn = u.pn; bf16_t* base; int ldc, colt, act;
        if (pn < 4) { base = U; ldc = 1024; colt = pn * 256; act = 1; }
        else if (pn < 8) { base = GVp; ldc = 1024; colt = (pn - 4) * 256; act = 1; }
        else if (pn < 21) { base = SZp; ldc = PSH; colt = (pn - 8) * 256; act = 0; }
        else if (pn < 25) { base = Qp; ldc = 1024; colt = (pn - 21) * 256; act = 3; }
        else { base = GTp; ldc = 3072; colt = (pn - 25) * 256; act = 2; }
        const int row0 = u.pm * 256 + wr * 64 + fr, col0 = colt + wc * 32 + 8 * fq;
#pragma unroll
        for (int ai = 0; ai < 2; ++ai)
#pragma unroll
            for (int m = 0; m < 4; ++m) { const int row = row0 + ai * 128 + m * 16; bf16_t* rowp = base + (size_t)row * ldc + col0;
#pragma unroll
                for (int bj = 0; bj < 2; ++bj) { f32x4 v0 = acc[ai][bj][m][0], v1 = acc[ai][bj][m][1];
                    if (act == 1) {
#pragma unroll
                        for (int q = 0; q < 4; ++q) { v0[q] = gelu_tanh(v0[q]); v1[q] = gelu_tanh(v1[q]); } }
                    else if (act == 2) {
#pragma unroll
                        for (int q = 0; q < 4; ++q) { v0[q] = sigmoidf_(v0[q]); v1[q] = sigmoidf_(v1[q]); } }
                    else if (act == 0) {
                        const bool lastp = row < MP ? ((row & 2047) == 2047) : (((row - MP) & 3) == 3);
                        if (lastp) { float* d = (row < MP ? out + O_PSH + (size_t)(row >> 11) * PSH : out + O_SSH + (size_t)((row - MP) >> 2) * PSH) + col0 + bj * 128;
                            *(f32x4*)d = v0; *(f32x4*)(d + 4) = v1; } }
                    u32x4 o; o[0] = pk2(v0[0], v0[1]); o[1] = pk2(v0[2], v0[3]); o[2] = pk2(v1[0], v1[1]); o[3] = pk2(v1[2], v1[3]);
                    *(u32x4*)(rowp + bj * 128) = o; } }
    }
};
struct EpiMem {
    static constexpr bool PERM = false, AFTER_DRAIN = false;
    float* out; bf16_t *MKB, *MVT;
    __device__ __forceinline__ void operator()(const f32x4 (&acc)[2][2][4][2], const pg8::Unit& u, int wr, int wc, int fr, int fq) const {
        const int row0 = u.pm * 256 + wr * 64 + fr, col0 = u.pn * 256 + wc * 32 + 4 * fq; const bool isv = u.pn >= 4;
#pragma unroll
        for (int ai = 0; ai < 2; ++ai)
#pragma unroll
            for (int m = 0; m < 4; ++m) { const int row = row0 + ai * 128 + m * 16;
#pragma unroll
                for (int bj = 0; bj < 2; ++bj)
#pragma unroll
                    for (int n = 0; n < 2; ++n) { const f32x4 v = acc[ai][bj][m][n]; const int col = col0 + bj * 128 + n * 16;
                        if (!isv) { *(f32x4*)(out + O_PMK + (size_t)row * 1024 + col) = v; u32x2 o; o[0] = pk2(v[0], v[1]); o[1] = pk2(v[2], v[3]); *(u32x2*)(MKB + (size_t)row * 1024 + col) = o; }
                        else { const int c = col - 1024; *(f32x4*)(out + O_PMV + (size_t)row * 1024 + c) = v;
                            const int b = row >> 8, mem = row & 255, head = c >> 8, d = c & 255; bf16_t* dst = MVT + ((size_t)((b * 4 + head) * 256 + d)) * 256 + mem;
                            const unsigned p0 = pk2(v[0], v[1]), p1 = pk2(v[2], v[3]);
                            dst[0] = (bf16_t)(p0 & 0xffffu); dst[256] = (bf16_t)(p0 >> 16); dst[512] = (bf16_t)(p1 & 0xffffu); dst[768] = (bf16_t)(p1 >> 16); } } }
    }
};
struct BranchOrder {
    int G, c;
    __device__ bool next(int i, pg8::Unit& u) const { const int tile = (i / 3) * G + c, n = i % 3; if (tile >= (MP / 256) * 4) return false;
        const int xcd = tile & 7, q = tile >> 3, pm = xcd * 8 + (q >> 2), pn = q & 3;
        u.pm = n * NPANEL + pm; u.pn = n * 4 + pn; return true; }
    __device__ __forceinline__ void a_ready(const pg8::Unit&) const {}
    __device__ __forceinline__ void done(const pg8::Unit&) const {}
};
struct EpiMerge {
    static constexpr bool PERM = false, AFTER_DRAIN = false;
    const bf16_t* GT; float* MF; bf16_t* MB;
    __device__ __forceinline__ void operator()(const f32x4 (&acc)[2][2][4][2], const pg8::Unit& u, int wr, int wc, int fr, int fq) const {
        const int n = u.pm / NPANEL, pm = u.pm - n * NPANEL, pn = u.pn & 3;
        const int row0 = pm * 256 + wr * 64 + fr, col0 = pn * 256 + wc * 32 + 4 * fq;
        u32x2 g[2][4]; f32x4 o[2][4];
        auto issue = [&](int grp, int slot) { const int row = row0 + (grp >> 2) * 128 + (grp & 3) * 16; const bf16_t* gp = GT + (size_t)row * 3072 + n * 1024 + col0; const float* mp = MF + (size_t)row * 1024 + col0;
#pragma unroll
            for (int x = 0; x < 4; ++x) { g[slot][x] = *(const u32x2*)(gp + (x >> 1) * 128 + (x & 1) * 16); if (n > 0) o[slot][x] = *(const f32x4*)(mp + (x >> 1) * 128 + (x & 1) * 16); else o[slot][x] = (f32x4){0.f, 0.f, 0.f, 0.f}; } };
        issue(0, 0);
#pragma unroll
        for (int grp = 0; grp < 8; ++grp) { const int slot = grp & 1, ai = grp >> 2, m = grp & 3; const int row = row0 + ai * 128 + m * 16;
            if (grp < 7) issue(grp + 1, slot ^ 1);
            float* mp = MF + (size_t)row * 1024 + col0;
#pragma unroll
            for (int x = 0; x < 4; ++x) { float gf[4]; unpack4(g[slot][x], gf); f32x4 v = acc[ai][x >> 1][m][x & 1];
                v[0] = v[0] * gf[0] + o[slot][x][0]; v[1] = v[1] * gf[1] + o[slot][x][1]; v[2] = v[2] * gf[2] + o[slot][x][2]; v[3] = v[3] * gf[3] + o[slot][x][3];
                if (n < 2) *(f32x4*)(mp + (x >> 1) * 128 + (x & 1) * 16) = v;
                else { u32x2 w; w[0] = pk2(v[0], v[1]); w[1] = pk2(v[2], v[3]); *(u32x2*)(MB + (size_t)row * 1024 + col0 + (x >> 1) * 128 + (x & 1) * 16) = w; } } }
    }
};
template <int KS, class Mid, class Fin>
__device__ __forceinline__ void thin_gemm(LAS unsigned char* lds, const bf16_t* A0, size_t a_bstride, const bf16_t* B0, size_t b_bstride, int nb, int N, int K, const Mid& mid, const Fin& fin) {
    const int wid = threadIdx.x >> 6, lane = threadIdx.x & 63, fr = lane & 15, fq = lane >> 4; const int ntask = 32 * (N >> 6);
    constexpr int TPB = 8 / KS; const int grp = wid / KS, kq = wid % KS, kspan = K / KS;
    LAS f32x4* red = (LAS f32x4*)lds;
    for (int t0 = blockIdx.x * TPB; t0 < ntask; t0 += gridDim.x * TPB) {
        const int t = t0 + grp; const bool valid = t < ntask;
        const int r0 = MP + (t & 31) * 16, c0 = (t >> 5) * 64;
        f32x4 tot[4];
#pragma unroll
        for (int j = 0; j < 4; ++j) tot[j] = (f32x4){0.f, 0.f, 0.f, 0.f};
        if (valid) for (int n = 0; n < nb; ++n) { f32x4 acc[4];
#pragma unroll
            for (int j = 0; j < 4; ++j) acc[j] = (f32x4){0.f, 0.f, 0.f, 0.f};
            const bf16_t* ap = A0 + (size_t)n * a_bstride + (size_t)(r0 + fr) * K + kq * kspan + fq * 8; const bf16_t* bp = B0 + (size_t)n * b_bstride + (size_t)(c0 + fr) * K + kq * kspan + fq * 8;
#pragma unroll 4
            for (int ks = 0; ks < (kspan >> 5); ++ks) { const bf16x8 a = *(const bf16x8*)(ap + ks * 32);
#pragma unroll
                for (int j = 0; j < 4; ++j) { const bf16x8 b = *(const bf16x8*)(bp + (size_t)j * 16 * K + ks * 32); acc[j] = mfma16(b, a, acc[j]); } }
            mid(n, acc, tot, r0 + fr, c0 + 4 * fq); }
        if (KS > 1) {
#pragma unroll
            for (int j = 0; j < 4; ++j) red[(wid * 4 + j) * 64 + lane] = tot[j];
            __syncthreads();
            if (kq == 0 && valid) {
#pragma unroll
                for (int q = 1; q < KS; ++q)
#pragma unroll
                    for (int j = 0; j < 4; ++j) tot[j] += red[((wid + q) * 4 + j) * 64 + lane];
                fin(tot, r0 + fr, c0 + 4 * fq); }
            __syncthreads();
        } else if (valid) fin(tot, r0 + fr, c0 + 4 * fq);
    }
}
struct EpiRes {
    static constexpr bool PERM = false, AFTER_DRAIN = false;
    const float* resP; const float* resS; float* X; bf16_t* XB; float* ssq;
    __device__ __forceinline__ void operator()(const f32x4 (&acc)[2][2][4][2], const pg8::Unit& u, int wr, int wc, int fr, int fq) const {
        const int row0 = u.pm * 256 + wr * 64 + fr, col0 = u.pn * 256 + wc * 32 + 4 * fq;
#pragma unroll
        for (int ai = 0; ai < 2; ++ai) { f32x4 r[4][4];
#pragma unroll
            for (int m = 0; m < 4; ++m) { const int row = row0 + ai * 128 + m * 16; const float* rp = (row < MP ? resP + (size_t)row * 1024 : resS + (size_t)(row - MP) * 1024) + col0;
#pragma unroll
                for (int x = 0; x < 4; ++x) r[m][x] = *(const f32x4*)(rp + (x >> 1) * 128 + (x & 1) * 16); }
#pragma unroll
            for (int m = 0; m < 4; ++m) { const int row = row0 + ai * 128 + m * 16; float ss = 0.f;
#pragma unroll
                for (int x = 0; x < 4; ++x) { const int col = col0 + (x >> 1) * 128 + (x & 1) * 16; const f32x4 v = acc[ai][x >> 1][m][x & 1] + r[m][x];
                    *(f32x4*)(X + (size_t)row * 1024 + col) = v; ss += v[0] * v[0] + v[1] * v[1] + v[2] * v[2] + v[3] * v[3];
                    if (XB) { u32x2 w; w[0] = pk2(v[0], v[1]); w[1] = pk2(v[2], v[3]); *(u32x2*)(XB + (size_t)row * 1024 + col) = w; } }
                ss += __shfl_xor(ss, 16); ss += __shfl_xor(ss, 32);
                if (fq == 0) atomicAdd(ssq + row, ss); } }
    }
};
struct EpiUp {
    static constexpr bool PERM = true, AFTER_DRAIN = false;
    const float* ssq; bf16_t* H;
    __device__ __forceinline__ void operator()(const f32x4 (&acc)[2][2][4][2], const pg8::Unit& u, int wr, int wc, int fr, int fq) const {
        const int row0 = u.pm * 256 + wr * 64 + fr, col0 = u.pn * 256 + wc * 32 + 8 * fq;
#pragma unroll
        for (int ai = 0; ai < 2; ++ai)
#pragma unroll
            for (int m = 0; m < 4; ++m) { const int row = row0 + ai * 128 + m * 16; const float rs = rsqrtf(ssq[row] * (1.f / 1024.f) + 1e-6f);
#pragma unroll
                for (int bj = 0; bj < 2; ++bj) { f32x4 v0 = acc[ai][bj][m][0], v1 = acc[ai][bj][m][1];
#pragma unroll
                    for (int q = 0; q < 4; ++q) { float a = fmaxf(v0[q] * rs, 0.f); v0[q] = a * a; float b = fmaxf(v1[q] * rs, 0.f); v1[q] = b * b; }
                    u32x4 o; o[0] = pk2(v0[0], v0[1]); o[1] = pk2(v0[2], v0[3]); o[2] = pk2(v1[0], v1[1]); o[3] = pk2(v1[2], v1[3]);
                    *(u32x4*)(H + (size_t)row * DFF + col0 + bj * 128) = o; } }
    }
};

template <int NR, bool DUMMY> __device__ __forceinline__ void p2_rows(const Params& p, const int (&mrow)[NR], int lane) {
    unsigned char* ws = p.ws; const float* lng = p.in[I_LNG]; const float* lnb = p.in[I_LNB];
    const int c4 = lane * 4;
    u32x4 q0[NR], q1[NR]; u32x2 cq[NR], pq[NR]; f32x4 sq[NR]; bool valid[NR], first[NR];
#pragma unroll
    for (int i = 0; i < NR; ++i) { const int m = mrow[i]; valid[i] = m < MT; const int mm = valid[i] ? m : 0;
        const bf16_t* row = (const bf16_t*)(ws + WS_GV) + (size_t)mm * 1024; q0[i] = *(const u32x4*)(row + lane * 8); q1[i] = *(const u32x4*)(row + 512 + lane * 8);
        const bf16_t* cur = (const bf16_t*)(ws + WS_SZ) + (size_t)mm * PSH + 3072 + c4; cq[i] = *(const u32x2*)cur;
        first[i] = mm < MP ? ((mm & 2047) == 0) : (((mm - MP) & 3) == 0);
        pq[i] = (u32x2){0u, 0u}; sq[i] = (f32x4){0.f, 0.f, 0.f, 0.f};
        if (!first[i]) pq[i] = *(const u32x2*)(cur - PSH);
        else if (mm >= MP) sq[i] = *(const f32x4*)(p.in[I_SSH] + (size_t)((mm - MP) >> 2) * PSH + 3072 + c4); }
    const f32x4 mu = *(const f32x4*)(p.in[I_MU] + 3072 + c4);
    f32x4 g0[2], g1[2], b0[2], b1[2];
#pragma unroll
    for (int c = 0; c < 2; ++c) { const int col = c * 512 + lane * 8; g0[c] = *(const f32x4*)(lng + col); g1[c] = *(const f32x4*)(lng + col + 4); b0[c] = *(const f32x4*)(lnb + col); b1[c] = *(const f32x4*)(lnb + col + 4); }
#pragma unroll
    for (int i = 0; i < NR; ++i) { if (!valid[i]) continue; const int m = mrow[i]; bf16_t* row = (bf16_t*)(ws + WS_GV) + (size_t)m * 1024; float x[16];
#pragma unroll
        for (int k = 0; k < 4; ++k) { x[2 * k] = bflo(q0[i][k]); x[2 * k + 1] = bfhi(q0[i][k]); x[8 + 2 * k] = bflo(q1[i][k]); x[8 + 2 * k + 1] = bfhi(q1[i][k]); }
        float s = 0.f;
#pragma unroll
        for (int k = 0; k < 16; ++k) s += x[k];
        s = wave_sum(s); const float mean = s * (1.f / 1024.f); float vs = 0.f;
#pragma unroll
        for (int k = 0; k < 16; ++k) { x[k] -= mean; vs += x[k] * x[k]; }
        vs = wave_sum(vs); const float rstd = rsqrtf(vs * (1.f / 1024.f) + 1e-5f);
#pragma unroll
        for (int c = 0; c < 2; ++c) { const int col = c * 512 + lane * 8; float y[8];
#pragma unroll
            for (int k = 0; k < 4; ++k) { y[k] = x[c * 8 + k] * rstd * g0[c][k] + b0[c][k]; y[4 + k] = x[c * 8 + 4 + k] * rstd * g1[c][k] + b1[c][k]; }
            u32x4 o; o[0] = pk2(y[0], y[1]); o[1] = pk2(y[2], y[3]); o[2] = pk2(y[4], y[5]); o[3] = pk2(y[6], y[7]); if (!DUMMY) *(u32x4*)(row + col) = o;
            if (m >= MP) { float* d = p.out + O_SGV + (size_t)(m - MP) * 1024 + col; *(f32x4*)d = (f32x4){y[0], y[1], y[2], y[3]}; *(f32x4*)(d + 4) = (f32x4){y[4], y[5], y[6], y[7]}; } }
        float cv[4], pv[4], o[4]; unpack4(cq[i], cv);
        if (!first[i]) unpack4(pq[i], pv); else { pv[0] = sq[i][0]; pv[1] = sq[i][1]; pv[2] = sq[i][2]; pv[3] = sq[i][3]; }
#pragma unroll
        for (int e = 0; e < 4; ++e) { const float ss = cv[e] + (pv[e] - cv[e]) * mu[e]; o[e] = lane < 16 ? tanhf_(ss) : (lane < 32 ? ss : sigmoidf_(ss)); }
        u32x2 w; w[0] = pk2(o[0], o[1]); w[1] = pk2(o[2], o[3]); *(u32x2*)((bf16_t*)(ws + WS_XL) + (size_t)m * 256 + c4) = w; }
}
struct EpiLora {
    static constexpr bool PERM = true, AFTER_DRAIN = false;
    bf16_t *E, *A, *Gg; const float *w0, *a0;
    __device__ __forceinline__ void operator()(const f32x4 (&acc)[2][2][4][2], const pg8::Unit& u, int wr, int wc, int fr, int fq) const {
        const int seg = u.pn >> 2, colt = (u.pn & 3) * 256; bf16_t* base = E + (size_t)seg * 17301504;
        const int row0 = u.pm * 256 + wr * 64 + fr, col0 = colt + wc * 32 + 8 * fq;
        f32x4 bv[2][2];
#pragma unroll
        for (int bj = 0; bj < 2; ++bj) { if (seg == 0) { bv[bj][0] = *(const f32x4*)(w0 + col0 + bj * 128); bv[bj][1] = *(const f32x4*)(w0 + col0 + bj * 128 + 4); } else if (seg == 1) { bv[bj][0] = *(const f32x4*)(a0 + col0 + bj * 128); bv[bj][1] = *(const f32x4*)(a0 + col0 + bj * 128 + 4); } else { bv[bj][0] = (f32x4){0.f, 0.f, 0.f, 0.f}; bv[bj][1] = bv[bj][0]; } }
#pragma unroll
        for (int ai = 0; ai < 2; ++ai)
#pragma unroll
            for (int m = 0; m < 4; ++m) { const int row = row0 + ai * 128 + m * 16; bf16_t* rowp = base + (size_t)row * 1024 + col0;
#pragma unroll
                for (int bj = 0; bj < 2; ++bj) { f32x4 v0 = acc[ai][bj][m][0] + bv[bj][0], v1 = acc[ai][bj][m][1] + bv[bj][1];
                    if (seg == 0) {
#pragma unroll
                        for (int q = 0; q < 4; ++q) { v0[q] = 0.60653066f * sigmoidf_(v0[q]); v1[q] = 0.60653066f * sigmoidf_(v1[q]); } }
                    else if (seg == 1) {
#pragma unroll
                        for (int q = 0; q < 4; ++q) { v0[q] = sigmoidf_(v0[q]); v1[q] = sigmoidf_(v1[q]); } }
                    u32x4 o; o[0] = pk2(v0[0], v0[1]); o[1] = pk2(v0[2], v0[3]); o[2] = pk2(v1[0], v1[1]); o[3] = pk2(v1[2], v1[3]);
                    *(u32x4*)(rowp + bj * 128) = o; } }
    }
};

struct ScanPre { u32x2 cr, ck, cv, pr, pk, pv, e, a, g; };
__device__ __forceinline__ u32x2 pack4f(const float* s) { const f32x4 q = *(const f32x4*)s; u32x2 o; o[0] = pk2(q[0], q[1]); o[1] = pk2(q[2], q[3]); return o; }
__device__ __forceinline__ void scan_head(const Params& p, LAS unsigned char* lds, int row0, int T, int h, const float* s0, float* sfin, const float* shift0) {
    const int tid = threadIdx.x, wid = tid >> 6, lane = tid & 63; unsigned char* ws = p.ws;
    const bf16_t* SZp = (const bf16_t*)(ws + WS_SZ); const bf16_t* Ep = (const bf16_t*)(ws + WS_E); const bf16_t* Ap = (const bf16_t*)(ws + WS_AV); const bf16_t* Gp = (const bf16_t*)(ws + WS_GG);
    bf16_t* YB = (bf16_t*)(ws + WS_Y3) + (size_t)MT * 1024;
    LAS float* bufs = (LAS float*)lds;
    LAS float* Yl2 = (LAS float*)(lds + 98304);
    LAS float* BON = (LAS float*)(lds + 98304 + 16384);
    const bool helper = wid >= 4; const int htid = tid & 255;
    const int tth = htid >> 4, j4 = (htid & 15) * 4, ch = h * 64 + j4;
    const int si = (wid & 3) * 16 + (lane >> 3) * 2, jb = (lane & 7) * 8;
    f32x2 S0[4], S1[4];
    if (s0 && !helper) {
#pragma unroll
        for (int q = 0; q < 4; ++q) { S0[q] = *(const f32x2*)(s0 + si * 64 + jb + 2 * q); S1[q] = *(const f32x2*)(s0 + (si + 1) * 64 + jb + 2 * q); } }
    else {
#pragma unroll
        for (int q = 0; q < 4; ++q) { S0[q] = (f32x2){0.f, 0.f}; S1[q] = S0[q]; } }
    auto load_pre = [&](int t0, ScanPre (&P)[2]) {
#pragma unroll
        for (int pp = 0; pp < 2; ++pp) { const int t = t0 + tth + 16 * pp; ScanPre& Q = P[pp];
            if (t < T) { const size_t m = (size_t)(row0 + t); const bf16_t* c = SZp + m * PSH + ch;
                Q.cr = *(const u32x2*)c; Q.ck = *(const u32x2*)(c + 1024); Q.cv = *(const u32x2*)(c + 2048);
                if (t > 0) { Q.pr = *(const u32x2*)(c - PSH); Q.pk = *(const u32x2*)(c - PSH + 1024); Q.pv = *(const u32x2*)(c - PSH + 2048); }
                else if (shift0) { Q.pr = pack4f(shift0 + ch); Q.pk = pack4f(shift0 + 1024 + ch); Q.pv = pack4f(shift0 + 2048 + ch); }
                else { Q.pr = (u32x2){0u, 0u}; Q.pk = Q.pr; Q.pv = Q.pr; }
                Q.e = *(const u32x2*)(Ep + m * 1024 + ch); Q.a = *(const u32x2*)(Ap + m * 1024 + ch); Q.g = (u32x2){0u, 0u}; }
            else { Q.cr = (u32x2){0u, 0u}; Q.ck = Q.cr; Q.cv = Q.cr; Q.pr = Q.cr; Q.pk = Q.cr; Q.pv = Q.cr; Q.e = Q.cr; Q.a = Q.cr; Q.g = Q.cr; } }
    };
    auto store_pre = [&](const ScanPre (&P)[2], int nb) {
        const f32x4 mur = *(const f32x4*)(p.in[I_MU] + ch), muk = *(const f32x4*)(p.in[I_MU] + 1024 + ch), muv = *(const f32x4*)(p.in[I_MU] + 2048 + ch),
                    kkc = *(const f32x4*)(p.in[I_KK] + ch), kac = *(const f32x4*)(p.in[I_KA] + ch), rkc = *(const f32x4*)(p.in[I_RK] + ch);
#pragma unroll
        for (int pp = 0; pp < 2; ++pp) { const ScanPre& Q = P[pp]; const int tt = tth + 16 * pp;
            float cr[4], ck[4], cv[4], pr[4], pk[4], pv[4], e[4], a[4];
            unpack4(Q.cr, cr); unpack4(Q.ck, ck); unpack4(Q.cv, cv); unpack4(Q.pr, pr); unpack4(Q.pk, pk); unpack4(Q.pv, pv); unpack4(Q.e, e); unpack4(Q.a, a);
            f32x4 r, w, k, na, bb, v; float ssq = 0.f, bon = 0.f; float kkr[4];
#pragma unroll
            for (int q = 0; q < 4; ++q) { r[q] = cr[q] + (pr[q] - cr[q]) * mur[q]; const float kz = ck[q] + (pk[q] - ck[q]) * muk[q]; v[q] = cv[q] + (pv[q] - cv[q]) * muv[q];
                k[q] = kz * (1.f + (a[q] - 1.f) * kac[q]); kkr[q] = kz * kkc[q]; ssq += kkr[q] * kkr[q]; bon += r[q] * k[q] * rkc[q]; w[q] = __expf(-e[q]); }
            ssq = red16(ssq); bon = red16(bon); const float rn = rsqrtf(ssq + 1e-12f);
#pragma unroll
            for (int q = 0; q < 4; ++q) { const float kk = kkr[q] * rn; na[q] = -kk; bb[q] = kk * a[q]; }
            LAS float* b = bufs + nb * 12288 + tt * 64 + j4;
            *(LAS f32x4*)(b) = r; *(LAS f32x4*)(b + 2048) = w; *(LAS f32x4*)(b + 4096) = k; *(LAS f32x4*)(b + 6144) = na; *(LAS f32x4*)(b + 8192) = bb; *(LAS f32x4*)(b + 10240) = v;
            if ((htid & 15) == 0) BON[nb * 32 + tt] = bon; }
    };
    auto epilogue = [&](int c) {
        const int cb = c & 1, t0 = c * 32, nv = (T - t0) < 32 ? (T - t0) : 32;
        const f32x4 lg = *(const f32x4*)(p.in[I_LXG] + h * 64 + j4), lb = *(const f32x4*)(p.in[I_LXB] + h * 64 + j4);
        u32x2 gq[2];
#pragma unroll
        for (int pp = 0; pp < 2; ++pp) { const int tt = tth + 16 * pp; gq[pp] = (u32x2){0u, 0u}; if (tt < nv) gq[pp] = *(const u32x2*)(Gp + (size_t)(row0 + t0 + tt) * 1024 + ch); }
#pragma unroll
        for (int pp = 0; pp < 2; ++pp) { const int tt = tth + 16 * pp;
            if (tt < nv) { const size_t m = (size_t)(row0 + t0 + tt);
                const f32x4 y = *(const LAS f32x4*)(Yl2 + cb * 2048 + tt * 64 + j4); const f32x4 v = *(const LAS f32x4*)(bufs + cb * 12288 + 10240 + tt * 64 + j4); const float bon = BON[cb * 32 + tt];
                float s = y[0] + y[1] + y[2] + y[3]; s = red16(s); const float mean = s * (1.f / 64.f);
                float d[4], vs = 0.f;
#pragma unroll
                for (int q = 0; q < 4; ++q) { d[q] = y[q] - mean; vs += d[q] * d[q]; }
                vs = red16(vs); const float rstd = rsqrtf(vs * (1.f / 64.f) + 64e-5f);
                float g[4]; unpack4(gq[pp], g); float o[4];
#pragma unroll
                for (int q = 0; q < 4; ++q) o[q] = (d[q] * rstd * lg[q] + lb[q] + bon * v[q]) * g[q];
                u32x2 w; w[0] = pk2(o[0], o[1]); w[1] = pk2(o[2], o[3]); *(u32x2*)(YB + m * 1024 + h * 64 + j4) = w; } }
    };
    ScanPre P[2];
    if (helper) { load_pre(0, P); store_pre(P, 0); }
    __syncthreads();
    const int nch = (T + 31) >> 5;
    for (int c = 0; c < nch; ++c) {
        const int cb = c & 1, t0 = c * 32, nv = (T - t0) < 32 ? (T - t0) : 32;
        if (!helper) { const LAS float* b = bufs + cb * 12288 + jb; const LAS float* vb = bufs + cb * 12288 + 10240 + si; LAS float* Yl = Yl2 + cb * 2048;
          f32x4 R[2], W[2], K[2], A[2], B[2], nR[2], nW[2], nK[2], nA[2], nB[2]; f32x2 v, nvv;
#define SCAN_LOAD(R_, W_, K_, A_, B_, V_, t) { const LAS float* bt = b + (t) * 64; _Pragma("unroll") for (int x = 0; x < 2; ++x) { \
              A_[x] = *(const LAS f32x4*)(bt + 6144 + 4 * x); B_[x] = *(const LAS f32x4*)(bt + 8192 + 4 * x); W_[x] = *(const LAS f32x4*)(bt + 2048 + 4 * x); \
              K_[x] = *(const LAS f32x4*)(bt + 4096 + 4 * x); R_[x] = *(const LAS f32x4*)(bt + 4 * x); } V_ = *(const LAS f32x2*)(vb + (t) * 64); }
#define H2(X, q) ((f32x2){X[(q) >> 1][((q) & 1) * 2], X[(q) >> 1][((q) & 1) * 2 + 1]})
          SCAN_LOAD(R, W, K, A, B, v, 0)
#pragma unroll 4
          for (int t = 0; t < nv; ++t) {
              { const int tn = (t + 1 < 32) ? t + 1 : 31; SCAN_LOAD(nR, nW, nK, nA, nB, nvv, tn) }
              asm volatile("" ::: "memory");
              f32x2 d0 = S0[0] * H2(A, 0), d1 = S1[0] * H2(A, 0);
#pragma unroll
              for (int q = 1; q < 4; ++q) { d0 += S0[q] * H2(A, q); d1 += S1[q] * H2(A, q); }
              const float sa0 = red8(d0[0] + d0[1]), sa1 = red8(d1[0] + d1[1]);
              const f32x2 sa02 = {sa0, sa0}, sa12 = {sa1, sa1}, v02 = {v[0], v[0]}, v12 = {v[1], v[1]};
#pragma unroll
              for (int q = 0; q < 4; ++q) { S0[q] = S0[q] * H2(W, q) + (sa02 * H2(B, q) + v02 * H2(K, q)); S1[q] = S1[q] * H2(W, q) + (sa12 * H2(B, q) + v12 * H2(K, q)); }
              f32x2 y0 = S0[0] * H2(R, 0), y1 = S1[0] * H2(R, 0);
#pragma unroll
              for (int q = 1; q < 4; ++q) { y0 += S0[q] * H2(R, q); y1 += S1[q] * H2(R, q); }
              float yy0 = y0[0] + y0[1], yy1 = y1[0] + y1[1];
              asm("" : "+v"(yy0)); asm("" : "+v"(yy1));
              yy0 = red8(yy0); yy1 = red8(yy1);
              *(LAS f32x2*)(Yl + t * 64 + si) = (f32x2){yy0, yy1};
#pragma unroll
              for (int x = 0; x < 2; ++x) { R[x] = nR[x]; W[x] = nW[x]; K[x] = nK[x]; A[x] = nA[x]; B[x] = nB[x]; }
              v = nvv; }
#undef SCAN_LOAD
#undef H2
        } else {
            if (c + 1 < nch) load_pre(t0 + 32, P);
            if (c > 0) epilogue(c - 1);
            if (c + 1 < nch) store_pre(P, cb ^ 1);
        }
        __syncthreads();
    }
    if (helper) epilogue(nch - 1);
#pragma unroll
    for (int q = 0; q < 4; ++q) if (!helper) { *(f32x2*)(sfin + si * 64 + jb + 2 * q) = S0[q]; *(f32x2*)(sfin + (si + 1) * 64 + jb + 2 * q) = S1[q]; }
}

template <bool DUMMY> __device__ __forceinline__ void attn_prompt_item(const Params& p, LAS unsigned char* lds, int item) {
    const int tid = threadIdx.x, wid = tid >> 6, lane = tid & 63, fr = lane & 15, fq = lane >> 4; unsigned char* ws = p.ws;
    const int b = item >> 6, head = (item >> 4) & 3, qt = item & 15;
    bf16_t* Qp = (bf16_t*)(ws + WS_Y3) + (size_t)2 * MT * 1024; const bf16_t* MKB = (const bf16_t*)(ws + WS_MKB); const bf16_t* MVT = (const bf16_t*)(ws + WS_MVT);
    const int qrow = b * 2048 + qt * 128 + wid * 16;
    bf16x8 qf[8];
#pragma unroll
    for (int ks = 0; ks < 8; ++ks) qf[ks] = *(const bf16x8*)(Qp + (size_t)(qrow + fr) * 1024 + head * 256 + ks * 32 + fq * 8);
#pragma unroll 1
    for (int rnd = 0; rnd < 2; ++rnd) { u32x4 kv[8];
#pragma unroll
      for (int it = 0; it < 8; ++it) { const int idx = (rnd * 8 + it) * 512 + tid, row = idx >> 5, c = idx & 31; kv[it] = *(const u32x4*)(MKB + (size_t)(b * 256 + row) * 1024 + head * 256 + c * 8); }
#pragma unroll
      for (int it = 0; it < 8; ++it) { const int idx = (rnd * 8 + it) * 512 + tid, row = idx >> 5, c = idx & 31; *(LAS u32x4*)(lds + (row * 32 + (c ^ (row & 15))) * 16) = kv[it]; } }
    __syncthreads();
    u32x4 pf[8];
    { f32x4 s[16];
      int koff[8];
#pragma unroll
      for (int ks = 0; ks < 8; ++ks) koff[ks] = (fr * 32 + ((ks * 4 + fq) ^ fr)) * 16;
#pragma unroll
      for (int nt = 0; nt < 16; ++nt) { f32x4 acc = {0.f, 0.f, 0.f, 0.f};
#pragma unroll
          for (int ks = 0; ks < 8; ++ks) { const bf16x8 kf = *(const LAS bf16x8*)(lds + nt * 8192 + koff[ks]); acc = mfma16(kf, qf[ks], acc); }
          s[nt] = acc; }
      float mx = -3.0e38f;
#pragma unroll
      for (int nt = 0; nt < 16; ++nt) mx = fmaxf(fmaxf(fmaxf(s[nt][0], s[nt][1]), fmaxf(s[nt][2], s[nt][3])), mx);
      mx = fmaxf(mx, __shfl_xor(mx, 16)); mx = fmaxf(mx, __shfl_xor(mx, 32));
      float sum = 0.f;
#pragma unroll
      for (int nt = 0; nt < 16; ++nt)
#pragma unroll
          for (int q = 0; q < 4; ++q) { const float e = __expf((s[nt][q] - mx) * 0.0625f); s[nt][q] = e; sum += e; }
      sum += __shfl_xor(sum, 16); sum += __shfl_xor(sum, 32); const float inv = rcpf(sum);
#pragma unroll
      for (int ks = 0; ks < 8; ++ks) { pf[ks][0] = pk2(s[2 * ks][0] * inv, s[2 * ks][1] * inv); pf[ks][1] = pk2(s[2 * ks][2] * inv, s[2 * ks][3] * inv);
          pf[ks][2] = pk2(s[2 * ks + 1][0] * inv, s[2 * ks + 1][1] * inv); pf[ks][3] = pk2(s[2 * ks + 1][2] * inv, s[2 * ks + 1][3] * inv); } }
    __syncthreads();
#pragma unroll 1
    for (int rnd = 0; rnd < 2; ++rnd) { u32x4 kv[8];
#pragma unroll
      for (int it = 0; it < 8; ++it) { const int idx = (rnd * 8 + it) * 512 + tid, row = idx >> 5, c = idx & 31; kv[it] = *(const u32x4*)(MVT + ((size_t)((b * 4 + head) * 256 + row)) * 256 + c * 8); }
#pragma unroll
      for (int it = 0; it < 8; ++it) { const int idx = (rnd * 8 + it) * 512 + tid, row = idx >> 5, c = idx & 31; *(LAS u32x4*)(lds + (row * 32 + (c ^ (row & 15))) * 16) = kv[it]; } }
    __syncthreads();
    { int voff[8][2];
#pragma unroll
      for (int ks = 0; ks < 8; ++ks) { const int c1 = ks * 4 + (fq >> 1); voff[ks][0] = (fr * 32 + (c1 ^ fr)) * 16 + (fq & 1) * 8; voff[ks][1] = (fr * 32 + ((c1 + 2) ^ fr)) * 16 + (fq & 1) * 8; }
#pragma unroll 2
      for (int dt = 0; dt < 16; ++dt) { f32x4 acc = {0.f, 0.f, 0.f, 0.f};
#pragma unroll
          for (int ks = 0; ks < 8; ++ks) { const u32x2 lo = *(const LAS u32x2*)(lds + dt * 8192 + voff[ks][0]), hi = *(const LAS u32x2*)(lds + dt * 8192 + voff[ks][1]);
              u32x4 vv; vv[0] = lo[0]; vv[1] = lo[1]; vv[2] = hi[0]; vv[3] = hi[1]; acc = mfma16(__builtin_bit_cast(bf16x8, vv), __builtin_bit_cast(bf16x8, pf[ks]), acc); }
          u32x2 w; w[0] = pk2(acc[0], acc[1]); w[1] = pk2(acc[2], acc[3]);
          bf16_t* o = Qp + (size_t)(qrow + fr) * 1024 + head * 256 + dt * 16 + 4 * fq;
          if (!DUMMY) *(u32x2*)o = w; else if (w[0] == 0x12345678u) Qp[0] = 0; } }
    __syncthreads();
}

template <bool DUMMY> __device__ __forceinline__ void attn_sample_item(const Params& p, LAS unsigned char* lds, int item) {
    const int tid = threadIdx.x, wid = tid >> 6, lane = tid & 63, l16 = lane & 15, rg = lane >> 4; unsigned char* ws = p.ws;
    const int b = item >> 2, head = item & 3;
    bf16_t* Qp = (bf16_t*)(ws + WS_Y3) + (size_t)2 * MT * 1024 + (size_t)(MP + 4 * b) * 1024 + head * 256;
    const float* Kp = p.in[I_CK] + ((size_t)b * 256 * 4 + head) * 256; const float* Vp = p.in[I_CV] + ((size_t)b * 256 * 4 + head) * 256;
    LAS float* sc = (LAS float*)lds; LAS float* pr = (LAS float*)(lds + 4096); LAS float* part = (LAS float*)(lds + 8192);
    float qv[4][4][4];
#pragma unroll
    for (int t = 0; t < 4; ++t)
#pragma unroll
        for (int c = 0; c < 4; ++c) { const u32x2 q = *(const u32x2*)(Qp + t * 1024 + 64 * c + 4 * l16); unpack4(q, qv[t][c]); }
#pragma unroll 2
    for (int it = 0; it < 8; ++it) { const int mrow = wid * 32 + it * 4 + rg; const float* kr = Kp + (size_t)mrow * 1024 + 4 * l16; float d[4] = {0.f, 0.f, 0.f, 0.f};
#pragma unroll
        for (int c = 0; c < 4; ++c) { const f32x4 kv = *(const f32x4*)(kr + 64 * c);
#pragma unroll
            for (int t = 0; t < 4; ++t) d[t] += kv[0] * qv[t][c][0] + kv[1] * qv[t][c][1] + kv[2] * qv[t][c][2] + kv[3] * qv[t][c][3]; }
#pragma unroll
        for (int t = 0; t < 4; ++t) { const float r = red16(d[t]); if (l16 == 0) sc[t * 256 + mrow] = r * 0.0625f; } }
    __syncthreads();
    if (wid < 4) { const f32x4 x = *(const LAS f32x4*)(sc + wid * 256 + lane * 4); float mx = fmaxf(fmaxf(x[0], x[1]), fmaxf(x[2], x[3])); mx = wave_max(mx);
        float e[4], sum = 0.f;
#pragma unroll
        for (int q = 0; q < 4; ++q) { e[q] = __expf(x[q] - mx); sum += e[q]; }
        sum = wave_sum(sum); const float inv = rcpf(sum);
#pragma unroll
        for (int q = 0; q < 4; ++q) pr[(lane * 4 + q) * 4 + wid] = e[q] * inv; }
    __syncthreads();
    { f32x4 acc[4];
#pragma unroll
      for (int t = 0; t < 4; ++t) acc[t] = (f32x4){0.f, 0.f, 0.f, 0.f};
#pragma unroll 8
      for (int it = 0; it < 32; ++it) { const int mrow = wid * 32 + it; const f32x4 vv = *(const f32x4*)(Vp + (size_t)mrow * 1024 + lane * 4); const f32x4 pp = *(const LAS f32x4*)(pr + mrow * 4);
#pragma unroll
          for (int t = 0; t < 4; ++t) acc[t] += pp[t] * vv; }
#pragma unroll
      for (int t = 0; t < 4; ++t) *(LAS f32x4*)(part + (wid * 4 + t) * 256 + lane * 4) = acc[t]; }
    __syncthreads();
    { const int o = tid * 2, t = o >> 8, d = o & 255; float a0 = 0.f, a1 = 0.f;
#pragma unroll
      for (int w = 0; w < 8; ++w) { const f32x2 v = *(const LAS f32x2*)(part + (w * 4 + t) * 256 + d); a0 += v[0]; a1 += v[1]; }
      const unsigned wv = pk2(a0, a1); if (!DUMMY) *(unsigned*)(Qp + t * 1024 + d) = wv; else if (wv == 0x12345678u) Qp[0] = 0; }
    __syncthreads();
}

template <bool DUMMY> __device__ __forceinline__ void sg_prompt_item(const Params& p, LAS unsigned char* lds, int item) {
    const int tid = threadIdx.x, wid = tid >> 6, lane = tid & 63, fr = lane & 15, fq = lane >> 4; unsigned char* ws = p.ws;
    const int chn = item >> 3, g = item & 7, m0 = chn * 128;
    const bf16_t* VN = (const bf16_t*)(ws + WS_GV); const bf16_t* SGW = (const bf16_t*)(ws + WS_SGW) + g * 16384; bf16_t* U = (bf16_t*)(ws + WS_Y3);
    LAS bf16_t* VT = (LAS bf16_t*)lds;
    { const int s = tid >> 2, hq = (tid & 3) * 32; const bf16_t* src = VN + (size_t)(m0 + s) * 1024 + g * 128 + hq;
#pragma unroll
      for (int c = 0; c < 4; ++c) { const u32x4 q = *(const u32x4*)(src + c * 8);
#pragma unroll
          for (int k = 0; k < 4; ++k) { VT[(hq + c * 8 + 2 * k) * 136 + s] = (bf16_t)(q[k] & 0xffffu); VT[(hq + c * 8 + 2 * k + 1) * 136 + s] = (bf16_t)(q[k] >> 16); } } }
    const int h0 = wid * 16; bf16x8 xf[4];
    const float* sgb = p.in[I_SGB] + g * 128;
    bf16x8 yf[8][4]; u32x2 uq[8]; float bias[8];
#pragma unroll
    for (int mt = 0; mt < 8; ++mt) {
#pragma unroll
        for (int ks = 0; ks < 4; ++ks) if (32 * ks <= 16 * mt + 15) yf[mt][ks] = *(const bf16x8*)(SGW + (mt * 16 + fr) * 128 + ks * 32 + fq * 8);
        uq[mt] = *(const u32x2*)(U + (size_t)(m0 + mt * 16 + fr) * 1024 + g * 128 + h0 + 4 * fq); bias[mt] = sgb[mt * 16 + fr]; }
    __syncthreads();
#pragma unroll
    for (int ks = 0; ks < 4; ++ks) xf[ks] = *(const LAS bf16x8*)(VT + (h0 + fr) * 136 + ks * 32 + fq * 8);
#pragma unroll
    for (int mt = 0; mt < 8; ++mt) { f32x4 acc = {0.f, 0.f, 0.f, 0.f};
#pragma unroll
        for (int ks = 0; ks < 4; ++ks) if (32 * ks <= 16 * mt + 15) acc = mfma16(xf[ks], yf[mt][ks], acc);
        bf16_t* up = U + (size_t)(m0 + mt * 16 + fr) * 1024 + g * 128 + h0 + 4 * fq; float uf[4]; unpack4(uq[mt], uf);
        u32x2 w; w[0] = pk2(uf[0] * (acc[0] + bias[mt]), uf[1] * (acc[1] + bias[mt])); w[1] = pk2(uf[2] * (acc[2] + bias[mt]), uf[3] * (acc[3] + bias[mt])); if (!DUMMY) *(u32x2*)up = w; else if (w[0] == 0x12345678u) up[0] = 0; }
    __syncthreads();
}
__device__ __forceinline__ void sg_sample_item(const Params& p, int item) {
    const int tid = threadIdx.x; unsigned char* ws = p.ws; const bf16_t* VN = (const bf16_t*)(ws + WS_GV); bf16_t* U = (bf16_t*)(ws + WS_Y3);
    const float* sgw = p.in[I_SGW]; const float* sgb = p.in[I_SGB];
    for (int e = tid; e < 32 * 128; e += 512) { const int r = e >> 7, c8 = (e & 127) * 8; const int m = MP + item * 32 + r, t = r & 3, g = c8 >> 7; float a[8];
#pragma unroll
        for (int k = 0; k < 8; ++k) a[k] = sgb[g * 128 + t];
        for (int s = 0; s <= t; ++s) { const float w = sgw[(g * 128 + t) * 128 + s]; const u32x4 q = *(const u32x4*)(VN + (size_t)(m - t + s) * 1024 + c8);
#pragma unroll
            for (int k = 0; k < 4; ++k) { a[2 * k] += w * bflo(q[k]); a[2 * k + 1] += w * bfhi(q[k]); } }
        bf16_t* up = U + (size_t)m * 1024 + c8; const u32x4 uq = *(const u32x4*)up; u32x4 o;
#pragma unroll
        for (int k = 0; k < 4; ++k) o[k] = pk2(bflo(uq[k]) * a[2 * k], bfhi(uq[k]) * a[2 * k + 1]);
        *(u32x4*)up = o; }
}

constexpr int Q_SATT = 0, Q_PATT = 512, Q_SGP = 1024, Q_SGS = 2048, Q_SSCAN = 2064, Q_END = 2064 + 2048;

template <int PH, bool DUMMY = false> __device__ __forceinline__ void run_phase(const Params& p, LAS unsigned char* lds) {
    unsigned char* ws = p.ws; const int G = gridDim.x, bid = blockIdx.x;
    if constexpr (PH == 0) phase0(p, lds);
    else if constexpr (PH == 1) {
        { pg8::Gemm g{(const bf16_t*)(ws + WS_HMB), (const bf16_t*)(ws + WS_WTMKV), 2048, 2048, 1024}; pg8::StaticOrder S; S.init(2048, 2048, G, (bid + 64) % G);
          EpiMem E{p.out, (bf16_t*)(ws + WS_MKB), (bf16_t*)(ws + WS_MVT)}; pg8::gemm_phase<EpiMem, pg8::StaticOrder, false>(lds, g, S, E, nullptr); }
        __syncthreads();
        { pg8::Gemm g{(const bf16_t*)(ws + WS_HB), (const bf16_t*)(ws + WS_WTIN), MT, PIN, 1024}; pg8::StaticOrder S; S.init(MT, PIN, G, bid);
          EpiZ E{(bf16_t*)(ws + WS_Y3), (bf16_t*)(ws + WS_GV), (bf16_t*)(ws + WS_SZ), (bf16_t*)(ws + WS_Y3) + (size_t)2 * MT * 1024, (bf16_t*)(ws + WS_GT), p.out};
          pg8::gemm_phase<EpiZ, pg8::StaticOrder, false>(lds, g, S, E, nullptr); }
    }
    else if constexpr (PH == 2) { const int wid = threadIdx.x >> 6, lane = threadIdx.x & 63; for (int m = wid * G + bid; m < MT; m += 24 * G) { const int mr[3] = {m, m + 8 * G, m + 16 * G}; p2_rows<3, DUMMY>(p, mr, lane); } }
    else if constexpr (PH == 11) { int kk = 256; asm volatile("" : "+s"(kk));
        pg8::Gemm g{(const bf16_t*)(ws + WS_XL), (const bf16_t*)(ws + WS_WTLORA), MP, 3072, kk}; pg8::StaticOrder S; S.init(MP, 3072, G, bid);
        EpiLora E{(bf16_t*)(ws + WS_E), (bf16_t*)(ws + WS_AV), (bf16_t*)(ws + WS_GG), p.in[I_W0], p.in[I_A0]}; pg8::gemm_phase<EpiLora, pg8::StaticOrder, false>(lds, g, S, E, nullptr);
        bf16_t* Eb = (bf16_t*)(ws + WS_E); const float* w0 = p.in[I_W0]; const float* a0 = p.in[I_A0];
        thin_gemm<1>(lds, (const bf16_t*)(ws + WS_XL), 0, (const bf16_t*)(ws + WS_WTLORA), 0, 1, 3072, kk,
            [&](int, const f32x4 (&acc)[4], f32x4 (&tot)[4], int, int) {
#pragma unroll
                for (int j = 0; j < 4; ++j) tot[j] = acc[j]; },
            [&](const f32x4 (&tot)[4], int row, int col) { const int seg = col >> 10;
#pragma unroll
                for (int j = 0; j < 4; ++j) { const int cc = (col & 1023) + 16 * j; f32x4 v = tot[j];
                    if (seg == 0) { const f32x4 bq = *(const f32x4*)(w0 + cc);
#pragma unroll
                        for (int q = 0; q < 4; ++q) v[q] = 0.60653066f * sigmoidf_(v[q] + bq[q]); }
                    else if (seg == 1) { const f32x4 bq = *(const f32x4*)(a0 + cc);
#pragma unroll
                        for (int q = 0; q < 4; ++q) v[q] = sigmoidf_(v[q] + bq[q]); }
                    u32x2 w; w[0] = pk2(v[0], v[1]); w[1] = pk2(v[2], v[3]); *(u32x2*)(Eb + (size_t)seg * 17301504 + (size_t)row * 1024 + cc) = w; } }); }
    else if constexpr (PH == 3 || PH == 10) {
#ifndef P3SPLIT
#define P3SPLIT 0
#endif
#ifndef P3SUB
#define P3SUB 31
#endif
        constexpr int SUB = DUMMY ? P3SUB : 31;
        constexpr bool DO_SCAN = (PH == 3), DO_REST = P3SPLIT ? (PH == 10) : (PH == 3);
        if (DO_SCAN && (SUB & 1) && bid < 128) { const int b = bid >> 4, h = bid & 15; scan_head(p, lds, b * 2048, 2048, h, nullptr, p.out + O_PWKV + (size_t)bid * 4096, nullptr); }
        unsigned* ctr = (unsigned*)(ws + WS_CTL) + (PH == 10 ? 1 : 0) + (DUMMY ? 2 : 0); LAS unsigned* qw = (LAS unsigned*)(lds + QW_OFF);
        const int q_lo = DO_REST ? 0 : Q_SSCAN, q_hi = DO_SCAN ? Q_END : Q_SSCAN;
        unsigned nxt = 0; if (threadIdx.x == 0) nxt = atomicAdd(ctr, 1u);
        for (;;) {
            __syncthreads();
            if (threadIdx.x == 0) { *qw = nxt; nxt = atomicAdd(ctr, 1u); }
            __syncthreads();
            const int it = (int)*qw + q_lo; if (it >= q_hi) break;
            if (it < Q_PATT) { if (SUB & 2) attn_sample_item<DUMMY>(p, lds, it); }
            else if (it < Q_SGP) { if (SUB & 4) attn_prompt_item<DUMMY>(p, lds, it - Q_PATT); }
            else if (it < Q_SGS) { if (SUB & 8) sg_prompt_item<DUMMY>(p, lds, it - Q_SGP); }
            else if (it < Q_SSCAN) { if (!DUMMY) sg_sample_item(p, it - Q_SGS); }
            else if (SUB & 16) { const int bh = it - Q_SSCAN, b = bh >> 4, h = bh & 15;
                scan_head(p, lds, MP + b * 4, 4, h, p.in[I_SWKV] + (size_t)bh * 4096, p.out + O_SWKV + (size_t)bh * 4096, p.in[I_SSH] + (size_t)b * PSH); }
        }
    }
    else if constexpr (PH == 4) { pg8::Gemm g{(const bf16_t*)(ws + WS_Y3), (const bf16_t*)(ws + WS_WTBR), 3 * MT, 3072, 1024}; BranchOrder S{G, bid};
        EpiMerge E{(const bf16_t*)(ws + WS_GT), (float*)(ws + WS_MF), (bf16_t*)(ws + WS_MB)}; pg8::gemm_phase<EpiMerge, BranchOrder, false>(lds, g, S, E, nullptr);
        const bf16_t* GT = (const bf16_t*)(ws + WS_GT); bf16_t* MB = (bf16_t*)(ws + WS_MB);
        thin_gemm<4>(lds, (const bf16_t*)(ws + WS_Y3), (size_t)MT * 1024, (const bf16_t*)(ws + WS_WTBR), (size_t)1048576, 3, 1024, 1024,
            [&](int n, const f32x4 (&acc)[4], f32x4 (&tot)[4], int row, int col) {
#pragma unroll
                for (int j = 0; j < 4; ++j) { float gf[4]; unpack4(*(const u32x2*)(GT + (size_t)row * 3072 + n * 1024 + col + 16 * j), gf);
                    tot[j][0] += acc[j][0] * gf[0]; tot[j][1] += acc[j][1] * gf[1]; tot[j][2] += acc[j][2] * gf[2]; tot[j][3] += acc[j][3] * gf[3]; } },
            [&](const f32x4 (&tot)[4], int row, int col) {
#pragma unroll
                for (int j = 0; j < 4; ++j) { u32x2 w; w[0] = pk2(tot[j][0], tot[j][1]); w[1] = pk2(tot[j][2], tot[j][3]); *(u32x2*)(MB + (size_t)row * 1024 + col + 16 * j) = w; } }); }
    else if constexpr (PH == 5) { pg8::Gemm g{(const bf16_t*)(ws + WS_MB), (const bf16_t*)(ws + WS_WTOUT), MP, 1024, 1024}; pg8::StaticOrder S; S.init(MP, 1024, G, bid);
        EpiRes E{p.in[I_XP], p.in[I_XS], (float*)(ws + WS_X1), (bf16_t*)(ws + WS_X1B), (float*)(ws + (DUMMY ? WS_XL : WS_SSQ1))}; pg8::gemm_phase<EpiRes, pg8::StaticOrder, false>(lds, g, S, E, nullptr);
        const float* xs = p.in[I_XS]; float* X1 = (float*)(ws + WS_X1); bf16_t* X1B = (bf16_t*)(ws + WS_X1B); float* ssq = (float*)(ws + (DUMMY ? WS_XL : WS_SSQ1));
        thin_gemm<4>(lds, (const bf16_t*)(ws + WS_MB), 0, (const bf16_t*)(ws + WS_WTOUT), 0, 1, 1024, 1024,
            [&](int, const f32x4 (&acc)[4], f32x4 (&tot)[4], int, int) {
#pragma unroll
                for (int j = 0; j < 4; ++j) tot[j] = acc[j]; },
            [&](const f32x4 (&tot)[4], int row, int col) { float ss = 0.f;
#pragma unroll
                for (int j = 0; j < 4; ++j) { const f32x4 v = tot[j] + *(const f32x4*)(xs + (size_t)(row - MP) * 1024 + col + 16 * j); *(f32x4*)(X1 + (size_t)row * 1024 + col + 16 * j) = v;
                    u32x2 w; w[0] = pk2(v[0], v[1]); w[1] = pk2(v[2], v[3]); *(u32x2*)(X1B + (size_t)row * 1024 + col + 16 * j) = w; ss += v[0] * v[0] + v[1] * v[1] + v[2] * v[2] + v[3] * v[3]; }
                ss += __shfl_xor(ss, 16); ss += __shfl_xor(ss, 32); if ((threadIdx.x & 63) < 16) atomicAdd(ssq + row, ss); }); }
    else if constexpr (PH == 6) { pg8::Gemm g{(const bf16_t*)(ws + WS_X1B), (const bf16_t*)(ws + WS_WTUP), MP, DFF, 1024}; pg8::StaticOrder S; S.init(MP, DFF, G, bid);
        EpiUp E{(const float*)(ws + WS_SSQ1), (bf16_t*)(ws + WS_HID)}; pg8::gemm_phase<EpiUp, pg8::StaticOrder, false>(lds, g, S, E, nullptr);
        const float* ssq = (const float*)(ws + WS_SSQ1); bf16_t* H = (bf16_t*)(ws + WS_HID);
        thin_gemm<1>(lds, (const bf16_t*)(ws + WS_X1B), 0, (const bf16_t*)(ws + WS_WTUP), 0, 1, DFF, 1024,
            [&](int, const f32x4 (&acc)[4], f32x4 (&tot)[4], int, int) {
#pragma unroll
                for (int j = 0; j < 4; ++j) tot[j] = acc[j]; },
            [&](const f32x4 (&tot)[4], int row, int col) { const float rs = rsqrtf(ssq[row] * (1.f / 1024.f) + 1e-6f);
#pragma unroll
                for (int j = 0; j < 4; ++j) { float h[4];
#pragma unroll
                    for (int q = 0; q < 4; ++q) { const float a = fmaxf(tot[j][q] * rs, 0.f); h[q] = a * a; }
                    u32x2 w; w[0] = pk2(h[0], h[1]); w[1] = pk2(h[2], h[3]); *(u32x2*)(H + (size_t)row * DFF + col + 16 * j) = w; } }); }
    else if constexpr (PH == 7) { pg8::Gemm g{(const bf16_t*)(ws + WS_HID), (const bf16_t*)(ws + WS_WTDN), MP, 1024, DFF}; pg8::StaticOrder S; S.init(MP, 1024, G, bid);
        const float* x1 = (const float*)(ws + WS_X1);
        EpiRes E{x1, x1 + (size_t)MP * 1024, (float*)(ws + WS_X2), nullptr, (float*)(ws + (DUMMY ? WS_XL : WS_SSQ2))}; pg8::gemm_phase<EpiRes, pg8::StaticOrder, false>(lds, g, S, E, nullptr);
        float* X2 = (float*)(ws + WS_X2); float* ssq = (float*)(ws + (DUMMY ? WS_XL : WS_SSQ2));
        thin_gemm<4>(lds, (const bf16_t*)(ws + WS_HID), 0, (const bf16_t*)(ws + WS_WTDN), 0, 1, 1024, DFF,
            [&](int, const f32x4 (&acc)[4], f32x4 (&tot)[4], int, int) {
#pragma unroll
                for (int j = 0; j < 4; ++j) tot[j] = acc[j]; },
            [&](const f32x4 (&tot)[4], int row, int col) { float ss = 0.f;
#pragma unroll
                for (int j = 0; j < 4; ++j) { const f32x4 v = tot[j] + *(const f32x4*)(x1 + (size_t)row * 1024 + col + 16 * j); *(f32x4*)(X2 + (size_t)row * 1024 + col + 16 * j) = v;
                    ss += v[0] * v[0] + v[1] * v[1] + v[2] * v[2] + v[3] * v[3]; }
                ss += __shfl_xor(ss, 16); ss += __shfl_xor(ss, 32); if ((threadIdx.x & 63) < 16) atomicAdd(ssq + row, ss); }); }
    else if constexpr (PH == 8) { const float* x2 = (const float*)(ws + WS_X2); const float* ssq = (const float*)(ws + WS_SSQ2); const float* gf = p.in[I_NFG];
        const int wid = threadIdx.x >> 6, lane = threadIdx.x & 63;
        f32x4 g[4];
#pragma unroll
        for (int c = 0; c < 4; ++c) g[c] = *(const f32x4*)(gf + c * 256 + lane * 4);
        for (int r0 = wid * G + bid; r0 < MT; r0 += 24 * G) {
            f32x4 v[3][4]; float rs[3];
#pragma unroll
            for (int i = 0; i < 3; ++i) { const int r = r0 + i * 8 * G; if (r < MT) { rs[i] = ssq[r];
#pragma unroll
                for (int c = 0; c < 4; ++c) v[i][c] = *(const f32x4*)(x2 + (size_t)r * 1024 + c * 256 + lane * 4); } }
#pragma unroll
            for (int i = 0; i < 3; ++i) { const int r = r0 + i * 8 * G; if (r < MT) { const float s = rsqrtf(rs[i] * (1.f / 1024.f) + 1e-6f);
#pragma unroll
                for (int c = 0; c < 4; ++c) *(f32x4*)(p.out + (size_t)r * 1024 + c * 256 + lane * 4) = v[i][c] * s * g[c]; } } } }
}
#ifdef DIAG_PHASES
template <int PH> __global__ __launch_bounds__(512, 2) void diag_phase(Params p) {
    extern __shared__ __attribute__((aligned(16))) unsigned char shm[];
    run_phase<PH>(p, (LAS unsigned char*)shm);
}
template __global__ void diag_phase<0>(Params); template __global__ void diag_phase<1>(Params); template __global__ void diag_phase<2>(Params);
template __global__ void diag_phase<3>(Params); template __global__ void diag_phase<4>(Params); template __global__ void diag_phase<5>(Params);
template __global__ void diag_phase<6>(Params); template __global__ void diag_phase<7>(Params); template __global__ void diag_phase<8>(Params);
#endif
template <int PH, bool DUMMY = false> __device__ __forceinline__ void phase_step(int ph_lo, int ph_hi, LAS unsigned char* lds, cg::grid_group& grid, unsigned& nbar) {
    constexpr int PE = (PH == 10) ? 3 : (PH == 11 ? 2 : PH);
    if (ph_lo <= PE && PE < ph_hi) {
        if (PH > ph_lo) {
            asm volatile("s_waitcnt vmcnt(0)" ::: "memory");
            __syncthreads();
            ++nbar;
            if (threadIdx.x == 0) {
                const __attribute__((address_space(4))) Params* pq = (const __attribute__((address_space(4))) Params*)__builtin_amdgcn_kernarg_segment_ptr();
                __attribute__((address_space(1))) unsigned char* wsb = (__attribute__((address_space(1))) unsigned char*)pq->ws;
                if (nbar == 1) {
                    __attribute__((address_space(1))) unsigned* bar = (__attribute__((address_space(1))) unsigned*)(wsb + WS_CTL + 128);
                    __builtin_amdgcn_fence(__ATOMIC_RELEASE, "agent"); asm volatile("s_waitcnt vmcnt(0)" ::: "memory");
                    __hip_atomic_fetch_add(bar, 1u, __ATOMIC_RELAXED, __HIP_MEMORY_SCOPE_AGENT);
                    while (__hip_atomic_load(bar, __ATOMIC_RELAXED, __HIP_MEMORY_SCOPE_AGENT) < gridDim.x) __builtin_amdgcn_s_sleep(2);
                    __builtin_amdgcn_fence(__ATOMIC_ACQUIRE, "agent"); asm volatile("s_waitcnt vmcnt(0)" ::: "memory");
                } else {
                    __attribute__((address_space(1))) unsigned* c2 = (__attribute__((address_space(1))) unsigned*)(wsb + WS_CTL2);
                    const unsigned xcc = (unsigned)__builtin_amdgcn_s_getreg((3 << 11) | 20) & 0xFu;
                    const unsigned nx = __hip_atomic_load(c2 + 1024 + xcc, __ATOMIC_RELAXED, __HIP_MEMORY_SCOPE_AGENT);
                    unsigned nxcc = 0;
                    for (int j = 0; j < 16; ++j) nxcc += __hip_atomic_load(c2 + 1024 + j, __ATOMIC_RELAXED, __HIP_MEMORY_SCOPE_AGENT) != 0u;
                    const unsigned k = nbar - 1;
                    const unsigned old = __hip_atomic_fetch_add(c2 + 64 * xcc, 1u, __ATOMIC_RELAXED, __HIP_MEMORY_SCOPE_AGENT);
                    if (old + 1 == k * nx) {
                        __builtin_amdgcn_fence(__ATOMIC_RELEASE, "agent"); asm volatile("s_waitcnt vmcnt(0)" ::: "memory");
                        const unsigned t = __hip_atomic_fetch_add(c2 + 1088, 1u, __ATOMIC_RELAXED, __HIP_MEMORY_SCOPE_AGENT);
                        if (t + 1 == k * nxcc) __hip_atomic_store(c2 + 1152, k, __ATOMIC_RELAXED, __HIP_MEMORY_SCOPE_AGENT);
                    }
                    while (__hip_atomic_load(c2 + 1152, __ATOMIC_RELAXED, __HIP_MEMORY_SCOPE_AGENT) < k) __builtin_amdgcn_s_sleep(1);
                    __builtin_amdgcn_fence(__ATOMIC_ACQUIRE, "agent"); asm volatile("s_waitcnt vmcnt(0)" ::: "memory");
                }
            }
            __syncthreads();
        }
        const __attribute__((address_space(4))) Params* pp = (const __attribute__((address_space(4))) Params*)__builtin_amdgcn_kernarg_segment_ptr();
        asm volatile("" : "+s"(pp) :: "memory");
        Params p;
#pragma unroll
        for (int i = 0; i < 33; ++i) p.in[i] = (const float*)(__attribute__((address_space(1))) const float*)pp->in[i];
        p.out = (float*)(__attribute__((address_space(1))) float*)pp->out; p.ws = (unsigned char*)(__attribute__((address_space(1))) unsigned char*)pp->ws;
        run_phase<PH, DUMMY>(p, lds);
    }
}
template <> __device__ __forceinline__ void run_phase<9, false>(const Params& p, LAS unsigned char* lds) {
    unsigned char* ws = p.ws; const int G = gridDim.x, bid = blockIdx.x; const int wid = threadIdx.x >> 6, lane = threadIdx.x & 63;
    for (int r = bid * 8 + wid; r < MT; r += G * 8) {
#pragma unroll
        for (int c = 0; c < 4; ++c) { const int col = c * 256 + lane * 4; f32x4 o;
#if DBG == 1
            const bf16_t* y3 = (const bf16_t*)(ws + WS_Y3); float a[4], b[4], d[4];
            unpack4(*(const u32x2*)(y3 + (size_t)r * 1024 + col), a); unpack4(*(const u32x2*)(y3 + (size_t)(MT + r) * 1024 + col), b); unpack4(*(const u32x2*)(y3 + (size_t)(2 * MT + r) * 1024 + col), d);
            for (int q = 0; q < 4; ++q) o[q] = a[q] + 2.f * b[q] + 4.f * d[q];
#elif DBG == 2
            float a[4]; unpack4(*(const u32x2*)((const bf16_t*)(ws + WS_MB) + (size_t)r * 1024 + col), a); for (int q = 0; q < 4; ++q) o[q] = a[q];
#elif DBG == 3
            o = *(const f32x4*)((const float*)(ws + WS_X1) + (size_t)r * 1024 + col);
#elif DBG == 4
            float a[4], b[4]; unpack4(*(const u32x2*)((const bf16_t*)(ws + WS_HID) + (size_t)r * DFF + col), a); unpack4(*(const u32x2*)((const bf16_t*)(ws + WS_HID) + (size_t)r * DFF + 2048 + col), b); for (int q = 0; q < 4; ++q) o[q] = a[q] + b[q];
#elif DBG == 5
            const bf16_t* y3 = (const bf16_t*)(ws + WS_Y3) + (size_t)(DBGSEL * MT + r) * 1024 + col; float a[4]; unpack4(*(const u32x2*)y3, a); for (int q = 0; q < 4; ++q) o[q] = a[q];
#else
            o = (f32x4){0.f, 0.f, 0.f, 0.f};
#endif
            *(f32x4*)(p.out + (size_t)r * 1024 + col) = o; } }
}
__global__ __launch_bounds__(512, 2) void mega(Params p, int ph_lo, int ph_hi) {
    extern __shared__ __attribute__((aligned(16))) unsigned char shm[];
    LAS unsigned char* lds = (LAS unsigned char*)shm;
    cg::grid_group grid = cg::this_grid();
#ifndef DUP
#define DUP -1
#endif
    unsigned nbar = 0;
    { const __attribute__((address_space(4))) Params* pq = (const __attribute__((address_space(4))) Params*)__builtin_amdgcn_kernarg_segment_ptr();
      __attribute__((address_space(1))) unsigned char* wsb = (__attribute__((address_space(1))) unsigned char*)pq->ws;
      if (ph_lo < 0) grid.sync();
      if (threadIdx.x == 0) { const unsigned xcc = (unsigned)__builtin_amdgcn_s_getreg((3 << 11) | 20) & 0xFu;
          __hip_atomic_fetch_add((__attribute__((address_space(1))) unsigned*)(wsb + WS_CTL2) + 1024 + xcc, 1u, __ATOMIC_RELAXED, __HIP_MEMORY_SCOPE_AGENT); } }
#define PSTEP(k) if (DUP == k) phase_step<k, true>(ph_lo, ph_hi, lds, grid, nbar); phase_step<k, false>(ph_lo, ph_hi, lds, grid, nbar);
    PSTEP(0) PSTEP(1) PSTEP(2) PSTEP(11) PSTEP(3)
#if P3SPLIT
    PSTEP(10)
#endif
    PSTEP(4) PSTEP(5) PSTEP(6) PSTEP(7) PSTEP(8)
#if DBG
    phase_step<9>(ph_lo, 10, lds, grid, nbar);
#endif
}

extern "C" void kernel_launch(void* const* d_in, const int* in_sizes, int n_in, void* d_out, int out_size, void* d_ws, size_t ws_size, hipStream_t stream) {
    static int grid_blocks = 0;
    if (grid_blocks == 0) {
        if (n_in != 33 || out_size != (int)O_END || ws_size < WS_END) { fprintf(stderr, "kernel_launch: unexpected shapes (n_in %d out %d ws %zu, need ws %zu)\n", n_in, out_size, ws_size, (size_t)WS_END); grid_blocks = -1; return; }
        int dev = 0, cus = 0, per_cu = 0;
        hipGetDevice(&dev); hipDeviceGetAttribute(&cus, hipDeviceAttributeMultiprocessorCount, dev);
        hipFuncSetAttribute((const void*)mega, hipFuncAttributeMaxDynamicSharedMemorySize, LDS_BYTES);
        hipOccupancyMaxActiveBlocksPerMultiprocessor(&per_cu, (const void*)mega, 512, LDS_BYTES);
        if (per_cu < 1) { fprintf(stderr, "kernel_launch: occupancy query says %d blocks per CU\n", per_cu); grid_blocks = -1; return; }
        grid_blocks = cus * 1;
        if (grid_blocks < 128) { fprintf(stderr, "kernel_launch: needs >= 128 CUs\n"); grid_blocks = -1; return; }
    }
    if (grid_blocks < 0) return;
    hipMemsetAsync((char*)d_ws + WS_CTL, 0, WS_WTIN - WS_CTL, stream);
    Params p{};
    for (int i = 0; i < 33; ++i) p.in[i] = (const float*)d_in[i];
    p.out = (float*)d_out; p.ws = (unsigned char*)d_ws;
#if DBG
    int lo = 0, hi = DBG_HI;
#else
    int lo = 0, hi = 9;
#endif
    void* args[] = {&p, &lo, &hi};
    hipError_t e = hipLaunchCooperativeKernel((const void*)mega, dim3(grid_blocks), dim3(512), args, LDS_BYTES, stream);
    if (e != hipSuccess) fprintf(stderr, "cooperative launch failed: %s (grid %d)\n", hipGetErrorString(e), grid_blocks);
}
```

```cpp
#include <hip/hip_runtime.h>
#include <hip/hip_cooperative_groups.h>
#include <cstdio>
namespace cg = cooperative_groups;
namespace pg8 {
#define PG8_LAS __attribute__((address_space(3)))
typedef unsigned short bf16_t;
typedef short bf16x8 __attribute__((ext_vector_type(8)));
typedef float f32x4 __attribute__((ext_vector_type(4)));
typedef unsigned u32x4 __attribute__((ext_vector_type(4)));
constexpr int BM = 256, BK = 64, HALF = 128, HTB = HALF * BK * 2  , STAGE_BYTES = 8 * HTB, NXCD = 8, WGM = 8;

__host__ __device__ __forceinline__ int lds_byte(int r, int c) { const int st = (r >> 4) * 2 + (c >> 5), rr = r & 15, cc = c & 31, ob = rr * 64 + cc * 2; return st * 1024 + (ob ^ (((ob >> 9) & 1) << 5)); }
__host__ __device__ __forceinline__ void stage_rc(int b, int& R, int& C) { const int st = b / 1024, sb = b % 1024, swz = sb ^ (((sb >> 9) & 1) << 5); R = (st >> 1) * 16 + swz / 64; C = (st & 1) * 32 + (swz % 64) / 2; }
__host__ __device__ __forceinline__ int perm32(int rho) { const int n = rho >> 4, i = rho & 15; return 8 * (i >> 2) + 4 * n + (i & 3); }

struct Unit { int pm, pn; };
struct Gemm { const bf16_t* A; const bf16_t* Bt; int M, N, K; };

struct StaticOrder {
    int nM, nN, nwg, G, c;
    __host__ __device__ void init(int M, int N, int G_, int c_) { nM = M / BM; nN = N / BM; nwg = nM * nN; G = G_; c = c_; }
    __host__ __device__ bool next(int i, Unit& u) const {
        const long L = (long)i * G + c; if (L >= nwg) return false;
        int wgid = (int)L; { const int q = nwg / NXCD, r = nwg % NXCD, xcd = wgid % NXCD, off = wgid / NXCD; wgid = (xcd < r ? xcd * (q + 1) : r * (q + 1) + (xcd - r) * q) + off; }
        const int nig = WGM * nN, gid = wgid / nig, fm = gid * WGM, gsz = (nM - fm) < WGM ? (nM - fm) : WGM;
        u.pm = fm + ((wgid % nig) % gsz); u.pn = (wgid % nig) / gsz; return true;
    }
    __device__ __forceinline__ void a_ready(const Unit&) const {}
    __device__ __forceinline__ void done(const Unit&) const {}
};
__device__ __forceinline__ unsigned cvt_pk_bf16(float lo, float hi) { unsigned r; asm volatile("v_cvt_pk_bf16_f32 %0, %1, %2" : "=v"(r) : "v"(lo), "v"(hi)); return r; }
template <class Epi, class Sched, bool STAMP = false>
__device__ __forceinline__ void gemm_phase(PG8_LAS unsigned char* lds, const Gemm g, const Sched& S, const Epi& E, unsigned long long* stamps) {
    const int tid = threadIdx.x, wid = __builtin_amdgcn_readfirstlane(tid >> 6), lane = tid & 63, wr = wid >> 2, wc = wid & 3, fr = lane & 15, fq = lane >> 4;
    const int K = g.K, nt = K / BK;
    int ts_lo = 0, ts_hi = 0, nts = 0; const unsigned long long rt_entry = STAMP ? (unsigned long long)wall_clock64() : 0ull;
#define PG8_STAMP() do { if (STAMP && wid == 0 && nts < 64) { const unsigned long long _c = (unsigned long long)clock64(); \
        ts_lo = (lane == nts) ? (int)(unsigned)_c : ts_lo; ts_hi = (lane == nts) ? (int)(unsigned)(_c >> 32) : ts_hi; ++nts; } } while (0)
    PG8_STAMP();
    unsigned voffA[2], voffB[2];
#pragma unroll
    for (int i = 0; i < 2; ++i) { int R, C; stage_rc(tid * 16 + i * 8192, R, C); const int Rb = Epi::PERM ? ((R & ~31) + perm32(R & 31)) : R;
        voffA[i] = (unsigned)(R * K + C) * 2u; voffB[i] = (unsigned)(Rb * K + C) * 2u; }
    const size_t kstep = (size_t)(BK * 2);
    const size_t hstep = (size_t)HALF * K * 2;
    const size_t tstep = 2 * hstep;
    const unsigned ldsw = (unsigned)wid * 1024u;
    const int aoff = lds_byte(wr * 64 + fr, fq * 8), boff = lds_byte(wc * 32 + fr, fq * 8);
#define PG8_SA(b, h) (((b) * 2 + (h)) * HTB)
#define PG8_SB(b, h) ((4 + (b) * 2 + (h)) * HTB)
#define PG8_STAGE(bufoff, gbase, voff) do { _Pragma("unroll") for (int _i = 0; _i < 2; ++_i) \
        __builtin_amdgcn_global_load_lds((const unsigned*)((const char*)(gbase) + (voff)[_i]), (PG8_LAS unsigned*)(lds + (bufoff) + ldsw + _i * 8192), 16, 0, 0); } while (0)
#define PG8_LDA(dst, b, h) do { _Pragma("unroll") for (int m = 0; m < 4; ++m) _Pragma("unroll") for (int k = 0; k < 2; ++k) dst[m][k] = *(const PG8_LAS bf16x8*)(lds + PG8_SA(b, h) + aoff + m * 2048 + k * 1024); } while (0)
#define PG8_LDB(dst, b, h) do { _Pragma("unroll") for (int n = 0; n < 2; ++n) _Pragma("unroll") for (int k = 0; k < 2; ++k) dst[n][k] = *(const PG8_LAS bf16x8*)(lds + PG8_SB(b, h) + boff + n * 2048 + k * 1024); } while (0)
#define PG8_MMA(ai, bj, At, Bt) do { __builtin_amdgcn_s_setprio(1); _Pragma("unroll") for (int m = 0; m < 4; ++m) _Pragma("unroll") for (int n = 0; n < 2; ++n) _Pragma("unroll") for (int k = 0; k < 2; ++k) \
        acc[ai][bj][m][n] = __builtin_amdgcn_mfma_f32_16x16x32_bf16(Bt[n][k], At[m][k], acc[ai][bj][m][n], 0, 0, 0); __builtin_amdgcn_s_setprio(0); } while (0)
#define PG8_WAIT_V(n) asm volatile("s_waitcnt vmcnt(" #n ")" ::: "memory")
#define PG8_WAIT_L(n) asm volatile("s_waitcnt lgkmcnt(" #n ")" ::: "memory")
#define PG8_BAR __builtin_amdgcn_s_barrier()
#define PG8_SCHED __builtin_amdgcn_sched_barrier(0)
    Unit cur, nxt; int ui = 0;
    if (!S.next(0, cur)) return;
    f32x4 acc[2][2][4][2];
#pragma unroll
    for (int a = 0; a < 2; ++a)
#pragma unroll
        for (int b = 0; b < 2; ++b)
#pragma unroll
            for (int m = 0; m < 4; ++m)
#pragma unroll
                for (int n = 0; n < 2; ++n) acc[a][b][m][n] = (f32x4){0.f, 0.f, 0.f, 0.f};
    bf16x8 At[4][2], B0[2][2], B1[2][2];
    const char* cA = (const char*)g.A + (size_t)cur.pm * tstep; const char* cB = (const char*)g.Bt + (size_t)cur.pn * tstep;
    S.a_ready(cur);
    PG8_STAGE(PG8_SB(0, 0), cB, voffB); PG8_STAGE(PG8_SA(0, 0), cA, voffA); PG8_STAGE(PG8_SB(0, 1), cB + hstep, voffB); PG8_STAGE(PG8_SA(0, 1), cA + hstep, voffA);
    if (wr == 1) PG8_BAR;
    PG8_WAIT_V(4); PG8_BAR;
    PG8_STAGE(PG8_SB(1, 0), cB + kstep, voffB); PG8_STAGE(PG8_SA(1, 0), cA + kstep, voffA); PG8_STAGE(PG8_SB(1, 1), cB + hstep + kstep, voffB);
    PG8_WAIT_V(6); PG8_BAR;
    PG8_STAMP();
    for (;;) {
        const bool has_next = S.next(ui + 1, nxt);
        const char* nA = has_next ? (const char*)g.A + (size_t)nxt.pm * tstep : cA; const char* nB = has_next ? (const char*)g.Bt + (size_t)nxt.pn * tstep : cB;
        for (int t = 0; t < nt; t += 2) {
            const bool last = (t == nt - 2);
            const char* a1 = cA + (size_t)(t + 1) * kstep;
            const char* a2 = last ? nA : cA + (size_t)(t + 2) * kstep; const char* b2 = last ? nB : cB + (size_t)(t + 2) * kstep;
            const char* a3 = a2 + kstep; const char* b3 = b2 + kstep;
            if (last && has_next) S.a_ready(nxt);
            PG8_LDB(B0, 0, 0); PG8_SCHED; PG8_LDA(At, 0, 0); PG8_STAGE(PG8_SA(1, 1), a1 + hstep, voffA);
            PG8_WAIT_L(8); PG8_BAR; PG8_WAIT_L(0); PG8_MMA(0, 0, At, B0); PG8_BAR; PG8_SCHED;
            PG8_LDB(B1, 0, 1); PG8_STAGE(PG8_SB(0, 0), b2, voffB);
            PG8_BAR; PG8_WAIT_L(0); PG8_MMA(0, 1, At, B1); PG8_BAR;
            PG8_LDA(At, 0, 1); PG8_STAGE(PG8_SA(0, 0), a2, voffA);
            PG8_BAR; PG8_WAIT_L(0); PG8_MMA(1, 0, At, B0); PG8_BAR; PG8_SCHED;
            PG8_STAGE(PG8_SB(0, 1), b2 + hstep, voffB);
            PG8_WAIT_V(6); PG8_BAR; PG8_MMA(1, 1, At, B1); PG8_BAR;
            PG8_LDB(B0, 1, 0); PG8_SCHED; PG8_LDA(At, 1, 0); PG8_STAGE(PG8_SA(0, 1), a2 + hstep, voffA);
            PG8_WAIT_L(8); PG8_BAR; PG8_WAIT_L(0); PG8_MMA(0, 0, At, B0); PG8_BAR; PG8_SCHED;
            PG8_LDB(B1, 1, 1); PG8_STAGE(PG8_SB(1, 0), b3, voffB);
            PG8_BAR; PG8_WAIT_L(0); PG8_MMA(0, 1, At, B1); PG8_BAR;
            PG8_LDA(At, 1, 1); PG8_STAGE(PG8_SA(1, 0), a3, voffA);
            PG8_BAR; PG8_WAIT_L(0); PG8_MMA(1, 0, At, B0); PG8_BAR; PG8_SCHED;
            PG8_STAGE(PG8_SB(1, 1), b3 + hstep, voffB);
            PG8_WAIT_V(6); PG8_BAR; PG8_MMA(1, 1, At, B1); PG8_BAR;
        }
        PG8_STAMP();
        if constexpr (!Epi::AFTER_DRAIN) { E(acc, cur, wr, wc, fr, fq); S.done(cur); }
        PG8_STAMP();
        if (!has_next) break;
#pragma unroll
        for (int a = 0; a < 2; ++a)
#pragma unroll
            for (int b = 0; b < 2; ++b)
#pragma unroll
                for (int m = 0; m < 4; ++m)
#pragma unroll
                    for (int n = 0; n < 2; ++n) acc[a][b][m][n] = (f32x4){0.f, 0.f, 0.f, 0.f};
        cur = nxt; cA = nA; cB = nB; ++ui;
    }
    PG8_WAIT_V(0);
    if (wr == 0) PG8_BAR;
    PG8_BAR;
    if constexpr (Epi::AFTER_DRAIN) { E.fused(acc, cur, wr, wc, fr, fq, lds, wid, lane); S.done(cur); }
    PG8_STAMP();
    if (STAMP && wid == 0) { stamps[lane] = lane < nts ? (((unsigned long long)(unsigned)ts_hi << 32) | (unsigned)ts_lo) : 0ull;
        if (lane == 62) stamps[62] = rt_entry; if (lane == 63) stamps[63] = (unsigned long long)wall_clock64(); }
#undef PG8_STAMP
#undef PG8_SA
#undef PG8_SB
#undef PG8_STAGE
#undef PG8_LDA
#undef PG8_LDB
#undef PG8_MMA
#undef PG8_WAIT_V
#undef PG8_WAIT_L
#undef PG8_BAR
#undef PG8_SCHED
}
}

using pg8::bf16_t; using pg8::bf16x8; using pg8::f32x4; using pg8::u32x4;
typedef unsigned u32x2 __attribute__((ext_vector_type(2)));
typedef float f32x2 __attribute__((ext_vector_type(2)));
#define LAS __attribute__((address_space(3)))
#ifndef DBG
#define DBG 0
#endif
#ifndef DBGSEL
#define DBGSEL 0
#endif

constexpr int MP = 16384, MS = 512, MT = 16896, DM = 1024, PIN = 9472, PSH = 3328, DFF = 4096;
constexpr int NPANEL = MT / 256;
constexpr size_t O_YP = 0, O_YS = 16777216, O_PSH = 17301504, O_PWKV = 17328128, O_PMK = 17852416, O_PMV = 19949568,
                 O_SSH = 22046720, O_SWKV = 22472704, O_SGV = 30861312, O_END = 31385600;
constexpr size_t WS_CTL = 0, WS_CTL2 = 256, WS_SSQ1 = 256 + 8192, WS_SSQ2 = WS_SSQ1 + 67584, WS_WTIN = WS_SSQ2 + 67584,
    WS_WTBR = WS_WTIN + 19398656, WS_WTOUT = WS_WTBR + 6291456, WS_WTUP = WS_WTOUT + 2097152, WS_WTDN = WS_WTUP + 8388608,
    WS_WTMKV = WS_WTDN + 8388608, WS_WTW2 = WS_WTMKV + 4194304, WS_WTA2 = WS_WTW2 + 131072, WS_WTG2 = WS_WTA2 + 131072,
    WS_SGW = WS_WTG2 + 262144, WS_HMB = WS_SGW + 262144, WS_MKB = WS_HMB + 4194304, WS_MVT = WS_MKB + 4194304,
    WS_Y3 = WS_MVT + 4194304, WS_GV = WS_Y3 + 103809024, WS_SZ = WS_GV + 34603008, WS_GT = WS_SZ + 112459776,
    WS_HB = WS_GT + 103809024, WS_AV = WS_HB + 34603008, WS_GG = WS_AV + 34603008, WS_XL = WS_GG + 34603008, WS_WTLORA = WS_XL + 8650752, WS_END = WS_WTLORA + 1572864;
constexpr size_t WS_MF = WS_SZ, WS_MB = WS_GV, WS_X1 = WS_GT, WS_X1B = WS_HB, WS_HID = WS_Y3, WS_X2 = WS_SZ, WS_E = WS_HB;
constexpr int LDS_BYTES = 131072 + 256;
constexpr int QW_OFF = 131072;

struct Params { const float* in[33]; float* out; unsigned char* ws; };

enum { I_XP = 0, I_XS, I_MEM, I_CK, I_CV, I_SSH, I_SWKV, I_N1G, I_WIN, I_MU, I_LNG, I_LNB, I_SGW, I_SGB, I_W0, I_WW2, I_A0, I_WA2,
       I_WG2, I_KK, I_KA, I_RK, I_LXG, I_LXB, I_MNG, I_WMK, I_WMV, I_WBR, I_WOUT, I_N2G, I_WUP, I_WDN, I_NFG };

__device__ __forceinline__ float bflo(unsigned u) { return __uint_as_float(u << 16); }
__device__ __forceinline__ float bfhi(unsigned u) { return __uint_as_float(u & 0xffff0000u); }
typedef __bf16 bf2_t __attribute__((ext_vector_type(2)));
__device__ __forceinline__ unsigned pk2(float lo, float hi) { const f32x2 v = {lo, hi}; const bf2_t b = __builtin_convertvector(v, bf2_t); return __builtin_bit_cast(unsigned, b); }
__device__ __forceinline__ float rcpf(float x) { return __builtin_amdgcn_rcpf(x); }
__device__ __forceinline__ float sigmoidf_(float x) { return rcpf(1.f + __expf(-x)); }
__device__ __forceinline__ float gelu_tanh(float x) { const float t = 1.5957691216f * (x + 0.044715f * x * x * x); return x * sigmoidf_(t); }
__device__ __forceinline__ float tanhf_(float x) { return 1.f - 2.f * rcpf(__expf(2.f * x) + 1.f); }
template <int CTRL> __device__ __forceinline__ float dpp_mov(float x) { return __int_as_float(__builtin_amdgcn_update_dpp(0, __float_as_int(x), CTRL, 0xF, 0xF, true)); }
__device__ __forceinline__ float red8(float x) { x += dpp_mov<0xB1>(x); x += dpp_mov<0x4E>(x); x += dpp_mov<0x141>(x); return x; }
__device__ __forceinline__ float red16(float x) { x = red8(x); x += dpp_mov<0x140>(x); return x; }
__device__ __forceinline__ float wave_sum(float x) { x = red16(x); x += __shfl_xor(x, 16); x += __shfl_xor(x, 32); return x; }
__device__ __forceinline__ float wave_max(float x) {
#pragma unroll
    for (int o = 1; o < 64; o <<= 1) x = fmaxf(x, __shfl_xor(x, o));
    return x; }
__device__ __forceinline__ f32x4 mfma16(bf16x8 a, bf16x8 b, f32x4 c) { return __builtin_amdgcn_mfma_f32_16x16x32_bf16(a, b, c, 0, 0, 0); }
__device__ __forceinline__ void unpack4(u32x2 q, float (&o)[4]) { o[0] = bflo(q[0]); o[1] = bfhi(q[0]); o[2] = bflo(q[1]); o[3] = bfhi(q[1]); }

struct TJob { const float* src; bf16_t* dst; const float* gain; int K, N, ldd; };
__device__ __forceinline__ void transpose_tile(const TJob& j, int tile, LAS float* t) {
    const int tid = threadIdx.x; const int tn = j.N >> 6; const int k0 = (tile / tn) << 6, n0 = (tile % tn) << 6;
#pragma unroll
    for (int pp = 0; pp < 2; ++pp) { const int r = (tid >> 4) + pp * 32, c = (tid & 15) * 4;
        const f32x4 v = *(const f32x4*)(j.src + (size_t)(k0 + r) * j.N + n0 + c); const float g = j.gain ? j.gain[k0 + r] : 1.f;
        t[r * 65 + c] = v[0] * g; t[r * 65 + c + 1] = v[1] * g; t[r * 65 + c + 2] = v[2] * g; t[r * 65 + c + 3] = v[3] * g; }
    __syncthreads();
    { const int n = tid >> 3, k8 = (tid & 7) * 8; u32x4 o;
#pragma unroll
      for (int q = 0; q < 4; ++q) o[q] = pk2(t[(k8 + 2 * q) * 65 + n], t[(k8 + 2 * q + 1) * 65 + n]);
      *(u32x4*)(j.dst + (size_t)(n0 + n) * j.ldd + k0 + k8) = o; }
    __syncthreads();
}
__device__ __forceinline__ void tr_one(const Params& p, LAS unsigned char* lds, int it) {
    unsigned char* ws = p.ws; TJob j; int base;
    if (it < 2368)      { j = {p.in[I_WIN], (bf16_t*)(ws + WS_WTIN), p.in[I_N1G], 1024, PIN, 1024}; base = 0; }
    else if (it < 3136) { const int n = (it - 2368) >> 8; j = {p.in[I_WBR] + (size_t)n * 1048576, (bf16_t*)(ws + WS_WTBR) + (size_t)n * 1048576, nullptr, 1024, 1024, 1024}; base = 2368 + n * 256; }
    else if (it < 3392) { j = {p.in[I_WOUT], (bf16_t*)(ws + WS_WTOUT), nullptr, 1024, 1024, 1024}; base = 3136; }
    else if (it < 4416) { j = {p.in[I_WUP], (bf16_t*)(ws + WS_WTUP), p.in[I_N2G], 1024, 4096, 1024}; base = 3392; }
    else if (it < 5440) { j = {p.in[I_WDN], (bf16_t*)(ws + WS_WTDN), nullptr, 4096, 1024, 4096}; base = 4416; }
    else if (it < 5696) { j = {p.in[I_WMK], (bf16_t*)(ws + WS_WTMKV), p.in[I_MNG], 1024, 1024, 1024}; base = 5440; }
    else if (it < 5952) { j = {p.in[I_WMV], (bf16_t*)(ws + WS_WTMKV) + 1048576, p.in[I_MNG], 1024, 1024, 1024}; base = 5696; }
    else if (it < 5968) { j = {p.in[I_WW2], (bf16_t*)(ws + WS_WTLORA), nullptr, 64, 1024, 256}; base = 5952; }
    else if (it < 5984) { j = {p.in[I_WA2], (bf16_t*)(ws + WS_WTLORA) + 1024 * 256 + 64, nullptr, 64, 1024, 256}; base = 5968; }
    else                { j = {p.in[I_WG2], (bf16_t*)(ws + WS_WTLORA) + 2048 * 256 + 128, nullptr, 128, 1024, 256}; base = 5984; }
    transpose_tile(j, it - base, (LAS float*)lds);
}
__device__ __forceinline__ void tr_late(const Params& p, LAS unsigned char* lds, int it) {
    unsigned char* ws = p.ws; TJob j; int base;
    if (it < 3392)      { const int n = (it - 2368) >> 8; j = {p.in[I_WBR] + (size_t)n * 1048576, (bf16_t*)(ws + WS_WTBR) + (size_t)n * 1048576, nullptr, 1024, 1024, 1024}; base = 2368 + n * 256; }
    else if (it < 4416) { j = {p.in[I_WUP], (bf16_t*)(ws + WS_WTUP), p.in[I_N2G], 1024, 4096, 1024}; base = 3392; }
    else                { j = {p.in[I_WDN], (bf16_t*)(ws + WS_WTDN), nullptr, 4096, 1024, 4096}; base = 4416; }
    if (it >= 3136 && it < 3392) { j = {p.in[I_WOUT], (bf16_t*)(ws + WS_WTOUT), nullptr, 1024, 1024, 1024}; base = 3136; }
    transpose_tile(j, it - base, (LAS float*)lds);
}
__device__ __forceinline__ void phase0(const Params& p, LAS unsigned char* lds) {
    const int tid = threadIdx.x, wid = tid >> 6, lane = tid & 63; unsigned char* ws = p.ws;
    for (int i = blockIdx.x; i < 2368 + 576; i += gridDim.x) tr_one(p, lds, i < 2368 ? i : i + 3072);
    for (int r = blockIdx.x * 8 + wid; r < MT + 2048; r += gridDim.x * 8) {
        const float* src; bf16_t* dst;
        if (r < MP) { src = p.in[I_XP] + (size_t)r * 1024; dst = (bf16_t*)(ws + WS_HB) + (size_t)r * 1024; }
        else if (r < MT) { src = p.in[I_XS] + (size_t)(r - MP) * 1024; dst = (bf16_t*)(ws + WS_HB) + (size_t)r * 1024; }
        else { src = p.in[I_MEM] + (size_t)(r - MT) * 1024; dst = (bf16_t*)(ws + WS_HMB) + (size_t)(r - MT) * 1024; }
        f32x4 v[4]; float ss = 0.f;
#pragma unroll
        for (int c = 0; c < 4; ++c) { v[c] = *(const f32x4*)(src + c * 256 + lane * 4); ss += v[c][0] * v[c][0] + v[c][1] * v[c][1] + v[c][2] * v[c][2] + v[c][3] * v[c][3]; }
        ss = wave_sum(ss); const float rs = rsqrtf(ss * (1.f / 1024.f) + 1e-6f);
#pragma unroll
        for (int c = 0; c < 4; ++c) { u32x2 o; o[0] = pk2(v[c][0] * rs, v[c][1] * rs); o[1] = pk2(v[c][2] * rs, v[c][3] * rs); *(u32x2*)(dst + c * 256 + lane * 4) = o; }
    }
    { bf16_t* wl = (bf16_t*)(ws + WS_WTLORA);
      for (int i = blockIdx.x * 512 + tid; i < 3072 * 32; i += gridDim.x * 512) { const int row = i >> 5, cc = (i & 31) * 8, blk = row >> 10;
          const bool used = (blk == 0 && cc < 64) || (blk == 1 && cc >= 64 && cc < 128) || (blk == 2 && cc >= 128);
          if (!used) *(u32x4*)(wl + (size_t)row * 256 + cc) = (u32x4){0u, 0u, 0u, 0u}; } }
    { const float* sg = p.in[I_SGW]; bf16_t* d = (bf16_t*)(ws + WS_SGW);
      for (int i = blockIdx.x * 512 + tid; i < 8 * 128 * 128; i += gridDim.x * 512) { const int t = (i >> 7) & 127, s = i & 127; d[i] = (bf16_t)(pk2(s <= t ? sg[i] : 0.f, 0.f) & 0xffffu); } }
}

struct EpiZ {
    static constexpr bool PERM = true, AFTER_DRAIN = false;
    bf16_t *U, *GVp, *SZp, *Qp, *GTp; float* out;
    __device__ __forceinline__ void operator()(const f32x4 (&acc)[2][2][4][2], const pg8::Unit& u, int wr, int wc, int fr, int fq) const {
        const int pn = u.pn; bf16_t* base; int ldc, colt, act;
        if (pn < 4) { base = U; ldc = 1024; colt = pn * 256; act = 1; }
        else if (pn < 8) { base = GVp; ldc = 1024; colt = (pn - 4) * 256; act = 1; }
        else if (pn < 21) { base = SZp; ldc = PSH; colt = (pn - 8) * 256; act = 0; }
        else if (pn < 25) { base = Qp; ldc = 1024; colt = (pn - 21) * 256; act = 3; }
        else { base = GTp; ldc = 3072; colt = (pn - 25) * 256; act = 2; }
        const int row0 = u.pm * 256 + wr * 64 + fr, col0 = colt + wc * 32 + 8 * fq;
#pragma unroll
        for (int ai = 0; ai < 2; ++ai)
#pragma unroll
            for (int m = 0; m < 4; ++m) { const int row = row0 + ai * 128 + m * 16; bf16_t* rowp = base + (size_t)row * ldc + col0;
#pragma unroll
                for (int bj = 0; bj < 2; ++bj) { f32x4 v0 = acc[ai][bj][m][0], v1 = acc[ai][bj][m][1];
                    if (act == 1) {
#pragma unroll
                        for (int q = 0; q < 4; ++q) { v0[q] = gelu_tanh(v0[q]); v1[q] = gelu_tanh(v1[q]); } }
                    else if (act == 2) {
#pragma unroll
                        for (int q = 0; q < 4; ++q) { v0[q] = sigmoidf_(v0[q]); v1[q] = sigmoidf_(v1[q]); } }
                    else if (act == 0) {
                        const bool lastp = row < MP ? ((row & 2047) == 2047) : (((row - MP) & 3) == 3);
                        if (lastp) { float* d = (row < MP ? out + O_PSH + (size_t)(row >> 11) * PSH : out + O_SSH + (size_t)((row - MP) >> 2) * PSH) + col0 + bj * 128;
                            *(f32x4*)d = v0; *(f32x4*)(d + 4) = v1; } }
                    u32x4 o; o[0] = pk2(v0[0], v0[1]); o[1] = pk2(v0[2], v0[3]); o[2] = pk2(v1[0], v1[1]); o[3] = pk2(v1[2], v1[3]);
                    *(u32x4*)(rowp + bj * 128) = o; } }
    }
};
struct EpiMem {
    static constexpr bool PERM = false, AFTER_DRAIN = false;
    float* out; bf16_t *MKB, *MVT;
    __device__ __forceinline__ void operator()(const f32x4 (&acc)[2][2][4][2], const pg8::Unit& u, int wr, int wc, int fr, int fq) const {
        const int row0 = u.pm * 256 + wr * 64 + fr, col0 = u.pn * 256 + wc * 32 + 4 * fq; const bool isv = u.pn >= 4;
#pragma unroll
        for (int ai = 0; ai < 2; ++ai)
#pragma unroll
            for (int m = 0; m < 4; ++m) { const int row = row0 + ai * 128 + m * 16;
#pragma unroll
                for (int bj = 0; bj < 2; ++bj)
#pragma unroll
                    for (int n = 0; n < 2; ++n) { const f32x4 v = acc[ai][bj][m][n]; const int col = col0 + bj * 128 + n * 16;
                        if (!isv) { *(f32x4*)(out + O_PMK + (size_t)row * 1024 + col) = v; u32x2 o; o[0] = pk2(v[0], v[1]); o[1] = pk2(v[2], v[3]); *(u32x2*)(MKB + (size_t)row * 1024 + col) = o; }
                        else { const int c = col - 1024; *(f32x4*)(out + O_PMV + (size_t)row * 1024 + c) = v;
                            const int b = row >> 8, mem = row & 255, head = c >> 8, d = c & 255; bf16_t* dst = MVT + ((size_t)((b * 4 + head) * 256 + d)) * 256 + mem;
                            const unsigned p0 = pk2(v[0], v[1]), p1 = pk2(v[2], v[3]);
                            dst[0] = (bf16_t)(p0 & 0xffffu); dst[256] = (bf16_t)(p0 >> 16); dst[512] = (bf16_t)(p1 & 0xffffu); dst[768] = (bf16_t)(p1 >> 16); } } }
    }
};
struct BranchOrder {
    int G, c;
    __device__ bool next(int i, pg8::Unit& u) const { const int tile = (i / 3) * G + c, n = i % 3; if (tile >= (MP / 256) * 4) return false;
        const int xcd = tile & 7, q = tile >> 3, pm = xcd * 8 + (q >> 2), pn = q & 3;
        u.pm = n * NPANEL + pm; u.pn = n * 4 + pn; return true; }
    __device__ __forceinline__ void a_ready(const pg8::Unit&) const {}
    __device__ __forceinline__ void done(const pg8::Unit&) const {}
};
struct EpiMerge {
    static constexpr bool PERM = false, AFTER_DRAIN = false;
    const bf16_t* GT; float* MF; bf16_t* MB;
    __device__ __forceinline__ void operator()(const f32x4 (&acc)[2][2][4][2], const pg8::Unit& u, int wr, int wc, int fr, int fq) const {
        const int n = u.pm / NPANEL, pm = u.pm - n * NPANEL, pn = u.pn & 3;
        const int row0 = pm * 256 + wr * 64 + fr, col0 = pn * 256 + wc * 32 + 4 * fq;
        u32x2 g[2][4]; f32x4 o[2][4];
        auto issue = [&](int grp, int slot) { const int row = row0 + (grp >> 2) * 128 + (grp & 3) * 16; const bf16_t* gp = GT + (size_t)row * 3072 + n * 1024 + col0; const float* mp = MF + (size_t)row * 1024 + col0;
#pragma unroll
            for (int x = 0; x < 4; ++x) { g[slot][x] = *(const u32x2*)(gp + (x >> 1) * 128 + (x & 1) * 16); if (n > 0) o[slot][x] = *(const f32x4*)(mp + (x >> 1) * 128 + (x & 1) * 16); else o[slot][x] = (f32x4){0.f, 0.f, 0.f, 0.f}; } };
        issue(0, 0);
#pragma unroll
        for (int grp = 0; grp < 8; ++grp) { const int slot = grp & 1, ai = grp >> 2, m = grp & 3; const int row = row0 + ai * 128 + m * 16;
            if (grp < 7) issue(grp + 1, slot ^ 1);
            float* mp = MF + (size_t)row * 1024 + col0;
#pragma unroll
            for (int x = 0; x < 4; ++x) { float gf[4]; unpack4(g[slot][x], gf); f32x4 v = acc[ai][x >> 1][m][x & 1];
                v[0] = v[0] * gf[0] + o[slot][x][0]; v[1] = v[1] * gf[1] + o[slot][x][1]; v[2] = v[2] * gf[2] + o[slot][x][2]; v[3] = v[3] * gf[3] + o[slot][x][3];
                if (n < 2) *(f32x4*)(mp + (x >> 1) * 128 + (x & 1) * 16) = v;
                else { u32x2 w; w[0] = pk2(v[0], v[1]); w[1] = pk2(v[2], v[3]); *(u32x2*)(MB + (size_t)row * 1024 + col0 + (x >> 1) * 128 + (x & 1) * 16) = w; } } }
    }
};
template <int KS, class Mid, class Fin>
__device__ __forceinline__ void thin_gemm(LAS unsigned char* lds, const bf16_t* A0, size_t a_bstride, const bf16_t* B0, size_t b_bstride, int nb, int N, int K, const Mid& mid, const Fin& fin) {
    const int wid = threadIdx.x >> 6, lane = threadIdx.x & 63, fr = lane & 15, fq = lane >> 4; const int ntask = 32 * (N >> 6);
    constexpr int TPB = 8 / KS; const int grp = wid / KS, kq = wid % KS, kspan = K / KS;
    LAS f32x4* red = (LAS f32x4*)lds;
    for (int t0 = blockIdx.x * TPB; t0 < ntask; t0 += gridDim.x * TPB) {
        const int t = t0 + grp; const bool valid = t < ntask;
        const int r0 = MP + (t & 31) * 16, c0 = (t >> 5) * 64;
        f32x4 tot[4];
#pragma unroll
        for (int j = 0; j < 4; ++j) tot[j] = (f32x4){0.f, 0.f, 0.f, 0.f};
        if (valid) for (int n = 0; n < nb; ++n) { f32x4 acc[4];
#pragma unroll
            for (int j = 0; j < 4; ++j) acc[j] = (f32x4){0.f, 0.f, 0.f, 0.f};
            const bf16_t* ap = A0 + (size_t)n * a_bstride + (size_t)(r0 + fr) * K + kq * kspan + fq * 8; const bf16_t* bp = B0 + (size_t)n * b_bstride + (size_t)(c0 + fr) * K + kq * kspan + fq * 8;
#pragma unroll 4
            for (int ks = 0; ks < (kspan >> 5); ++ks) { const bf16x8 a = *(const bf16x8*)(ap + ks * 32);
#pragma unroll
                for (int j = 0; j < 4; ++j) { const bf16x8 b = *(const bf16x8*)(bp + (size_t)j * 16 * K + ks * 32); acc[j] = mfma16(b, a, acc[j]); } }
            mid(n, acc, tot, r0 + fr, c0 + 4 * fq); }
        if (KS > 1) {
#pragma unroll
            for (int j = 0; j < 4; ++j) red[(wid * 4 + j) * 64 + lane] = tot[j];
            __syncthreads();
            if (kq == 0 && valid) {
#pragma unroll
                for (int q = 1; q < KS; ++q)
#pragma unroll
                    for (int j = 0; j < 4; ++j) tot[j] += red[((wid + q) * 4 + j) * 64 + lane];
                fin(tot, r0 + fr, c0 + 4 * fq); }
            __syncthreads();
        } else if (valid) fin(tot, r0 + fr, c0 + 4 * fq);
    }
}
struct EpiRes {
    static constexpr bool PERM = false, AFTER_DRAIN = false;
    const float* resP; const float* resS; float* X; bf16_t* XB; float* ssq;
    __device__ __forceinline__ void operator()(const f32x4 (&acc)[2][2][4][2], const pg8::Unit& u, int wr, int wc, int fr, int fq) const {
        const int row0 = u.pm * 256 + wr * 64 + fr, col0 = u.pn * 256 + wc * 32 + 4 * fq;
#pragma unroll
        for (int ai = 0; ai < 2; ++ai) { f32x4 r[4][4];
#pragma unroll
            for (int m = 0; m < 4; ++m) { const int row = row0 + ai * 128 + m * 16; const float* rp = (row < MP ? resP + (size_t)row * 1024 : resS + (size_t)(row - MP) * 1024) + col0;
#pragma unroll
                for (int x = 0; x < 4; ++x) r[m][x] = *(const f32x4*)(rp + (x >> 1) * 128 + (x & 1) * 16); }
#pragma unroll
            for (int m = 0; m < 4; ++m) { const int row = row0 + ai * 128 + m * 16; float ss = 0.f;
#pragma unroll
                for (int x = 0; x < 4; ++x) { const int col = col0 + (x >> 1) * 128 + (x & 1) * 16; const f32x4 v = acc[ai][x >> 1][m][x & 1] + r[m][x];
                    *(f32x4*)(X + (size_t)row * 1024 + col) = v; ss += v[0] * v[0] + v[1] * v[1] + v[2] * v[2] + v[3] * v[3];
                    if (XB) { u32x2 w; w[0] = pk2(v[0], v[1]); w[1] = pk2(v[2], v[3]); *(u32x2*)(XB + (size_t)row * 1024 + col) = w; } }
                ss += __shfl_xor(ss, 16); ss += __shfl_xor(ss, 32);
                if (fq == 0) atomicAdd(ssq + row, ss); } }
    }
};
struct EpiUp {
    static constexpr bool PERM = true, AFTER_DRAIN = false;
    const float* ssq; bf16_t* H;
    __device__ __forceinline__ void operator()(const f32x4 (&acc)[2][2][4][2], const pg8::Unit& u, int wr, int wc, int fr, int fq) const {
        const int row0 = u.pm * 256 + wr * 64 + fr, col0 = u.pn * 256 + wc * 32 + 8 * fq;
#pragma unroll
        for (int ai = 0; ai < 2; ++ai)
#pragma unroll
            for (int m = 0; m < 4; ++m) { const int row = row0 + ai * 128 + m * 16; const float rs = rsqrtf(ssq[row] * (1.f / 1024.f) + 1e-6f);
#pragma unroll
                for (int bj = 0; bj < 2; ++bj) { f32x4 v0 = acc[ai][bj][m][0], v1 = acc[ai][bj][m][1];
#pragma unroll
                    for (int q = 0; q < 4; ++q) { float a = fmaxf(v0[q] * rs, 0.f); v0[q] = a * a; float b = fmaxf(v1[q] * rs, 0.f); v1[q] = b * b; }
                    u32x4 o; o[0] = pk2(v0[0], v0[1]); o[1] = pk2(v0[2], v0[3]); o[2] = pk2(v1[0], v1[1]); o[3] = pk2(v1[2], v1[3]);
                    *(u32x4*)(H + (size_t)row * DFF + col0 + bj * 128) = o; } }
    }
};

template <int NR, bool DUMMY> __device__ __forceinline__ void p2_rows(const Params& p, const int (&mrow)[NR], int lane) {
    unsigned char* ws = p.ws; const float* lng = p.in[I_LNG]; const float* lnb = p.in[I_LNB];
    const int c4 = lane * 4;
    u32x4 q0[NR], q1[NR]; u32x2 cq[NR], pq[NR]; f32x4 sq[NR]; bool valid[NR], first[NR];
#pragma unroll
    for (int i = 0; i < NR; ++i) { const int m = mrow[i]; valid[i] = m < MT; const int mm = valid[i] ? m : 0;
        const bf16_t* row = (const bf16_t*)(ws + WS_GV) + (size_t)mm * 1024; q0[i] = *(const u32x4*)(row + lane * 8); q1[i] = *(const u32x4*)(row + 512 + lane * 8);
        const bf16_t* cur = (const bf16_t*)(ws + WS_SZ) + (size_t)mm * PSH + 3072 + c4; cq[i] = *(const u32x2*)cur;
        first[i] = mm < MP ? ((mm & 2047) == 0) : (((mm - MP) & 3) == 0);
        pq[i] = (u32x2){0u, 0u}; sq[i] = (f32x4){0.f, 0.f, 0.f, 0.f};
        if (!first[i]) pq[i] = *(const u32x2*)(cur - PSH);
        else if (mm >= MP) sq[i] = *(const f32x4*)(p.in[I_SSH] + (size_t)((mm - MP) >> 2) * PSH + 3072 + c4); }
    const f32x4 mu = *(const f32x4*)(p.in[I_MU] + 3072 + c4);
    f32x4 g0[2], g1[2], b0[2], b1[2];
#pragma unroll
    for (int c = 0; c < 2; ++c) { const int col = c * 512 + lane * 8; g0[c] = *(const f32x4*)(lng + col); g1[c] = *(const f32x4*)(lng + col + 4); b0[c] = *(const f32x4*)(lnb + col); b1[c] = *(const f32x4*)(lnb + col + 4); }
#pragma unroll
    for (int i = 0; i < NR; ++i) { if (!valid[i]) continue; const int m = mrow[i]; bf16_t* row = (bf16_t*)(ws + WS_GV) + (size_t)m * 1024; float x[16];
#pragma unroll
        for (int k = 0; k < 4; ++k) { x[2 * k] = bflo(q0[i][k]); x[2 * k + 1] = bfhi(q0[i][k]); x[8 + 2 * k] = bflo(q1[i][k]); x[8 + 2 * k + 1] = bfhi(q1[i][k]); }
        float s = 0.f;
#pragma unroll
        for (int k = 0; k < 16; ++k) s += x[k];
        s = wave_sum(s); const float mean = s * (1.f / 1024.f); float vs = 0.f;
#pragma unroll
        for (int k = 0; k < 16; ++k) { x[k] -= mean; vs += x[k] * x[k]; }
        vs = wave_sum(vs); const float rstd = rsqrtf(vs * (1.f / 1024.f) + 1e-5f);
#pragma unroll
        for (int c = 0; c < 2; ++c) { const int col = c * 512 + lane * 8; float y[8];
#pragma unroll
            for (int k = 0; k < 4; ++k) { y[k] = x[c * 8 + k] * rstd * g0[c][k] + b0[c][k]; y[4 + k] = x[c * 8 + 4 + k] * rstd * g1[c][k] + b1[c][k]; }
            u32x4 o; o[0] = pk2(y[0], y[1]); o[1] = pk2(y[2], y[3]); o[2] = pk2(y[4], y[5]); o[3] = pk2(y[6], y[7]); if (!DUMMY) *(u32x4*)(row + col) = o;
            if (m >= MP) { float* d = p.out + O_SGV + (size_t)(m - MP) * 1024 + col; *(f32x4*)d = (f32x4){y[0], y[1], y[2], y[3]}; *(f32x4*)(d + 4) = (f32x4){y[4], y[5], y[6], y[7]}; } }
        float cv[4], pv[4], o[4]; unpack4(cq[i], cv);
        if (!first[i]) unpack4(pq[i], pv); else { pv[0] = sq[i][0]; pv[1] = sq[i][1]; pv[2] = sq[i][2]; pv[3] = sq[i][3]; }
#pragma unroll
        for (int e = 0; e < 4; ++e) { const float ss = cv[e] + (pv[e] - cv[e]) * mu[e]; o[e] = lane < 16 ? tanhf_(ss) : (lane < 32 ? ss : sigmoidf_(ss)); }
        u32x2 w; w[0] = pk2(o[0], o[1]); w[1] = pk2(o[2], o[3]); *(u32x2*)((bf16_t*)(ws + WS_XL) + (size_t)m * 256 + c4) = w; }
}
struct EpiLora {
    static constexpr bool PERM = true, AFTER_DRAIN = false;
    bf16_t *E, *A, *Gg; const float *w0, *a0;
    __device__ __forceinline__ void operator()(const f32x4 (&acc)[2][2][4][2], const pg8::Unit& u, int wr, int wc, int fr, int fq) const {
        const int seg = u.pn >> 2, colt = (u.pn & 3) * 256; bf16_t* base = E + (size_t)seg * 17301504;
        const int row0 = u.pm * 256 + wr * 64 + fr, col0 = colt + wc * 32 + 8 * fq;
        f32x4 bv[2][2];
#pragma unroll
        for (int bj = 0; bj < 2; ++bj) { if (seg == 0) { bv[bj][0] = *(const f32x4*)(w0 + col0 + bj * 128); bv[bj][1] = *(const f32x4*)(w0 + col0 + bj * 128 + 4); } else if (seg == 1) { bv[bj][0] = *(const f32x4*)(a0 + col0 + bj * 128); bv[bj][1] = *(const f32x4*)(a0 + col0 + bj * 128 + 4); } else { bv[bj][0] = (f32x4){0.f, 0.f, 0.f, 0.f}; bv[bj][1] = bv[bj][0]; } }
#pragma unroll
        for (int ai = 0; ai < 2; ++ai)
#pragma unroll
            for (int m = 0; m < 4; ++m) { const int row = row0 + ai * 128 + m * 16; bf16_t* rowp = base + (size_t)row * 1024 + col0;
#pragma unroll
                for (int bj = 0; bj < 2; ++bj) { f32x4 v0 = acc[ai][bj][m][0] + bv[bj][0], v1 = acc[ai][bj][m][1] + bv[bj][1];
                    if (seg == 0) {
#pragma unroll
                        for (int q = 0; q < 4; ++q) { v0[q] = 0.60653066f * sigmoidf_(v0[q]); v1[q] = 0.60653066f * sigmoidf_(v1[q]); } }
                    else if (seg == 1) {
#pragma unroll
                        for (int q = 0; q < 4; ++q) { v0[q] = sigmoidf_(v0[q]); v1[q] = sigmoidf_(v1[q]); } }
                    u32x4 o; o[0] = pk2(v0[0], v0[1]); o[1] = pk2(v0[2], v0[3]); o[2] = pk2(v1[0], v1[1]); o[3] = pk2(v1[2], v1[3]);
                    *(u32x4*)(rowp + bj * 128) = o; } }
    }
};

struct ScanPre { u32x2 cr, ck, cv, pr, pk, pv, e, a, g; };
__device__ __forceinline__ u32x2 pack4f(const float* s) { const f32x4 q = *(const f32x4*)s; u32x2 o; o[0] = pk2(q[0], q[1]); o[1] = pk2(q[2], q[3]); return o; }
__device__ __forceinline__ void scan_head(const Params& p, LAS unsigned char* lds, int row0, int T, int h, const float* s0, float* sfin, const float* shift0) {
    const int tid = threadIdx.x, wid = tid >> 6, lane = tid & 63; unsigned char* ws = p.ws;
    const bf16_t* SZp = (const bf16_t*)(ws + WS_SZ); const bf16_t* Ep = (const bf16_t*)(ws + WS_E); const bf16_t* Ap = (const bf16_t*)(ws + WS_AV); const bf16_t* Gp = (const bf16_t*)(ws + WS_GG);
    bf16_t* YB = (bf16_t*)(ws + WS_Y3) + (size_t)MT * 1024;
    LAS float* bufs = (LAS float*)lds;
    LAS float* Yl2 = (LAS float*)(lds + 98304);
    LAS float* BON = (LAS float*)(lds + 98304 + 16384);
    const bool helper = wid >= 4; const int htid = tid & 255;
    const int tth = htid >> 4, j4 = (htid & 15) * 4, ch = h * 64 + j4;
    const int si = (wid & 3) * 16 + (lane >> 3) * 2, jb = (lane & 7) * 8;
    f32x2 S0[4], S1[4];
    if (s0 && !helper) {
#pragma unroll
        for (int q = 0; q < 4; ++q) { S0[q] = *(const f32x2*)(s0 + si * 64 + jb + 2 * q); S1[q] = *(const f32x2*)(s0 + (si + 1) * 64 + jb + 2 * q); } }
    else {
#pragma unroll
        for (int q = 0; q < 4; ++q) { S0[q] = (f32x2){0.f, 0.f}; S1[q] = S0[q]; } }
    auto load_pre = [&](int t0, ScanPre (&P)[2]) {
#pragma unroll
        for (int pp = 0; pp < 2; ++pp) { const int t = t0 + tth + 16 * pp; ScanPre& Q = P[pp];
            if (t < T) { const size_t m = (size_t)(row0 + t); const bf16_t* c = SZp + m * PSH + ch;
                Q.cr = *(const u32x2*)c; Q.ck = *(const u32x2*)(c + 1024); Q.cv = *(const u32x2*)(c + 2048);
                if (t > 0) { Q.pr = *(const u32x2*)(c - PSH); Q.pk = *(const u32x2*)(c - PSH + 1024); Q.pv = *(const u32x2*)(c - PSH + 2048); }
                else if (shift0) { Q.pr = pack4f(shift0 + ch); Q.pk = pack4f(shift0 + 1024 + ch); Q.pv = pack4f(shift0 + 2048 + ch); }
                else { Q.pr = (u32x2){0u, 0u}; Q.pk = Q.pr; Q.pv = Q.pr; }
                Q.e = *(const u32x2*)(Ep + m * 1024 + ch); Q.a = *(const u32x2*)(Ap + m * 1024 + ch); Q.g = (u32x2){0u, 0u}; }
            else { Q.cr = (u32x2){0u, 0u}; Q.ck = Q.cr; Q.cv = Q.cr; Q.pr = Q.cr; Q.pk = Q.cr; Q.pv = Q.cr; Q.e = Q.cr; Q.a = Q.cr; Q.g = Q.cr; } }
    };
    auto store_pre = [&](const ScanPre (&P)[2], int nb) {
        const f32x4 mur = *(const f32x4*)(p.in[I_MU] + ch), muk = *(const f32x4*)(p.in[I_MU] + 1024 + ch), muv = *(const f32x4*)(p.in[I_MU] + 2048 + ch),
                    kkc = *(const f32x4*)(p.in[I_KK] + ch), kac = *(const f32x4*)(p.in[I_KA] + ch), rkc = *(const f32x4*)(p.in[I_RK] + ch);
#pragma unroll
        for (int pp = 0; pp < 2; ++pp) { const ScanPre& Q = P[pp]; const int tt = tth + 16 * pp;
            float cr[4], ck[4], cv[4], pr[4], pk[4], pv[4], e[4], a[4];
            unpack4(Q.cr, cr); unpack4(Q.ck, ck); unpack4(Q.cv, cv); unpack4(Q.pr, pr); unpack4(Q.pk, pk); unpack4(Q.pv, pv); unpack4(Q.e, e); unpack4(Q.a, a);
            f32x4 r, w, k, na, bb, v; float ssq = 0.f, bon = 0.f; float kkr[4];
#pragma unroll
            for (int q = 0; q < 4; ++q) { r[q] = cr[q] + (pr[q] - cr[q]) * mur[q]; const float kz = ck[q] + (pk[q] - ck[q]) * muk[q]; v[q] = cv[q] + (pv[q] - cv[q]) * muv[q];
                k[q] = kz * (1.f + (a[q] - 1.f) * kac[q]); kkr[q] = kz * kkc[q]; ssq += kkr[q] * kkr[q]; bon += r[q] * k[q] * rkc[q]; w[q] = __expf(-e[q]); }
            ssq = red16(ssq); bon = red16(bon); const float rn = rsqrtf(ssq + 1e-12f);
#pragma unroll
            for (int q = 0; q < 4; ++q) { const float kk = kkr[q] * rn; na[q] = -kk; bb[q] = kk * a[q]; }
            LAS float* b = bufs + nb * 12288 + tt * 64 + j4;
            *(LAS f32x4*)(b) = r; *(LAS f32x4*)(b + 2048) = w; *(LAS f32x4*)(b + 4096) = k; *(LAS f32x4*)(b + 6144) = na; *(LAS f32x4*)(b + 8192) = bb; *(LAS f32x4*)(b + 10240) = v;
            if ((htid & 15) == 0) BON[nb * 32 + tt] = bon; }
    };
    auto epilogue = [&](int c) {
        const int cb = c & 1, t0 = c * 32, nv = (T - t0) < 32 ? (T - t0) : 32;
        const f32x4 lg = *(const f32x4*)(p.in[I_LXG] + h * 64 + j4), lb = *(const f32x4*)(p.in[I_LXB] + h * 64 + j4);
        u32x2 gq[2];
#pragma unroll
        for (int pp = 0; pp < 2; ++pp) { const int tt = tth + 16 * pp; gq[pp] = (u32x2){0u, 0u}; if (tt < nv) gq[pp] = *(const u32x2*)(Gp + (size_t)(row0 + t0 + tt) * 1024 + ch); }
#pragma unroll
        for (int pp = 0; pp < 2; ++pp) { const int tt = tth + 16 * pp;
            if (tt < nv) { const size_t m = (size_t)(row0 + t0 + tt);
                const f32x4 y = *(const LAS f32x4*)(Yl2 + cb * 2048 + tt * 64 + j4); const f32x4 v = *(const LAS f32x4*)(bufs + cb * 12288 + 10240 + tt * 64 + j4); const float bon = BON[cb * 32 + tt];
                float s = y[0] + y[1] + y[2] + y[3]; s = red16(s); const float mean = s * (1.f / 64.f);
                float d[4], vs = 0.f;
#pragma unroll
                for (int q = 0; q < 4; ++q) { d[q] = y[q] - mean; vs += d[q] * d[q]; }
                vs = red16(vs); const float rstd = rsqrtf(vs * (1.f / 64.f) + 64e-5f);
                float g[4]; unpack4(gq[pp], g); float o[4];
#pragma unroll
                for (int q = 0; q < 4; ++q) o[q] = (d[q] * rstd * lg[q] + lb[q] + bon * v[q]) * g[q];
                u32x2 w; w[0] = pk2(o[0], o[1]); w[1] = pk2(o[2], o[3]); *(u32x2*)(YB + m * 1024 + h * 64 + j4) = w; } }
    };
    ScanPre P[2];
    if (helper) { load_pre(0, P); store_pre(P, 0); }
    __syncthreads();
    const int nch = (T + 31) >> 5;
    for (int c = 0; c < nch; ++c) {
        const int cb = c & 1, t0 = c * 32, nv = (T - t0) < 32 ? (T - t0) : 32;
        if (!helper) { const LAS float* b = bufs + cb * 12288 + jb; const LAS float* vb = bufs + cb * 12288 + 10240 + si; LAS float* Yl = Yl2 + cb * 2048;
          f32x4 R[2], W[2], K[2], A[2], B[2], nR[2], nW[2], nK[2], nA[2], nB[2]; f32x2 v, nvv;
#define SCAN_LOAD(R_, W_, K_, A_, B_, V_, t) { const LAS float* bt = b + (t) * 64; _Pragma("unroll") for (int x = 0; x < 2; ++x) { \
              A_[x] = *(const LAS f32x4*)(bt + 6144 + 4 * x); B_[x] = *(const LAS f32x4*)(bt + 8192 + 4 * x); W_[x] = *(const LAS f32x4*)(bt + 2048 + 4 * x); \
              K_[x] = *(const LAS f32x4*)(bt + 4096 + 4 * x); R_[x] = *(const LAS f32x4*)(bt + 4 * x); } V_ = *(const LAS f32x2*)(vb + (t) * 64); }
#define H2(X, q) ((f32x2){X[(q) >> 1][((q) & 1) * 2], X[(q) >> 1][((q) & 1) * 2 + 1]})
          SCAN_LOAD(R, W, K, A, B, v, 0)
#pragma unroll 4
          for (int t = 0; t < nv; ++t) {
              { const int tn = (t + 1 < 32) ? t + 1 : 31; SCAN_LOAD(nR, nW, nK, nA, nB, nvv, tn) }
              asm volatile("" ::: "memory");
              f32x2 d0 = S0[0] * H2(A, 0), d1 = S1[0] * H2(A, 0);
#pragma unroll
              for (int q = 1; q < 4; ++q) { d0 += S0[q] * H2(A, q); d1 += S1[q] * H2(A, q); }
              const float sa0 = red8(d0[0] + d0[1]), sa1 = red8(d1[0] + d1[1]);
              const f32x2 sa02 = {sa0, sa0}, sa12 = {sa1, sa1}, v02 = {v[0], v[0]}, v12 = {v[1], v[1]};
#pragma unroll
              for (int q = 0; q < 4; ++q) { S0[q] = S0[q] * H2(W, q) + (sa02 * H2(B, q) + v02 * H2(K, q)); S1[q] = S1[q] * H2(W, q) + (sa12 * H2(B, q) + v12 * H2(K, q)); }
              f32x2 y0 = S0[0] * H2(R, 0), y1 = S1[0] * H2(R, 0);
#pragma unroll
              for (int q = 1; q < 4; ++q) { y0 += S0[q] * H2(R, q); y1 += S1[q] * H2(R, q); }
              float yy0 = y0[0] + y0[1], yy1 = y1[0] + y1[1];
              asm("" : "+v"(yy0)); asm("" : "+v"(yy1));
              yy0 = red8(yy0); yy1 = red8(yy1);
              *(LAS f32x2*)(Yl + t * 64 + si) = (f32x2){yy0, yy1};
#pragma unroll
              for (int x = 0; x < 2; ++x) { R[x] = nR[x]; W[x] = nW[x]; K[x] = nK[x]; A[x] = nA[x]; B[x] = nB[x]; }
              v = nvv; }
#undef SCAN_LOAD
#undef H2
        } else {
            if (c + 1 < nch) load_pre(t0 + 32, P);
            if (c > 0) epilogue(c - 1);
            if (c + 1 < nch) store_pre(P, cb ^ 1);
        }
        __syncthreads();
    }
    if (helper) epilogue(nch - 1);
#pragma unroll
    for (int q = 0; q < 4; ++q) if (!helper) { *(f32x2*)(sfin + si * 64 + jb + 2 * q) = S0[q]; *(f32x2*)(sfin + (si + 1) * 64 + jb + 2 * q) = S1[q]; }
}

template <bool DUMMY> __device__ __forceinline__ void attn_prompt_item(const Params& p, LAS unsigned char* lds, int item) {
    const int tid = threadIdx.x, wid = tid >> 6, lane = tid & 63, fr = lane & 15, fq = lane >> 4; unsigned char* ws = p.ws;
    const int b = item >> 6, head = (item >> 4) & 3, qt = item & 15;
    bf16_t* Qp = (bf16_t*)(ws + WS_Y3) + (size_t)2 * MT * 1024; const bf16_t* MKB = (const bf16_t*)(ws + WS_MKB); const bf16_t* MVT = (const bf16_t*)(ws + WS_MVT);
    const int qrow = b * 2048 + qt * 128 + wid * 16;
    bf16x8 qf[8];
#pragma unroll
    for (int ks = 0; ks < 8; ++ks) qf[ks] = *(const bf16x8*)(Qp + (size_t)(qrow + fr) * 1024 + head * 256 + ks * 32 + fq * 8);
#pragma unroll 1
    for (int rnd = 0; rnd < 2; ++rnd) { u32x4 kv[8];
#pragma unroll
      for (int it = 0; it < 8; ++it) { const int idx = (rnd * 8 + it) * 512 + tid, row = idx >> 5, c = idx & 31; kv[it] = *(const u32x4*)(MKB + (size_t)(b * 256 + row) * 1024 + head * 256 + c * 8); }
#pragma unroll
      for (int it = 0; it < 8; ++it) { const int idx = (rnd * 8 + it) * 512 + tid, row = idx >> 5, c = idx & 31; *(LAS u32x4*)(lds + (row * 32 + (c ^ (row & 15))) * 16) = kv[it]; } }
    __syncthreads();
    u32x4 pf[8];
    { f32x4 s[16];
      int koff[8];
#pragma unroll
      for (int ks = 0; ks < 8; ++ks) koff[ks] = (fr * 32 + ((ks * 4 + fq) ^ fr)) * 16;
#pragma unroll
      for (int nt = 0; nt < 16; ++nt) { f32x4 acc = {0.f, 0.f, 0.f, 0.f};
#pragma unroll
          for (int ks = 0; ks < 8; ++ks) { const bf16x8 kf = *(const LAS bf16x8*)(lds + nt * 8192 + koff[ks]); acc = mfma16(kf, qf[ks], acc); }
          s[nt] = acc; }
      float mx = -3.0e38f;
#pragma unroll
      for (int nt = 0; nt < 16; ++nt) mx = fmaxf(fmaxf(fmaxf(s[nt][0], s[nt][1]), fmaxf(s[nt][2], s[nt][3])), mx);
      mx = fmaxf(mx, __shfl_xor(mx, 16)); mx = fmaxf(mx, __shfl_xor(mx, 32));
      float sum = 0.f;
#pragma unroll
      for (int nt = 0; nt < 16; ++nt)
#pragma unroll
          for (int q = 0; q < 4; ++q) { const float e = __expf((s[nt][q] - mx) * 0.0625f); s[nt][q] = e; sum += e; }
      sum += __shfl_xor(sum, 16); sum += __shfl_xor(sum, 32); const float inv = rcpf(sum);
#pragma unroll
      for (int ks = 0; ks < 8; ++ks) { pf[ks][0] = pk2(s[2 * ks][0] * inv, s[2 * ks][1] * inv); pf[ks][1] = pk2(s[2 * ks][2] * inv, s[2 * ks][3] * inv);
          pf[ks][2] = pk2(s[2 * ks + 1][0] * inv, s[2 * ks + 1][1] * inv); pf[ks][3] = pk2(s[2 * ks + 1][2] * inv, s[2 * ks + 1][3] * inv); } }
    __syncthreads();
#pragma unroll 1
    for (int rnd = 0; rnd < 2; ++rnd) { u32x4 kv[8];
#pragma unroll
      for (int it = 0; it < 8; ++it) { const int idx = (rnd * 8 + it) * 512 + tid, row = idx >> 5, c = idx & 31; kv[it] = *(const u32x4*)(MVT + ((size_t)((b * 4 + head) * 256 + row)) * 256 + c * 8); }
#pragma unroll
      for (int it = 0; it < 8; ++it) { const int idx = (rnd * 8 + it) * 512 + tid, row = idx >> 5, c = idx & 31; *(LAS u32x4*)(lds + (row * 32 + (c ^ (row & 15))) * 16) = kv[it]; } }
    __syncthreads();
    { int voff[8][2];
#pragma unroll
      for (int ks = 0; ks < 8; ++ks) { const int c1 = ks * 4 + (fq >> 1); voff[ks][0] = (fr * 32 + (c1 ^ fr)) * 16 + (fq & 1) * 8; voff[ks][1] = (fr * 32 + ((c1 + 2) ^ fr)) * 16 + (fq & 1) * 8; }
#pragma unroll 2
      for (int dt = 0; dt < 16; ++dt) { f32x4 acc = {0.f, 0.f, 0.f, 0.f};
#pragma unroll
          for (int ks = 0; ks < 8; ++ks) { const u32x2 lo = *(const LAS u32x2*)(lds + dt * 8192 + voff[ks][0]), hi = *(const LAS u32x2*)(lds + dt * 8192 + voff[ks][1]);
              u32x4 vv; vv[0] = lo[0]; vv[1] = lo[1]; vv[2] = hi[0]; vv[3] = hi[1]; acc = mfma16(__builtin_bit_cast(bf16x8, vv), __builtin_bit_cast(bf16x8, pf[ks]), acc); }
          u32x2 w; w[0] = pk2(acc[0], acc[1]); w[1] = pk2(acc[2], acc[3]);
          bf16_t* o = Qp + (size_t)(qrow + fr) * 1024 + head * 256 + dt * 16 + 4 * fq;
          if (!DUMMY) *(u32x2*)o = w; else if (w[0] == 0x12345678u) Qp[0] = 0; } }
    __syncthreads();
}

template <bool DUMMY> __device__ __forceinline__ void attn_sample_item(const Params& p, LAS unsigned char* lds, int item) {
    const int tid = threadIdx.x, wid = tid >> 6, lane = tid & 63, l16 = lane & 15, rg = lane >> 4; unsigned char* ws = p.ws;
    const int b = item >> 2, head = item & 3;
    bf16_t* Qp = (bf16_t*)(ws + WS_Y3) + (size_t)2 * MT * 1024 + (size_t)(MP + 4 * b) * 1024 + head * 256;
    const float* Kp = p.in[I_CK] + ((size_t)b * 256 * 4 + head) * 256; const float* Vp = p.in[I_CV] + ((size_t)b * 256 * 4 + head) * 256;
    LAS float* sc = (LAS float*)lds; LAS float* pr = (LAS float*)(lds + 4096); LAS float* part = (LAS float*)(lds + 8192);
    float qv[4][4][4];
#pragma unroll
    for (int t = 0; t < 4; ++t)
#pragma unroll
        for (int c = 0; c < 4; ++c) { const u32x2 q = *(const u32x2*)(Qp + t * 1024 + 64 * c + 4 * l16); unpack4(q, qv[t][c]); }
#pragma unroll 2
    for (int it = 0; it < 8; ++it) { const int mrow = wid * 32 + it * 4 + rg; const float* kr = Kp + (size_t)mrow * 1024 + 4 * l16; float d[4] = {0.f, 0.f, 0.f, 0.f};
#pragma unroll
        for (int c = 0; c < 4; ++c) { const f32x4 kv = *(const f32x4*)(kr + 64 * c);
#pragma unroll
            for (int t = 0; t < 4; ++t) d[t] += kv[0] * qv[t][c][0] + kv[1] * qv[t][c][1] + kv[2] * qv[t][c][2] + kv[3] * qv[t][c][3]; }
#pragma unroll
        for (int t = 0; t < 4; ++t) { const float r = red16(d[t]); if (l16 == 0) sc[t * 256 + mrow] = r * 0.0625f; } }
    __syncthreads();
    if (wid < 4) { const f32x4 x = *(const LAS f32x4*)(sc + wid * 256 + lane * 4); float mx = fmaxf(fmaxf(x[0], x[1]), fmaxf(x[2], x[3])); mx = wave_max(mx);
        float e[4], sum = 0.f;
#pragma unroll
        for (int q = 0; q < 4; ++q) { e[q] = __expf(x[q] - mx); sum += e[q]; }
        sum = wave_sum(sum); const float inv = rcpf(sum);
#pragma unroll
        for (int q = 0; q < 4; ++q) pr[(lane * 4 + q) * 4 + wid] = e[q] * inv; }
    __syncthreads();
    { f32x4 acc[4];
#pragma unroll
      for (int t = 0; t < 4; ++t) acc[t] = (f32x4){0.f, 0.f, 0.f, 0.f};
#pragma unroll 8
      for (int it = 0; it < 32; ++it) { const int mrow = wid * 32 + it; const f32x4 vv = *(const f32x4*)(Vp + (size_t)mrow * 1024 + lane * 4); const f32x4 pp = *(const LAS f32x4*)(pr + mrow * 4);
#pragma unroll
          for (int t = 0; t < 4; ++t) acc[t] += pp[t] * vv; }
#pragma unroll
      for (int t = 0; t < 4; ++t) *(LAS f32x4*)(part + (wid * 4 + t) * 256 + lane * 4) = acc[t]; }
    __syncthreads();
    { const int o = tid * 2, t = o >> 8, d = o & 255; float a0 = 0.f, a1 = 0.f;
#pragma unroll
      for (int w = 0; w < 8; ++w) { const f32x2 v = *(const LAS f32x2*)(part + (w * 4 + t) * 256 + d); a0 += v[0]; a1 += v[1]; }
      const unsigned wv = pk2(a0, a1); if (!DUMMY) *(unsigned*)(Qp + t * 1024 + d) = wv; else if (wv == 0x12345678u) Qp[0] = 0; }
    __syncthreads();
}

template <bool DUMMY> __device__ __forceinline__ void sg_prompt_item(const Params& p, LAS unsigned char* lds, int item) {
    const int tid = threadIdx.x, wid = tid >> 6, lane = tid & 63, fr = lane & 15, fq = lane >> 4; unsigned char* ws = p.ws;
    const int chn = item >> 3, g = item & 7, m0 = chn * 128;
    const bf16_t* VN = (const bf16_t*)(ws + WS_GV); const bf16_t* SGW = (const bf16_t*)(ws + WS_SGW) + g * 16384; bf16_t* U = (bf16_t*)(ws + WS_Y3);
    LAS bf16_t* VT = (LAS bf16_t*)lds;
    { const int s = tid >> 2, hq = (tid & 3) * 32; const bf16_t* src = VN + (size_t)(m0 + s) * 1024 + g * 128 + hq;
#pragma unroll
      for (int c = 0; c < 4; ++c) { const u32x4 q = *(const u32x4*)(src + c * 8);
#pragma unroll
          for (int k = 0; k < 4; ++k) { VT[(hq + c * 8 + 2 * k) * 136 + s] = (bf16_t)(q[k] & 0xffffu); VT[(hq + c * 8 + 2 * k + 1) * 136 + s] = (bf16_t)(q[k] >> 16); } } }
    const int h0 = wid * 16; bf16x8 xf[4];
    const float* sgb = p.in[I_SGB] + g * 128;
    bf16x8 yf[8][4]; u32x2 uq[8]; float bias[8];
#pragma unroll
    for (int mt = 0; mt < 8; ++mt) {
#pragma unroll
        for (int ks = 0; ks < 4; ++ks) if (32 * ks <= 16 * mt + 15) yf[mt][ks] = *(const bf16x8*)(SGW + (mt * 16 + fr) * 128 + ks * 32 + fq * 8);
        uq[mt] = *(const u32x2*)(U + (size_t)(m0 + mt * 16 + fr) * 1024 + g * 128 + h0 + 4 * fq); bias[mt] = sgb[mt * 16 + fr]; }
    __syncthreads();
#pragma unroll
    for (int ks = 0; ks < 4; ++ks) xf[ks] = *(const LAS bf16x8*)(VT + (h0 + fr) * 136 + ks * 32 + fq * 8);
#pragma unroll
    for (int mt = 0; mt < 8; ++mt) { f32x4 acc = {0.f, 0.f, 0.f, 0.f};
#pragma unroll
        for (int ks = 0; ks < 4; ++ks) if (32 * ks <= 16 * mt + 15) acc = mfma16(xf[ks], yf[mt][ks], acc);
        bf16_t* up = U + (size_t)(m0 + mt * 16 + fr) * 1024 + g * 128 + h0 + 4 * fq; float uf[4]; unpack4(uq[mt], uf);
        u32x2 w; w[0] = pk2(uf[0] * (acc[0] + bias[mt]), uf[1] * (acc[1] + bias[mt])); w[1] = pk2(uf[2] * (acc[2] + bias[mt]), uf[3] * (acc[3] + bias[mt])); if (!DUMMY) *(u32x2*)up = w; else if (w[0] == 0x12345678u) up[0] = 0; }
    __syncthreads();
}
__device__ __forceinline__ void sg_sample_item(const Params& p, int item) {
    const int tid = threadIdx.x; unsigned char* ws = p.ws; const bf16_t* VN = (const bf16_t*)(ws + WS_GV); bf16_t* U = (bf16_t*)(ws + WS_Y3);
    const float* sgw = p.in[I_SGW]; const float* sgb = p.in[I_SGB];
    for (int e = tid; e < 32 * 128; e += 512) { const int r = e >> 7, c8 = (e & 127) * 8; const int m = MP + item * 32 + r, t = r & 3, g = c8 >> 7; float a[8];
#pragma unroll
        for (int k = 0; k < 8; ++k) a[k] = sgb[g * 128 + t];
        for (int s = 0; s <= t; ++s) { const float w = sgw[(g * 128 + t) * 128 + s]; const u32x4 q = *(const u32x4*)(VN + (size_t)(m - t + s) * 1024 + c8);
#pragma unroll
            for (int k = 0; k < 4; ++k) { a[2 * k] += w * bflo(q[k]); a[2 * k + 1] += w * bfhi(q[k]); } }
        bf16_t* up = U + (size_t)m * 1024 + c8; const u32x4 uq = *(const u32x4*)up; u32x4 o;
#pragma unroll
        for (int k = 0; k < 4; ++k) o[k] = pk2(bflo(uq[k]) * a[2 * k], bfhi(uq[k]) * a[2 * k + 1]);
        *(u32x4*)up = o; }
}

constexpr int Q_SATT = 0, Q_PATT = 512, Q_SGP = 1024, Q_SGS = 2048, Q_SSCAN = 2064, Q_END = 2064 + 2048;

template <int PH, bool DUMMY = false> __device__ __forceinline__ void run_phase(const Params& p, LAS unsigned char* lds) {
    unsigned char* ws = p.ws; const int G = gridDim.x, bid = blockIdx.x;
    if constexpr (PH == 0) phase0(p, lds);
    else if constexpr (PH == 1) {
        { pg8::Gemm g{(const bf16_t*)(ws + WS_HMB), (const bf16_t*)(ws + WS_WTMKV), 2048, 2048, 1024}; pg8::StaticOrder S; S.init(2048, 2048, G, (bid + 64) % G);
          EpiMem E{p.out, (bf16_t*)(ws + WS_MKB), (bf16_t*)(ws + WS_MVT)}; pg8::gemm_phase<EpiMem, pg8::StaticOrder, false>(lds, g, S, E, nullptr); }
        __syncthreads();
        { pg8::Gemm g{(const bf16_t*)(ws + WS_HB), (const bf16_t*)(ws + WS_WTIN), MT, PIN, 1024}; pg8::StaticOrder S; S.init(MT, PIN, G, bid);
          EpiZ E{(bf16_t*)(ws + WS_Y3), (bf16_t*)(ws + WS_GV), (bf16_t*)(ws + WS_SZ), (bf16_t*)(ws + WS_Y3) + (size_t)2 * MT * 1024, (bf16_t*)(ws + WS_GT), p.out};
          pg8::gemm_phase<EpiZ, pg8::StaticOrder, false>(lds, g, S, E, nullptr); }
    }
    else if constexpr (PH == 2) { const int wid = threadIdx.x >> 6, lane = threadIdx.x & 63; for (int m = wid * G + bid; m < MT; m += 24 * G) { const int mr[3] = {m, m + 8 * G, m + 16 * G}; p2_rows<3, DUMMY>(p, mr, lane); } }
    else if constexpr (PH == 11) { int kk = 256; asm volatile("" : "+s"(kk));
        pg8::Gemm g{(const bf16_t*)(ws + WS_XL), (const bf16_t*)(ws + WS_WTLORA), MP, 3072, kk}; pg8::StaticOrder S; S.init(MP, 3072, G, bid);
        EpiLora E{(bf16_t*)(ws + WS_E), (bf16_t*)(ws + WS_AV), (bf16_t*)(ws + WS_GG), p.in[I_W0], p.in[I_A0]}; pg8::gemm_phase<EpiLora, pg8::StaticOrder, false>(lds, g, S, E, nullptr);
        bf16_t* Eb = (bf16_t*)(ws + WS_E); const float* w0 = p.in[I_W0]; const float* a0 = p.in[I_A0];
        thin_gemm<1>(lds, (const bf16_t*)(ws + WS_XL), 0, (const bf16_t*)(ws + WS_WTLORA), 0, 1, 3072, kk,
            [&](int, const f32x4 (&acc)[4], f32x4 (&tot)[4], int, int) {
#pragma unroll
                for (int j = 0; j < 4; ++j) tot[j] = acc[j]; },
            [&](const f32x4 (&tot)[4], int row, int col) { const int seg = col >> 10;
#pragma unroll
                for (int j = 0; j < 4; ++j) { const int cc = (col & 1023) + 16 * j; f32x4 v = tot[j];
                    if (seg == 0) { const f32x4 bq = *(const f32x4*)(w0 + cc);
#pragma unroll
                        for (int q = 0; q < 4; ++q) v[q] = 0.60653066f * sigmoidf_(v[q] + bq[q]); }
                    else if (seg == 1) { const f32x4 bq = *(const f32x4*)(a0 + cc);
#pragma unroll
                        for (int q = 0; q < 4; ++q) v[q] = sigmoidf_(v[q] + bq[q]); }
                    u32x2 w; w[0] = pk2(v[0], v[1]); w[1] = pk2(v[2], v[3]); *(u32x2*)(Eb + (size_t)seg * 17301504 + (size_t)row * 1024 + cc) = w; } }); }
    else if constexpr (PH == 3 || PH == 10) {
#ifndef P3SPLIT
#define P3SPLIT 0
#endif
#ifndef P3SUB
#define P3SUB 31
#endif
        constexpr int SUB = DUMMY ? P3SUB : 31;
        constexpr bool DO_SCAN = (PH == 3), DO_REST = P3SPLIT ? (PH == 10) : (PH == 3);
        if (DO_SCAN && !DUMMY && bid >= 128) {
#pragma unroll 1
            for (int it = 2368 + (bid - 128); it < 5440; it += G - 128) tr_late(p, lds, it); }
        if (DO_SCAN && (SUB & 1) && bid < 128) { const int b = bid >> 4, h = bid & 15; scan_head(p, lds, b * 2048, 2048, h, nullptr, p.out + O_PWKV + (size_t)bid * 4096, nullptr); }
        unsigned* ctr = (unsigned*)(ws + WS_CTL) + (PH == 10 ? 1 : 0) + (DUMMY ? 2 : 0); LAS unsigned* qw = (LAS unsigned*)(lds + QW_OFF);
        const int q_lo = DO_REST ? 0 : Q_SSCAN, q_hi = DO_SCAN ? Q_END : Q_SSCAN;
        unsigned nxt = 0; if (threadIdx.x == 0) nxt = atomicAdd(ctr, 1u);
        for (;;) {
            __syncthreads();
            if (threadIdx.x == 0) { *qw = nxt; nxt = atomicAdd(ctr, 1u); }
            __syncthreads();
            const int it = (int)*qw + q_lo; if (it >= q_hi) break;
            if (it < Q_PATT) { if (SUB & 2) attn_sample_item<DUMMY>(p, lds, it); }
            else if (it < Q_SGP) { if (SUB & 4) attn_prompt_item<DUMMY>(p, lds, it - Q_PATT); }
            else if (it < Q_SGS) { if (SUB & 8) sg_prompt_item<DUMMY>(p, lds, it - Q_SGP); }
            else if (it < Q_SSCAN) { if (!DUMMY) sg_sample_item(p, it - Q_SGS); }
            else if (SUB & 16) { const int bh = it - Q_SSCAN, b = bh >> 4, h = bh & 15;
                scan_head(p, lds, MP + b * 4, 4, h, p.in[I_SWKV] + (size_t)bh * 4096, p.out + O_SWKV + (size_t)bh * 4096, p.in[I_SSH] + (size_t)b * PSH); }
        }
    }
    else if constexpr (PH == 4) { pg8::Gemm g{(const bf16_t*)(ws + WS_Y3), (const bf16_t*)(ws + WS_WTBR), 3 * MT, 3072, 1024}; BranchOrder S{G, bid};
        EpiMerge E{(const bf16_t*)(ws + WS_GT), (float*)(ws + WS_MF), (bf16_t*)(ws + WS_MB)}; pg8::gemm_phase<EpiMerge, BranchOrder, false>(lds, g, S, E, nullptr);
        const bf16_t* GT = (const bf16_t*)(ws + WS_GT); bf16_t* MB = (bf16_t*)(ws + WS_MB);
        thin_gemm<4>(lds, (const bf16_t*)(ws + WS_Y3), (size_t)MT * 1024, (const bf16_t*)(ws + WS_WTBR), (size_t)1048576, 3, 1024, 1024,
            [&](int n, const f32x4 (&acc)[4], f32x4 (&tot)[4], int row, int col) {
#pragma unroll
                for (int j = 0; j < 4; ++j) { float gf[4]; unpack4(*(const u32x2*)(GT + (size_t)row * 3072 + n * 1024 + col + 16 * j), gf);
                    tot[j][0] += acc[j][0] * gf[0]; tot[j][1] += acc[j][1] * gf[1]; tot[j][2] += acc[j][2] * gf[2]; tot[j][3] += acc[j][3] * gf[3]; } },
            [&](const f32x4 (&tot)[4], int row, int col) {
#pragma unroll
                for (int j = 0; j < 4; ++j) { u32x2 w; w[0] = pk2(tot[j][0], tot[j][1]); w[1] = pk2(tot[j][2], tot[j][3]); *(u32x2*)(MB + (size_t)row * 1024 + col + 16 * j) = w; } }); }
    else if constexpr (PH == 5) { pg8::Gemm g{(const bf16_t*)(ws + WS_MB), (const bf16_t*)(ws + WS_WTOUT), MP, 1024, 1024}; pg8::StaticOrder S; S.init(MP, 1024, G, bid);
        EpiRes E{p.in[I_XP], p.in[I_XS], (float*)(ws + WS_X1), (bf16_t*)(ws + WS_X1B), (float*)(ws + (DUMMY ? WS_XL : WS_SSQ1))}; pg8::gemm_phase<EpiRes, pg8::StaticOrder, false>(lds, g, S, E, nullptr);
        const float* xs = p.in[I_XS]; float* X1 = (float*)(ws + WS_X1); bf16_t* X1B = (bf16_t*)(ws + WS_X1B); float* ssq = (float*)(ws + (DUMMY ? WS_XL : WS_SSQ1));
        thin_gemm<4>(lds, (const bf16_t*)(ws + WS_MB), 0, (const bf16_t*)(ws + WS_WTOUT), 0, 1, 1024, 1024,
            [&](int, const f32x4 (&acc)[4], f32x4 (&tot)[4], int, int) {
#pragma unroll
                for (int j = 0; j < 4; ++j) tot[j] = acc[j]; },
            [&](const f32x4 (&tot)[4], int row, int col) { float ss = 0.f;
#pragma unroll
                for (int j = 0; j < 4; ++j) { const f32x4 v = tot[j] + *(const f32x4*)(xs + (size_t)(row - MP) * 1024 + col + 16 * j); *(f32x4*)(X1 + (size_t)row * 1024 + col + 16 * j) = v;
                    u32x2 w; w[0] = pk2(v[0], v[1]); w[1] = pk2(v[2], v[3]); *(u32x2*)(X1B + (size_t)row * 1024 + col + 16 * j) = w; ss += v[0] * v[0] + v[1] * v[1] + v[2] * v[2] + v[3] * v[3]; }
                ss += __shfl_xor(ss, 16); ss += __shfl_xor(ss, 32); if ((threadIdx.x & 63) < 16) atomicAdd(ssq + row, ss); }); }
    else if constexpr (PH == 6) { pg8::Gemm g{(const bf16_t*)(ws + WS_X1B), (const bf16_t*)(ws + WS_WTUP), MP, DFF, 1024}; pg8::StaticOrder S; S.init(MP, DFF, G, bid);
        EpiUp E{(const float*)(ws + WS_SSQ1), (bf16_t*)(ws + WS_HID)}; pg8::gemm_phase<EpiUp, pg8::StaticOrder, false>(lds, g, S, E, nullptr);
        const float* ssq = (const float*)(ws + WS_SSQ1); bf16_t* H = (bf16_t*)(ws + WS_HID);
        thin_gemm<1>(lds, (const bf16_t*)(ws + WS_X1B), 0, (const bf16_t*)(ws + WS_WTUP), 0, 1, DFF, 1024,
            [&](int, const f32x4 (&acc)[4], f32x4 (&tot)[4], int, int) {
#pragma unroll
                for (int j = 0; j < 4; ++j) tot[j] = acc[j]; },
            [&](const f32x4 (&tot)[4], int row, int col) { const float rs = rsqrtf(ssq[row] * (1.f / 1024.f) + 1e-6f);
#pragma unroll
                for (int j = 0; j < 4; ++j) { float h[4];
#pragma unroll
                    for (int q = 0; q < 4; ++q) { const float a = fmaxf(tot[j][q] * rs, 0.f); h[q] = a * a; }
                    u32x2 w; w[0] = pk2(h[0], h[1]); w[1] = pk2(h[2], h[3]); *(u32x2*)(H + (size_t)row * DFF + col + 16 * j) = w; } }); }
    else if constexpr (PH == 7) { pg8::Gemm g{(const bf16_t*)(ws + WS_HID), (const bf16_t*)(ws + WS_WTDN), MP, 1024, DFF}; pg8::StaticOrder S; S.init(MP, 1024, G, bid);
        const float* x1 = (const float*)(ws + WS_X1);
        EpiRes E{x1, x1 + (size_t)MP * 1024, (float*)(ws + WS_X2), nullptr, (float*)(ws + (DUMMY ? WS_XL : WS_SSQ2))}; pg8::gemm_phase<EpiRes, pg8::StaticOrder, false>(lds, g, S, E, nullptr);
        float* X2 = (float*)(ws + WS_X2); float* ssq = (float*)(ws + (DUMMY ? WS_XL : WS_SSQ2));
        thin_gemm<4>(lds, (const bf16_t*)(ws + WS_HID), 0, (const bf16_t*)(ws + WS_WTDN), 0, 1, 1024, DFF,
            [&](int, const f32x4 (&acc)[4], f32x4 (&tot)[4], int, int) {
#pragma unroll
                for (int j = 0; j < 4; ++j) tot[j] = acc[j]; },
            [&](const f32x4 (&tot)[4], int row, int col) { float ss = 0.f;
#pragma unroll
                for (int j = 0; j < 4; ++j) { const f32x4 v = tot[j] + *(const f32x4*)(x1 + (size_t)row * 1024 + col + 16 * j); *(f32x4*)(X2 + (size_t)row * 1024 + col + 16 * j) = v;
                    ss += v[0] * v[0] + v[1] * v[1] + v[2] * v[2] + v[3] * v[3]; }
                ss += __shfl_xor(ss, 16); ss += __shfl_xor(ss, 32); if ((threadIdx.x & 63) < 16) atomicAdd(ssq + row, ss); }); }
    else if constexpr (PH == 8) { const float* x2 = (const float*)(ws + WS_X2); const float* ssq = (const float*)(ws + WS_SSQ2); const float* gf = p.in[I_NFG];
        const int wid = threadIdx.x >> 6, lane = threadIdx.x & 63;
        f32x4 g[4];
#pragma unroll
        for (int c = 0; c < 4; ++c) g[c] = *(const f32x4*)(gf + c * 256 + lane * 4);
        for (int r0 = wid * G + bid; r0 < MT; r0 += 24 * G) {
            f32x4 v[3][4]; float rs[3];
#pragma unroll
            for (int i = 0; i < 3; ++i) { const int r = r0 + i * 8 * G; if (r < MT) { rs[i] = ssq[r];
#pragma unroll
                for (int c = 0; c < 4; ++c) v[i][c] = *(const f32x4*)(x2 + (size_t)r * 1024 + c * 256 + lane * 4); } }
#pragma unroll
            for (int i = 0; i < 3; ++i) { const int r = r0 + i * 8 * G; if (r < MT) { const float s = rsqrtf(rs[i] * (1.f / 1024.f) + 1e-6f);
#pragma unroll
                for (int c = 0; c < 4; ++c) *(f32x4*)(p.out + (size_t)r * 1024 + c * 256 + lane * 4) = v[i][c] * s * g[c]; } } } }
}
#ifdef DIAG_PHASES
template <int PH> __global__ __launch_bounds__(512, 2) void diag_phase(Params p) {
    extern __shared__ __attribute__((aligned(16))) unsigned char shm[];
    run_phase<PH>(p, (LAS unsigned char*)shm);
}
template __global__ void diag_phase<0>(Params); template __global__ void diag_phase<1>(Params); template __global__ void diag_phase<2>(Params);
template __global__ void diag_phase<3>(Params); template __global__ void diag_phase<4>(Params); template __global__ void diag_phase<5>(Params);
template __global__ void diag_phase<6>(Params); template __global__ void diag_phase<7>(Params); template __global__ void diag_phase<8>(Params);
#endif
template <int PH, bool DUMMY = false> __device__ __forceinline__ void phase_step(int ph_lo, int ph_hi, LAS unsigned char* lds, cg::grid_group& grid, unsigned& nbar) {
    constexpr int PE = (PH == 10) ? 3 : (PH == 11 ? 2 : PH);
    if (ph_lo <= PE && PE < ph_hi) {
        if (PH > ph_lo) {
            asm volatile("s_waitcnt vmcnt(0)" ::: "memory");
            __syncthreads();
            ++nbar;
            if (threadIdx.x == 0) {
                const __attribute__((address_space(4))) Params* pq = (const __attribute__((address_space(4))) Params*)__builtin_amdgcn_kernarg_segment_ptr();
                __attribute__((address_space(1))) unsigned char* wsb = (__attribute__((address_space(1))) unsigned char*)pq->ws;
                if (nbar == 1) {
                    __attribute__((address_space(1))) unsigned* bar = (__attribute__((address_space(1))) unsigned*)(wsb + WS_CTL + 128);
                    __builtin_amdgcn_fence(__ATOMIC_RELEASE, "agent"); asm volatile("s_waitcnt vmcnt(0)" ::: "memory");
                    __hip_atomic_fetch_add(bar, 1u, __ATOMIC_RELAXED, __HIP_MEMORY_SCOPE_AGENT);
                    while (__hip_atomic_load(bar, __ATOMIC_RELAXED, __HIP_MEMORY_SCOPE_AGENT) < gridDim.x) __builtin_amdgcn_s_sleep(2);
                    __builtin_amdgcn_fence(__ATOMIC_ACQUIRE, "agent"); asm volatile("s_waitcnt vmcnt(0)" ::: "memory");
                } else {
                    __attribute__((address_space(1))) unsigned* c2 = (__attribute__((address_space(1))) unsigned*)(wsb + WS_CTL2);
                    const unsigned xcc = (unsigned)__builtin_amdgcn_s_getreg((3 << 11) | 20) & 0xFu;
                    const unsigned nx = __hip_atomic_load(c2 + 1024 + xcc, __ATOMIC_RELAXED, __HIP_MEMORY_SCOPE_AGENT);
                    unsigned nxcc = 0;
                    for (int j = 0; j < 16; ++j) nxcc += __hip_atomic_load(c2 + 1024 + j, __ATOMIC_RELAXED, __HIP_MEMORY_SCOPE_AGENT) != 0u;
                    const unsigned k = nbar - 1;
                    const unsigned old = __hip_atomic_fetch_add(c2 + 64 * xcc, 1u, __ATOMIC_RELAXED, __HIP_MEMORY_SCOPE_AGENT);
                    if (old + 1 == k * nx) {
                        __builtin_amdgcn_fence(__ATOMIC_RELEASE, "agent"); asm volatile("s_waitcnt vmcnt(0)" ::: "memory");
                        const unsigned t = __hip_atomic_fetch_add(c2 + 1088, 1u, __ATOMIC_RELAXED, __HIP_MEMORY_SCOPE_AGENT);
                        if (t + 1 == k * nxcc) __hip_atomic_store(c2 + 1152, k, __ATOMIC_RELAXED, __HIP_MEMORY_SCOPE_AGENT);
                    }
                    while (__hip_atomic_load(c2 + 1152, __ATOMIC_RELAXED, __HIP_MEMORY_SCOPE_AGENT) < k) __builtin_amdgcn_s_sleep(1);
                    __builtin_amdgcn_fence(__ATOMIC_ACQUIRE, "agent"); asm volatile("s_waitcnt vmcnt(0)" ::: "memory");
                }
            }
            __syncthreads();
        }
        const __attribute__((address_space(4))) Params* pp = (const __attribute__((address_space(4))) Params*)__builtin_amdgcn_kernarg_segment_ptr();
        asm volatile("" : "+s"(pp) :: "memory");
        Params p;
#pragma unroll
        for (int i = 0; i < 33; ++i) p.in[i] = (const float*)(__attribute__((address_space(1))) const float*)pp->in[i];
        p.out = (float*)(__attribute__((address_space(1))) float*)pp->out; p.ws = (unsigned char*)(__attribute__((address_space(1))) unsigned char*)pp->ws;
        run_phase<PH, DUMMY>(p, lds);
    }
}
template <> __device__ __forceinline__ void run_phase<9, false>(const Params& p, LAS unsigned char* lds) {
    unsigned char* ws = p.ws; const int G = gridDim.x, bid = blockIdx.x; const int wid = threadIdx.x >> 6, lane = threadIdx.x & 63;
    for (int r = bid * 8 + wid; r < MT; r += G * 8) {
#pragma unroll
        for (int c = 0; c < 4; ++c) { const int col = c * 256 + lane * 4; f32x4 o;
#if DBG == 1
            const bf16_t* y3 = (const bf16_t*)(ws + WS_Y3); float a[4], b[4], d[4];
            unpack4(*(const u32x2*)(y3 + (size_t)r * 1024 + col), a); unpack4(*(const u32x2*)(y3 + (size_t)(MT + r) * 1024 + col), b); unpack4(*(const u32x2*)(y3 + (size_t)(2 * MT + r) * 1024 + col), d);
            for (int q = 0; q < 4; ++q) o[q] = a[q] + 2.f * b[q] + 4.f * d[q];
#elif DBG == 2
            float a[4]; unpack4(*(const u32x2*)((const bf16_t*)(ws + WS_MB) + (size_t)r * 1024 + col), a); for (int q = 0; q < 4; ++q) o[q] = a[q];
#elif DBG == 3
            o = *(const f32x4*)((const float*)(ws + WS_X1) + (size_t)r * 1024 + col);
#elif DBG == 4
            float a[4], b[4]; unpack4(*(const u32x2*)((const bf16_t*)(ws + WS_HID) + (size_t)r * DFF + col), a); unpack4(*(const u32x2*)((const bf16_t*)(ws + WS_HID) + (size_t)r * DFF + 2048 + col), b); for (int q = 0; q < 4; ++q) o[q] = a[q] + b[q];
#elif DBG == 5
            const bf16_t* y3 = (const bf16_t*)(ws + WS_Y3) + (size_t)(DBGSEL * MT + r) * 1024 + col; float a[4]; unpack4(*(const u32x2*)y3, a); for (int q = 0; q < 4; ++q) o[q] = a[q];
#else
            o = (f32x4){0.f, 0.f, 0.f, 0.f};
#endif
            *(f32x4*)(p.out + (size_t)r * 1024 + col) = o; } }
}
__global__ __launch_bounds__(512, 2) void mega(Params p, int ph_lo, int ph_hi) {
    extern __shared__ __attribute__((aligned(16))) unsigned char shm[];
    LAS unsigned char* lds = (LAS unsigned char*)shm;
    cg::grid_group grid = cg::this_grid();
#ifndef DUP
#define DUP -1
#endif
    unsigned nbar = 0;
    { const __attribute__((address_space(4))) Params* pq = (const __attribute__((address_space(4))) Params*)__builtin_amdgcn_kernarg_segment_ptr();
      __attribute__((address_space(1))) unsigned char* wsb = (__attribute__((address_space(1))) unsigned char*)pq->ws;
      if (ph_lo < 0) grid.sync();
      if (threadIdx.x == 0) { const unsigned xcc = (unsigned)__builtin_amdgcn_s_getreg((3 << 11) | 20) & 0xFu;
          __hip_atomic_fetch_add((__attribute__((address_space(1))) unsigned*)(wsb + WS_CTL2) + 1024 + xcc, 1u, __ATOMIC_RELAXED, __HIP_MEMORY_SCOPE_AGENT); } }
#define PSTEP(k) if (DUP == k) phase_step<k, true>(ph_lo, ph_hi, lds, grid, nbar); phase_step<k, false>(ph_lo, ph_hi, lds, grid, nbar);
    PSTEP(0) PSTEP(1) PSTEP(2) PSTEP(11) PSTEP(3)
#if P3SPLIT
    PSTEP(10)
#endif
    PSTEP(4) PSTEP(5) PSTEP(6) PSTEP(7) PSTEP(8)
#if DBG
    phase_step<9>(ph_lo, 10, lds, grid, nbar);
#endif
}

extern "C" void kernel_launch(void* const* d_in, const int* in_sizes, int n_in, void* d_out, int out_size, void* d_ws, size_t ws_size, hipStream_t stream) {
    static int grid_blocks = 0;
    if (grid_blocks == 0) {
        if (n_in != 33 || out_size != (int)O_END || ws_size < WS_END) { fprintf(stderr, "kernel_launch: unexpected shapes (n_in %d out %d ws %zu, need ws %zu)\n", n_in, out_size, ws_size, (size_t)WS_END); grid_blocks = -1; return; }
        int dev = 0, cus = 0, per_cu = 0;
        hipGetDevice(&dev); hipDeviceGetAttribute(&cus, hipDeviceAttributeMultiprocessorCount, dev);
        hipFuncSetAttribute((const void*)mega, hipFuncAttributeMaxDynamicSharedMemorySize, LDS_BYTES);
        hipOccupancyMaxActiveBlocksPerMultiprocessor(&per_cu, (const void*)mega, 512, LDS_BYTES);
        if (per_cu < 1) { fprintf(stderr, "kernel_launch: occupancy query says %d blocks per CU\n", per_cu); grid_blocks = -1; return; }
        grid_blocks = cus * 1;
        if (grid_blocks < 128) { fprintf(stderr, "kernel_launch: needs >= 128 CUs\n"); grid_blocks = -1; return; }
    }
    if (grid_blocks < 0) return;
    hipMemsetAsync((char*)d_ws + WS_CTL, 0, WS_WTIN - WS_CTL, stream);
    Params p{};
    for (int i = 0; i < 33; ++i) p.in[i] = (const float*)d_in[i];
    p.out = (float*)d_out; p.ws = (unsigned char*)d_ws;
#if DBG
    int lo = 0, hi = DBG_HI;
#else
    int lo = 0, hi = 9;
#endif
    void* args[] = {&p, &lo, &hi};
    hipError_t e = hipLaunchCooperativeKernel((const void*)mega, dim3(grid_blocks), dim3(512), args, LDS_BYTES, stream);
    if (e != hipSuccess) fprintf(stderr, "cooperative launch failed: %s (grid %d)\n", hipGetErrorString(e), grid_blocks);
}
```

```cpp
#include <hip/hip_runtime.h>
#include <hip/hip_cooperative_groups.h>
#include <cstdio>
namespace cg = cooperative_groups;
namespace pg8 {
#define PG8_LAS __attribute__((address_space(3)))
typedef unsigned short bf16_t;
typedef short bf16x8 __attribute__((ext_vector_type(8)));
typedef float f32x4 __attribute__((ext_vector_type(4)));
typedef unsigned u32x4 __attribute__((ext_vector_type(4)));
constexpr int BM = 256, BK = 64, HALF = 128, HTB = HALF * BK * 2  , STAGE_BYTES = 8 * HTB, NXCD = 8, WGM = 8;

__host__ __device__ __forceinline__ int lds_byte(int r, int c) { const int st = (r >> 4) * 2 + (c >> 5), rr = r & 15, cc = c & 31, ob = rr * 64 + cc * 2; return st * 1024 + (ob ^ (((ob >> 9) & 1) << 5)); }
__host__ __device__ __forceinline__ void stage_rc(int b, int& R, int& C) { const int st = b / 1024, sb = b % 1024, swz = sb ^ (((sb >> 9) & 1) << 5); R = (st >> 1) * 16 + swz / 64; C = (st & 1) * 32 + (swz % 64) / 2; }
__host__ __device__ __forceinline__ int perm32(int rho) { const int n = rho >> 4, i = rho & 15; return 8 * (i >> 2) + 4 * n + (i & 3); }

struct Unit { int pm, pn; };
struct Gemm { const bf16_t* A; const bf16_t* Bt; int M, N, K; };

struct StaticOrder {
    int nM, nN, nwg, G, c;
    __host__ __device__ void init(int M, int N, int G_, int c_) { nM = M / BM; nN = N / BM; nwg = nM * nN; G = G_; c = c_; }
    __host__ __device__ bool next(int i, Unit& u) const {
        const long L = (long)i * G + c; if (L >= nwg) return false;
        int wgid = (int)L; { const int q = nwg / NXCD, r = nwg % NXCD, xcd = wgid % NXCD, off = wgid / NXCD; wgid = (xcd < r ? xcd * (q + 1) : r * (q + 1) + (xcd - r) * q) + off; }
        const int nig = WGM * nN, gid = wgid / nig, fm = gid * WGM, gsz = (nM - fm) < WGM ? (nM - fm) : WGM;
        u.pm = fm + ((wgid % nig) % gsz); u.pn = (wgid % nig) / gsz; return true;
    }
    __device__ __forceinline__ void a_ready(const Unit&) const {}
    __device__ __forceinline__ void done(const Unit&) const {}
};
__device__ __forceinline__ unsigned cvt_pk_bf16(float lo, float hi) { unsigned r; asm volatile("v_cvt_pk_bf16_f32 %0, %1, %2" : "=v"(r) : "v"(lo), "v"(hi)); return r; }
template <class Epi, class Sched, bool STAMP = false>
__device__ __forceinline__ void gemm_phase(PG8_LAS unsigned char* lds, const Gemm g, const Sched& S, const Epi& E, unsigned long long* stamps) {
    const int tid = threadIdx.x, wid = __builtin_amdgcn_readfirstlane(tid >> 6), lane = tid & 63, wr = wid >> 2, wc = wid & 3, fr = lane & 15, fq = lane >> 4;
    const int K = g.K, nt = K / BK;
    int ts_lo = 0, ts_hi = 0, nts = 0; const unsigned long long rt_entry = STAMP ? (unsigned long long)wall_clock64() : 0ull;
#define PG8_STAMP() do { if (STAMP && wid == 0 && nts < 64) { const unsigned long long _c = (unsigned long long)clock64(); \
        ts_lo = (lane == nts) ? (int)(unsigned)_c : ts_lo; ts_hi = (lane == nts) ? (int)(unsigned)(_c >> 32) : ts_hi; ++nts; } } while (0)
    PG8_STAMP();
    unsigned voffA[2], voffB[2];
#pragma unroll
    for (int i = 0; i < 2; ++i) { int R, C; stage_rc(tid * 16 + i * 8192, R, C); const int Rb = Epi::PERM ? ((R & ~31) + perm32(R & 31)) : R;
        voffA[i] = (unsigned)(R * K + C) * 2u; voffB[i] = (unsigned)(Rb * K + C) * 2u; }
    const size_t kstep = (size_t)(BK * 2);
    const size_t hstep = (size_t)HALF * K * 2;
    const size_t tstep = 2 * hstep;
    const unsigned ldsw = (unsigned)wid * 1024u;
    const int aoff = lds_byte(wr * 64 + fr, fq * 8), boff = lds_byte(wc * 32 + fr, fq * 8);
#define PG8_SA(b, h) (((b) * 2 + (h)) * HTB)
#define PG8_SB(b, h) ((4 + (b) * 2 + (h)) * HTB)
#define PG8_STAGE(bufoff, gbase, voff) do { _Pragma("unroll") for (int _i = 0; _i < 2; ++_i) \
        __builtin_amdgcn_global_load_lds((const unsigned*)((const char*)(gbase) + (voff)[_i]), (PG8_LAS unsigned*)(lds + (bufoff) + ldsw + _i * 8192), 16, 0, 0); } while (0)
#define PG8_LDA(dst, b, h) do { _Pragma("unroll") for (int m = 0; m < 4; ++m) _Pragma("unroll") for (int k = 0; k < 2; ++k) dst[m][k] = *(const PG8_LAS bf16x8*)(lds + PG8_SA(b, h) + aoff + m * 2048 + k * 1024); } while (0)
#define PG8_LDB(dst, b, h) do { _Pragma("unroll") for (int n = 0; n < 2; ++n) _Pragma("unroll") for (int k = 0; k < 2; ++k) dst[n][k] = *(const PG8_LAS bf16x8*)(lds + PG8_SB(b, h) + boff + n * 2048 + k * 1024); } while (0)
#define PG8_MMA(ai, bj, At, Bt) do { __builtin_amdgcn_s_setprio(1); _Pragma("unroll") for (int m = 0; m < 4; ++m) _Pragma("unroll") for (int n = 0; n < 2; ++n) _Pragma("unroll") for (int k = 0; k < 2; ++k) \
        acc[ai][bj][m][n] = __builtin_amdgcn_mfma_f32_16x16x32_bf16(Bt[n][k], At[m][k], acc[ai][bj][m][n], 0, 0, 0); __builtin_amdgcn_s_setprio(0); } while (0)
#define PG8_WAIT_V(n) asm volatile("s_waitcnt vmcnt(" #n ")" ::: "memory")
#define PG8_WAIT_L(n) asm volatile("s_waitcnt lgkmcnt(" #n ")" ::: "memory")
#define PG8_BAR __builtin_amdgcn_s_barrier()
#define PG8_SCHED __builtin_amdgcn_sched_barrier(0)
    Unit cur, nxt; int ui = 0;
    if (!S.next(0, cur)) return;
    f32x4 acc[2][2][4][2];
#pragma unroll
    for (int a = 0; a < 2; ++a)
#pragma unroll
        for (int b = 0; b < 2; ++b)
#pragma unroll
            for (int m = 0; m < 4; ++m)
#pragma unroll
                for (int n = 0; n < 2; ++n) acc[a][b][m][n] = (f32x4){0.f, 0.f, 0.f, 0.f};
    bf16x8 At[4][2], B0[2][2], B1[2][2];
    const char* cA = (const char*)g.A + (size_t)cur.pm * tstep; const char* cB = (const char*)g.Bt + (size_t)cur.pn * tstep;
    S.a_ready(cur);
    PG8_STAGE(PG8_SB(0, 0), cB, voffB); PG8_STAGE(PG8_SA(0, 0), cA, voffA); PG8_STAGE(PG8_SB(0, 1), cB + hstep, voffB); PG8_STAGE(PG8_SA(0, 1), cA + hstep, voffA);
    if (wr == 1) PG8_BAR;
    PG8_WAIT_V(4); PG8_BAR;
    PG8_STAGE(PG8_SB(1, 0), cB + kstep, voffB); PG8_STAGE(PG8_SA(1, 0), cA + kstep, voffA); PG8_STAGE(PG8_SB(1, 1), cB + hstep + kstep, voffB);
    PG8_WAIT_V(6); PG8_BAR;
    PG8_STAMP();
    for (;;) {
        const bool has_next = S.next(ui + 1, nxt);
        const char* nA = has_next ? (const char*)g.A + (size_t)nxt.pm * tstep : cA; const char* nB = has_next ? (const char*)g.Bt + (size_t)nxt.pn * tstep : cB;
        for (int t = 0; t < nt; t += 2) {
            const bool last = (t == nt - 2);
            const char* a1 = cA + (size_t)(t + 1) * kstep;
            const char* a2 = last ? nA : cA + (size_t)(t + 2) * kstep; const char* b2 = last ? nB : cB + (size_t)(t + 2) * kstep;
            const char* a3 = a2 + kstep; const char* b3 = b2 + kstep;
            if (last && has_next) S.a_ready(nxt);
            PG8_LDB(B0, 0, 0); PG8_SCHED; PG8_LDA(At, 0, 0); PG8_STAGE(PG8_SA(1, 1), a1 + hstep, voffA);
            PG8_WAIT_L(8); PG8_BAR; PG8_WAIT_L(0); PG8_MMA(0, 0, At, B0); PG8_BAR; PG8_SCHED;
            PG8_LDB(B1, 0, 1); PG8_STAGE(PG8_SB(0, 0), b2, voffB);
            PG8_BAR; PG8_WAIT_L(0); PG8_MMA(0, 1, At, B1); PG8_BAR;
            PG8_LDA(At, 0, 1); PG8_STAGE(PG8_SA(0, 0), a2, voffA);
            PG8_BAR; PG8_WAIT_L(0); PG8_MMA(1, 0, At, B0); PG8_BAR; PG8_SCHED;
            PG8_STAGE(PG8_SB(0, 1), b2 + hstep, voffB);
            PG8_WAIT_V(6); PG8_BAR; PG8_MMA(1, 1, At, B1); PG8_BAR;
            PG8_LDB(B0, 1, 0); PG8_SCHED; PG8_LDA(At, 1, 0); PG8_STAGE(PG8_SA(0, 1), a2 + hstep, voffA);
            PG8_WAIT_L(8); PG8_BAR; PG8_WAIT_L(0); PG8_MMA(0, 0, At, B0); PG8_BAR; PG8_SCHED;
            PG8_LDB(B1, 1, 1); PG8_STAGE(PG8_SB(1, 0), b3, voffB);
            PG8_BAR; PG8_WAIT_L(0); PG8_MMA(0, 1, At, B1); PG8_BAR;
            PG8_LDA(At, 1, 1); PG8_STAGE(PG8_SA(1, 0), a3, voffA);
            PG8_BAR; PG8_WAIT_L(0); PG8_MMA(1, 0, At, B0); PG8_BAR; PG8_SCHED;
            PG8_STAGE(PG8_SB(1, 1), b3 + hstep, voffB);
            PG8_WAIT_V(6); PG8_BAR; PG8_MMA(1, 1, At, B1); PG8_BAR;
        }
        PG8_STAMP();
        if constexpr (!Epi::AFTER_DRAIN) { E(acc, cur, wr, wc, fr, fq); S.done(cur); }
        PG8_STAMP();
        if (!has_next) break;
#pragma unroll
        for (int a = 0; a < 2; ++a)
#pragma unroll
            for (int b = 0; b < 2; ++b)
#pragma unroll
                for (int m = 0; m < 4; ++m)
#pragma unroll
                    for (int n = 0; n < 2; ++n) acc[a][b][m][n] = (f32x4){0.f, 0.f, 0.f, 0.f};
        cur = nxt; cA = nA; cB = nB; ++ui;
    }
    PG8_WAIT_V(0);
    if (wr == 0) PG8_BAR;
    PG8_BAR;
    if constexpr (Epi::AFTER_DRAIN) { E.fused(acc, cur, wr, wc, fr, fq, lds, wid, lane); S.done(cur); }
    PG8_STAMP();
    if (STAMP && wid == 0) { stamps[lane] = lane < nts ? (((unsigned long long)(unsigned)ts_hi << 32) | (unsigned)ts_lo) : 0ull;
        if (lane == 62) stamps[62] = rt_entry; if (lane == 63) stamps[63] = (unsigned long long)wall_clock64(); }
#undef PG8_STAMP
#undef PG8_SA
#undef PG8_SB
#undef PG8_STAGE
#undef PG8_LDA
#undef PG8_LDB
#undef PG8_MMA
#undef PG8_WAIT_V
#undef PG8_WAIT_L
#undef PG8_BAR
#undef PG8_SCHED
}
}

using pg8::bf16_t; using pg8::bf16x8; using pg8::f32x4; using pg8::u32x4;
typedef unsigned u32x2 __attribute__((ext_vector_type(2)));
typedef float f32x2 __attribute__((ext_vector_type(2)));
#define LAS __attribute__((address_space(3)))
#ifndef DBG
#define DBG 0
#endif
#ifndef DBGSEL
#define DBGSEL 0
#endif

constexpr int MP = 16384, MS = 512, MT = 16896, DM = 1024, PIN = 9472, PSH = 3328, DFF = 4096;
constexpr int NPANEL = MT / 256;
constexpr size_t O_YP = 0, O_YS = 16777216, O_PSH = 17301504, O_PWKV = 17328128, O_PMK = 17852416, O_PMV = 19949568,
                 O_SSH = 22046720, O_SWKV = 22472704, O_SGV = 30861312, O_END = 31385600;
constexpr size_t WS_CTL = 0, WS_CTL2 = 256, WS_SSQ1 = 256 + 8192, WS_SSQ2 = WS_SSQ1 + 67584, WS_WTIN = WS_SSQ2 + 67584,
    WS_WTBR = WS_WTIN + 19398656, WS_WTOUT = WS_WTBR + 6291456, WS_WTUP = WS_WTOUT + 2097152, WS_WTDN = WS_WTUP + 8388608,
    WS_WTMKV = WS_WTDN + 8388608, WS_WTW2 = WS_WTMKV + 4194304, WS_WTA2 = WS_WTW2 + 131072, WS_WTG2 = WS_WTA2 + 131072,
    WS_SGW = WS_WTG2 + 262144, WS_HMB = WS_SGW + 262144, WS_MKB = WS_HMB + 4194304, WS_MVT = WS_MKB + 4194304,
    WS_Y3 = WS_MVT + 4194304, WS_GV = WS_Y3 + 103809024, WS_SZ = WS_GV + 34603008, WS_GT = WS_SZ + 112459776,
    WS_HB = WS_GT + 103809024, WS_AV = WS_HB + 34603008, WS_GG = WS_AV + 34603008, WS_XL = WS_GG + 34603008, WS_WTLORA = WS_XL + 8650752, WS_END = WS_WTLORA + 1572864;
constexpr size_t WS_MF = WS_SZ, WS_MB = WS_GV, WS_X1 = WS_GT, WS_X1B = WS_HB, WS_HID = WS_Y3, WS_X2 = WS_SZ, WS_E = WS_HB;
constexpr int LDS_BYTES = 131072 + 256;
constexpr int QW_OFF = 131072;

struct Params { const float* in[33]; float* out; unsigned char* ws; };

enum { I_XP = 0, I_XS, I_MEM, I_CK, I_CV, I_SSH, I_SWKV, I_N1G, I_WIN, I_MU, I_LNG, I_LNB, I_SGW, I_SGB, I_W0, I_WW2, I_A0, I_WA2,
       I_WG2, I_KK, I_KA, I_RK, I_LXG, I_LXB, I_MNG, I_WMK, I_WMV, I_WBR, I_WOUT, I_N2G, I_WUP, I_WDN, I_NFG };

__device__ __forceinline__ float bflo(unsigned u) { return __uint_as_float(u << 16); }
__device__ __forceinline__ float bfhi(unsigned u) { return __uint_as_float(u & 0xffff0000u); }
typedef __bf16 bf2_t __attribute__((ext_vector_type(2)));
__device__ __forceinline__ unsigned pk2(float lo, float hi) { const f32x2 v = {lo, hi}; const bf2_t b = __builtin_convertvector(v, bf2_t); return __builtin_bit_cast(unsigned, b); }
__device__ __forceinline__ float rcpf(float x) { return __builtin_amdgcn_rcpf(x); }
__device__ __forceinline__ float sigmoidf_(float x) { return rcpf(1.f + __expf(-x)); }
__device__ __forceinline__ float gelu_tanh(float x) { const float t = 1.5957691216f * (x + 0.044715f * x * x * x); return x * sigmoidf_(t); }
__device__ __forceinline__ float tanhf_(float x) { return 1.f - 2.f * rcpf(__expf(2.f * x) + 1.f); }
template <int CTRL> __device__ __forceinline__ float dpp_mov(float x) { return __int_as_float(__builtin_amdgcn_update_dpp(0, __float_as_int(x), CTRL, 0xF, 0xF, true)); }
__device__ __forceinline__ float red8(float x) { x += dpp_mov<0xB1>(x); x += dpp_mov<0x4E>(x); x += dpp_mov<0x141>(x); return x; }
__device__ __forceinline__ float red16(float x) { x = red8(x); x += dpp_mov<0x140>(x); return x; }
__device__ __forceinline__ float wave_sum(float x) { x = red16(x); x += __shfl_xor(x, 16); x += __shfl_xor(x, 32); return x; }
__device__ __forceinline__ float wave_max(float x) {
#pragma unroll
    for (int o = 1; o < 64; o <<= 1) x = fmaxf(x, __shfl_xor(x, o));
    return x; }
__device__ __forceinline__ f32x4 mfma16(bf16x8 a, bf16x8 b, f32x4 c) { return __builtin_amdgcn_mfma_f32_16x16x32_bf16(a, b, c, 0, 0, 0); }
__device__ __forceinline__ void unpack4(u32x2 q, float (&o)[4]) { o[0] = bflo(q[0]); o[1] = bfhi(q[0]); o[2] = bflo(q[1]); o[3] = bfhi(q[1]); }

struct TJob { const float* src; bf16_t* dst; const float* gain; int K, N, ldd; };
__device__ __forceinline__ void transpose_tile(const TJob& j, int tile, LAS float* t) {
    const int tid = threadIdx.x; const int tn = j.N >> 6; const int k0 = (tile / tn) << 6, n0 = (tile % tn) << 6;
#pragma unroll
    for (int pp = 0; pp < 2; ++pp) { const int r = (tid >> 4) + pp * 32, c = (tid & 15) * 4;
        const f32x4 v = *(const f32x4*)(j.src + (size_t)(k0 + r) * j.N + n0 + c); const float g = j.gain ? j.gain[k0 + r] : 1.f;
        t[r * 65 + c] = v[0] * g; t[r * 65 + c + 1] = v[1] * g; t[r * 65 + c + 2] = v[2] * g; t[r * 65 + c + 3] = v[3] * g; }
    __syncthreads();
    { const int n = tid >> 3, k8 = (tid & 7) * 8; u32x4 o;
#pragma unroll
      for (int q = 0; q < 4; ++q) o[q] = pk2(t[(k8 + 2 * q) * 65 + n], t[(k8 + 2 * q + 1) * 65 + n]);
      *(u32x4*)(j.dst + (size_t)(n0 + n) * j.ldd + k0 + k8) = o; }
    __syncthreads();
}
__device__ __forceinline__ void tr_one(const Params& p, LAS unsigned char* lds, int it) {
    unsigned char* ws = p.ws; TJob j; int base;
    if (it < 2368)      { j = {p.in[I_WIN], (bf16_t*)(ws + WS_WTIN), p.in[I_N1G], 1024, PIN, 1024}; base = 0; }
    else if (it < 3136) { const int n = (it - 2368) >> 8; j = {p.in[I_WBR] + (size_t)n * 1048576, (bf16_t*)(ws + WS_WTBR) + (size_t)n * 1048576, nullptr, 1024, 1024, 1024}; base = 2368 + n * 256; }
    else if (it < 3392) { j = {p.in[I_WOUT], (bf16_t*)(ws + WS_WTOUT), nullptr, 1024, 1024, 1024}; base = 3136; }
    else if (it < 4416) { j = {p.in[I_WUP], (bf16_t*)(ws + WS_WTUP), p.in[I_N2G], 1024, 4096, 1024}; base = 3392; }
    else if (it < 5440) { j = {p.in[I_WDN], (bf16_t*)(ws + WS_WTDN), nullptr, 4096, 1024, 4096}; base = 4416; }
    else if (it < 5696) { j = {p.in[I_WMK], (bf16_t*)(ws + WS_WTMKV), p.in[I_MNG], 1024, 1024, 1024}; base = 5440; }
    else if (it < 5952) { j = {p.in[I_WMV], (bf16_t*)(ws + WS_WTMKV) + 1048576, p.in[I_MNG], 1024, 1024, 1024}; base = 5696; }
    else if (it < 5968) { j = {p.in[I_WW2], (bf16_t*)(ws + WS_WTLORA), nullptr, 64, 1024, 256}; base = 5952; }
    else if (it < 5984) { j = {p.in[I_WA2], (bf16_t*)(ws + WS_WTLORA) + 1024 * 256 + 64, nullptr, 64, 1024, 256}; base = 5968; }
    else                { j = {p.in[I_WG2], (bf16_t*)(ws + WS_WTLORA) + 2048 * 256 + 128, nullptr, 128, 1024, 256}; base = 5984; }
    transpose_tile(j, it - base, (LAS float*)lds);
}
__device__ __forceinline__ void tr_late(const Params& p, LAS unsigned char* lds, int it) {
    unsigned char* ws = p.ws; TJob j; int base;
    if (it < 3392)      { const int n = (it - 2368) >> 8; j = {p.in[I_WBR] + (size_t)n * 1048576, (bf16_t*)(ws + WS_WTBR) + (size_t)n * 1048576, nullptr, 1024, 1024, 1024}; base = 2368 + n * 256; }
    else if (it < 4416) { j = {p.in[I_WUP], (bf16_t*)(ws + WS_WTUP), p.in[I_N2G], 1024, 4096, 1024}; base = 3392; }
    else                { j = {p.in[I_WDN], (bf16_t*)(ws + WS_WTDN), nullptr, 4096, 1024, 4096}; base = 4416; }
    if (it >= 3136 && it < 3392) { j = {p.in[I_WOUT], (bf16_t*)(ws + WS_WTOUT), nullptr, 1024, 1024, 1024}; base = 3136; }
    transpose_tile(j, it - base, (LAS float*)lds);
}
__device__ __forceinline__ void phase0(const Params& p, LAS unsigned char* lds) {
    const int tid = threadIdx.x, wid = tid >> 6, lane = tid & 63; unsigned char* ws = p.ws;
    for (int i = blockIdx.x; i < 2368 + 576; i += gridDim.x) tr_one(p, lds, i < 2368 ? i : i + 3072);
    for (int r = blockIdx.x * 8 + wid; r < MT + 2048; r += gridDim.x * 8) {
        const float* src; bf16_t* dst;
        if (r < MP) { src = p.in[I_XP] + (size_t)r * 1024; dst = (bf16_t*)(ws + WS_HB) + (size_t)r * 1024; }
        else if (r < MT) { src = p.in[I_XS] + (size_t)(r - MP) * 1024; dst = (bf16_t*)(ws + WS_HB) + (size_t)r * 1024; }
        else { src = p.in[I_MEM] + (size_t)(r - MT) * 1024; dst = (bf16_t*)(ws + WS_HMB) + (size_t)(r - MT) * 1024; }
        f32x4 v[4]; float ss = 0.f;
#pragma unroll
        for (int c = 0; c < 4; ++c) { v[c] = *(const f32x4*)(src + c * 256 + lane * 4); ss += v[c][0] * v[c][0] + v[c][1] * v[c][1] + v[c][2] * v[c][2] + v[c][3] * v[c][3]; }
        ss = wave_sum(ss); const float rs = rsqrtf(ss * (1.f / 1024.f) + 1e-6f);
#pragma unroll
        for (int c = 0; c < 4; ++c) { u32x2 o; o[0] = pk2(v[c][0] * rs, v[c][1] * rs); o[1] = pk2(v[c][2] * rs, v[c][3] * rs); *(u32x2*)(dst + c * 256 + lane * 4) = o; }
    }
    { bf16_t* wl = (bf16_t*)(ws + WS_WTLORA);
      for (int i = blockIdx.x * 512 + tid; i < 3072 * 32; i += gridDim.x * 512) { const int row = i >> 5, cc = (i & 31) * 8, blk = row >> 10;
          const bool used = (blk == 0 && cc < 64) || (blk == 1 && cc >= 64 && cc < 128) || (blk == 2 && cc >= 128);
          if (!used) *(u32x4*)(wl + (size_t)row * 256 + cc) = (u32x4){0u, 0u, 0u, 0u}; } }
    { const float* sg = p.in[I_SGW]; bf16_t* d = (bf16_t*)(ws + WS_SGW);
      for (int i = blockIdx.x * 512 + tid; i < 8 * 128 * 128; i += gridDim.x * 512) { const int t = (i >> 7) & 127, s = i & 127; d[i] = (bf16_t)(pk2(s <= t ? sg[i] : 0.f, 0.f) & 0xffffu); } }
}

struct EpiZ {
    static constexpr bool PERM = true, AFTER_DRAIN = false;
    bf16_t *U, *GVp, *SZp, *Qp, *GTp; float* out;
    __device__ __forceinline__ void operator()(const f32x4 (&acc)[2][2][4][2], const pg8::Unit& u, int wr, int wc, int fr, int fq) const {
        const int pn = u.pn; bf16_t* base; int ldc, colt, act;
        if (pn < 4) { base = U; ldc = 1024; colt = pn * 256; act = 1; }
        else if (pn < 8) { base = GVp; ldc = 1024; colt = (pn - 4) * 256; act = 1; }
        else if (pn < 21) { base = SZp; ldc = PSH; colt = (pn - 8) * 256; act = 0; }
        else if (pn < 25) { base = Qp; ldc = 1024; colt = (pn - 21) * 256; act = 3; }
        else { base = GTp; ldc = 3072; colt = (pn - 25) * 256; act = 2; }
        const int row0 = u.pm * 256 + wr * 64 + fr, col0 = colt + wc * 32 + 8 * fq;
#pragma unroll
        for (int ai = 0; ai < 2; ++ai)
#pragma unroll
            for (int m = 0; m < 4; ++m) { const int row = row0 + ai * 128 + m * 16; bf16_t* rowp = base + (size_t)row * ldc + col0;
#pragma unroll
                for (int bj = 0; bj < 2; ++bj) { f32x4 v0 = acc[ai][bj][m][0], v1 = acc[ai][bj][m][1];
                    if (act == 1) {
#pragma unroll
                        for (int q = 0; q < 4; ++q) { v0[q] = gelu_tanh(v0[q]); v1[q] = gelu_tanh(v1[q]); } }
                    else if (act == 2) {
#pragma unroll
                        for (int q = 0; q < 4; ++q) { v0[q] = sigmoidf_(v0[q]); v1[q] = sigmoidf_(v1[q]); } }
                    else if (act == 0) {
                        const bool lastp = row < MP ? ((row & 2047) == 2047) : (((row - MP) & 3) == 3);
                        if (lastp) { float* d = (row < MP ? out + O_PSH + (size_t)(row >> 11) * PSH : out + O_SSH + (size_t)((row - MP) >> 2) * PSH) + col0 + bj * 128;
                            *(f32x4*)d = v0; *(f32x4*)(d + 4) = v1; } }
                    u32x4 o; o[0] = pk2(v0[0], v0[1]); o[1] = pk2(v0[2], v0[3]); o[2] = pk2(v1[0], v1[1]); o[3] = pk2(v1[2], v1[3]);
                    __builtin_nontemporal_store(o, (u32x4*)(rowp + bj * 128)); } }
    }
};
struct EpiMem {
    static constexpr bool PERM = false, AFTER_DRAIN = false;
    float* out; bf16_t *MKB, *MVT;
    __device__ __forceinline__ void operator()(const f32x4 (&acc)[2][2][4][2], const pg8::Unit& u, int wr, int wc, int fr, int fq) const {
        const int row0 = u.pm * 256 + wr * 64 + fr, col0 = u.pn * 256 + wc * 32 + 4 * fq; const bool isv = u.pn >= 4;
#pragma unroll
        for (int ai = 0; ai < 2; ++ai)
#pragma unroll
            for (int m = 0; m < 4; ++m) { const int row = row0 + ai * 128 + m * 16;
#pragma unroll
                for (int bj = 0; bj < 2; ++bj)
#pragma unroll
                    for (int n = 0; n < 2; ++n) { const f32x4 v = acc[ai][bj][m][n]; const int col = col0 + bj * 128 + n * 16;
                        if (!isv) { *(f32x4*)(out + O_PMK + (size_t)row * 1024 + col) = v; u32x2 o; o[0] = pk2(v[0], v[1]); o[1] = pk2(v[2], v[3]); *(u32x2*)(MKB + (size_t)row * 1024 + col) = o; }
                        else { const int c = col - 1024; *(f32x4*)(out + O_PMV + (size_t)row * 1024 + c) = v;
                            const int b = row >> 8, mem = row & 255, head = c >> 8, d = c & 255; bf16_t* dst = MVT + ((size_t)((b * 4 + head) * 256 + d)) * 256 + mem;
                            const unsigned p0 = pk2(v[0], v[1]), p1 = pk2(v[2], v[3]);
                            dst[0] = (bf16_t)(p0 & 0xffffu); dst[256] = (bf16_t)(p0 >> 16); dst[512] = (bf16_t)(p1 & 0xffffu); dst[768] = (bf16_t)(p1 >> 16); } } }
    }
};
struct BranchOrder {
    int G, c;
    __device__ bool next(int i, pg8::Unit& u) const { const int tile = (i / 3) * G + c, n = i % 3; if (tile >= (MP / 256) * 4) return false;
        const int xcd = tile & 7, q = tile >> 3, pm = xcd * 8 + (q >> 2), pn = q & 3;
        u.pm = n * NPANEL + pm; u.pn = n * 4 + pn; return true; }
    __device__ __forceinline__ void a_ready(const pg8::Unit&) const {}
    __device__ __forceinline__ void done(const pg8::Unit&) const {}
};
struct EpiMerge {
    static constexpr bool PERM = false, AFTER_DRAIN = false;
    const bf16_t* GT; float* MF; bf16_t* MB;
    __device__ __forceinline__ void operator()(const f32x4 (&acc)[2][2][4][2], const pg8::Unit& u, int wr, int wc, int fr, int fq) const {
        const int n = u.pm / NPANEL, pm = u.pm - n * NPANEL, pn = u.pn & 3;
        const int row0 = pm * 256 + wr * 64 + fr, col0 = pn * 256 + wc * 32 + 4 * fq;
        u32x2 g[2][4]; f32x4 o[2][4];
        auto issue = [&](int grp, int slot) { const int row = row0 + (grp >> 2) * 128 + (grp & 3) * 16; const bf16_t* gp = GT + (size_t)row * 3072 + n * 1024 + col0; const float* mp = MF + (size_t)row * 1024 + col0;
#pragma unroll
            for (int x = 0; x < 4; ++x) { g[slot][x] = *(const u32x2*)(gp + (x >> 1) * 128 + (x & 1) * 16); if (n > 0) o[slot][x] = *(const f32x4*)(mp + (x >> 1) * 128 + (x & 1) * 16); else o[slot][x] = (f32x4){0.f, 0.f, 0.f, 0.f}; } };
        issue(0, 0);
#pragma unroll
        for (int grp = 0; grp < 8; ++grp) { const int slot = grp & 1, ai = grp >> 2, m = grp & 3; const int row = row0 + ai * 128 + m * 16;
            if (grp < 7) issue(grp + 1, slot ^ 1);
            float* mp = MF + (size_t)row * 1024 + col0;
#pragma unroll
            for (int x = 0; x < 4; ++x) { float gf[4]; unpack4(g[slot][x], gf); f32x4 v = acc[ai][x >> 1][m][x & 1];
                v[0] = v[0] * gf[0] + o[slot][x][0]; v[1] = v[1] * gf[1] + o[slot][x][1]; v[2] = v[2] * gf[2] + o[slot][x][2]; v[3] = v[3] * gf[3] + o[slot][x][3];
                if (n < 2) *(f32x4*)(mp + (x >> 1) * 128 + (x & 1) * 16) = v;
                else { u32x2 w; w[0] = pk2(v[0], v[1]); w[1] = pk2(v[2], v[3]); *(u32x2*)(MB + (size_t)row * 1024 + col0 + (x >> 1) * 128 + (x & 1) * 16) = w; } } }
    }
};
template <int KS, class Mid, class Fin>
__device__ __forceinline__ void thin_gemm(LAS unsigned char* lds, const bf16_t* A0, size_t a_bstride, const bf16_t* B0, size_t b_bstride, int nb, int N, int K, const Mid& mid, const Fin& fin) {
    const int wid = threadIdx.x >> 6, lane = threadIdx.x & 63, fr = lane & 15, fq = lane >> 4; const int ntask = 32 * (N >> 6);
    constexpr int TPB = 8 / KS; const int grp = wid / KS, kq = wid % KS, kspan = K / KS;
    LAS f32x4* red = (LAS f32x4*)lds;
    for (int t0 = blockIdx.x * TPB; t0 < ntask; t0 += gridDim.x * TPB) {
        const int t = t0 + grp; const bool valid = t < ntask;
        const int r0 = MP + (t & 31) * 16, c0 = (t >> 5) * 64;
        f32x4 tot[4];
#pragma unroll
        for (int j = 0; j < 4; ++j) tot[j] = (f32x4){0.f, 0.f, 0.f, 0.f};
        if (valid) for (int n = 0; n < nb; ++n) { f32x4 acc[4];
#pragma unroll
            for (int j = 0; j < 4; ++j) acc[j] = (f32x4){0.f, 0.f, 0.f, 0.f};
            const bf16_t* ap = A0 + (size_t)n * a_bstride + (size_t)(r0 + fr) * K + kq * kspan + fq * 8; const bf16_t* bp = B0 + (size_t)n * b_bstride + (size_t)(c0 + fr) * K + kq * kspan + fq * 8;
#pragma unroll 4
            for (int ks = 0; ks < (kspan >> 5); ++ks) { const bf16x8 a = *(const bf16x8*)(ap + ks * 32);
#pragma unroll
                for (int j = 0; j < 4; ++j) { const bf16x8 b = *(const bf16x8*)(bp + (size_t)j * 16 * K + ks * 32); acc[j] = mfma16(b, a, acc[j]); } }
            mid(n, acc, tot, r0 + fr, c0 + 4 * fq); }
        if (KS > 1) {
#pragma unroll
            for (int j = 0; j < 4; ++j) red[(wid * 4 + j) * 64 + lane] = tot[j];
            __syncthreads();
            if (kq == 0 && valid) {
#pragma unroll
                for (int q = 1; q < KS; ++q)
#pragma unroll
                    for (int j = 0; j < 4; ++j) tot[j] += red[((wid + q) * 4 + j) * 64 + lane];
                fin(tot, r0 + fr, c0 + 4 * fq); }
            __syncthreads();
        } else if (valid) fin(tot, r0 + fr, c0 + 4 * fq);
    }
}
struct EpiRes {
    static constexpr bool PERM = false, AFTER_DRAIN = false;
    const float* resP; const float* resS; float* X; bf16_t* XB; float* ssq;
    __device__ __forceinline__ void operator()(const f32x4 (&acc)[2][2][4][2], const pg8::Unit& u, int wr, int wc, int fr, int fq) const {
        const int row0 = u.pm * 256 + wr * 64 + fr, col0 = u.pn * 256 + wc * 32 + 4 * fq;
#pragma unroll
        for (int ai = 0; ai < 2; ++ai) { f32x4 r[4][4];
#pragma unroll
            for (int m = 0; m < 4; ++m) { const int row = row0 + ai * 128 + m * 16; const float* rp = (row < MP ? resP + (size_t)row * 1024 : resS + (size_t)(row - MP) * 1024) + col0;
#pragma unroll
                for (int x = 0; x < 4; ++x) r[m][x] = *(const f32x4*)(rp + (x >> 1) * 128 + (x & 1) * 16); }
#pragma unroll
            for (int m = 0; m < 4; ++m) { const int row = row0 + ai * 128 + m * 16; float ss = 0.f;
#pragma unroll
                for (int x = 0; x < 4; ++x) { const int col = col0 + (x >> 1) * 128 + (x & 1) * 16; const f32x4 v = acc[ai][x >> 1][m][x & 1] + r[m][x];
                    *(f32x4*)(X + (size_t)row * 1024 + col) = v; ss += v[0] * v[0] + v[1] * v[1] + v[2] * v[2] + v[3] * v[3];
                    if (XB) { u32x2 w; w[0] = pk2(v[0], v[1]); w[1] = pk2(v[2], v[3]); *(u32x2*)(XB + (size_t)row * 1024 + col) = w; } }
                ss += __shfl_xor(ss, 16); ss += __shfl_xor(ss, 32);
                if (fq == 0) atomicAdd(ssq + row, ss); } }
    }
};
struct EpiUp {
    static constexpr bool PERM = true, AFTER_DRAIN = false;
    const float* ssq; bf16_t* H;
    __device__ __forceinline__ void operator()(const f32x4 (&acc)[2][2][4][2], const pg8::Unit& u, int wr, int wc, int fr, int fq) const {
        const int row0 = u.pm * 256 + wr * 64 + fr, col0 = u.pn * 256 + wc * 32 + 8 * fq;
#pragma unroll
        for (int ai = 0; ai < 2; ++ai)
#pragma unroll
            for (int m = 0; m < 4; ++m) { const int row = row0 + ai * 128 + m * 16; const float rs = rsqrtf(ssq[row] * (1.f / 1024.f) + 1e-6f);
#pragma unroll
                for (int bj = 0; bj < 2; ++bj) { f32x4 v0 = acc[ai][bj][m][0], v1 = acc[ai][bj][m][1];
#pragma unroll
                    for (int q = 0; q < 4; ++q) { float a = fmaxf(v0[q] * rs, 0.f); v0[q] = a * a; float b = fmaxf(v1[q] * rs, 0.f); v1[q] = b * b; }
                    u32x4 o; o[0] = pk2(v0[0], v0[1]); o[1] = pk2(v0[2], v0[3]); o[2] = pk2(v1[0], v1[1]); o[3] = pk2(v1[2], v1[3]);
                    __builtin_nontemporal_store(o, (u32x4*)(H + (size_t)row * DFF + col0 + bj * 128)); } }
    }
};

template <int NR, bool DUMMY> __device__ __forceinline__ void p2_rows(const Params& p, const int (&mrow)[NR], int lane) {
    unsigned char* ws = p.ws; const float* lng = p.in[I_LNG]; const float* lnb = p.in[I_LNB];
    const int c4 = lane * 4;
    u32x4 q0[NR], q1[NR]; u32x2 cq[NR], pq[NR]; f32x4 sq[NR]; bool valid[NR], first[NR];
#pragma unroll
    for (int i = 0; i < NR; ++i) { const int m = mrow[i]; valid[i] = m < MT; const int mm = valid[i] ? m : 0;
        const bf16_t* row = (const bf16_t*)(ws + WS_GV) + (size_t)mm * 1024; q0[i] = *(const u32x4*)(row + lane * 8); q1[i] = *(const u32x4*)(row + 512 + lane * 8);
        const bf16_t* cur = (const bf16_t*)(ws + WS_SZ) + (size_t)mm * PSH + 3072 + c4; cq[i] = *(const u32x2*)cur;
        first[i] = mm < MP ? ((mm & 2047) == 0) : (((mm - MP) & 3) == 0);
        pq[i] = (u32x2){0u, 0u}; sq[i] = (f32x4){0.f, 0.f, 0.f, 0.f};
        if (!first[i]) pq[i] = *(const u32x2*)(cur - PSH);
        else if (mm >= MP) sq[i] = *(const f32x4*)(p.in[I_SSH] + (size_t)((mm - MP) >> 2) * PSH + 3072 + c4); }
    const f32x4 mu = *(const f32x4*)(p.in[I_MU] + 3072 + c4);
    f32x4 g0[2], g1[2], b0[2], b1[2];
#pragma unroll
    for (int c = 0; c < 2; ++c) { const int col = c * 512 + lane * 8; g0[c] = *(const f32x4*)(lng + col); g1[c] = *(const f32x4*)(lng + col + 4); b0[c] = *(const f32x4*)(lnb + col); b1[c] = *(const f32x4*)(lnb + col + 4); }
#pragma unroll
    for (int i = 0; i < NR; ++i) { if (!valid[i]) continue; const int m = mrow[i]; bf16_t* row = (bf16_t*)(ws + WS_GV) + (size_t)m * 1024; float x[16];
#pragma unroll
        for (int k = 0; k < 4; ++k) { x[2 * k] = bflo(q0[i][k]); x[2 * k + 1] = bfhi(q0[i][k]); x[8 + 2 * k] = bflo(q1[i][k]); x[8 + 2 * k + 1] = bfhi(q1[i][k]); }
        float s = 0.f;
#pragma unroll
        for (int k = 0; k < 16; ++k) s += x[k];
        s = wave_sum(s); const float mean = s * (1.f / 1024.f); float vs = 0.f;
#pragma unroll
        for (int k = 0; k < 16; ++k) { x[k] -= mean; vs += x[k] * x[k]; }
        vs = wave_sum(vs); const float rstd = rsqrtf(vs * (1.f / 1024.f) + 1e-5f);
#pragma unroll
        for (int c = 0; c < 2; ++c) { const int col = c * 512 + lane * 8; float y[8];
#pragma unroll
            for (int k = 0; k < 4; ++k) { y[k] = x[c * 8 + k] * rstd * g0[c][k] + b0[c][k]; y[4 + k] = x[c * 8 + 4 + k] * rstd * g1[c][k] + b1[c][k]; }
            u32x4 o; o[0] = pk2(y[0], y[1]); o[1] = pk2(y[2], y[3]); o[2] = pk2(y[4], y[5]); o[3] = pk2(y[6], y[7]); if (!DUMMY) *(u32x4*)(row + col) = o;
            if (m >= MP) { float* d = p.out + O_SGV + (size_t)(m - MP) * 1024 + col; *(f32x4*)d = (f32x4){y[0], y[1], y[2], y[3]}; *(f32x4*)(d + 4) = (f32x4){y[4], y[5], y[6], y[7]}; } }
        float cv[4], pv[4], o[4]; unpack4(cq[i], cv);
        if (!first[i]) unpack4(pq[i], pv); else { pv[0] = sq[i][0]; pv[1] = sq[i][1]; pv[2] = sq[i][2]; pv[3] = sq[i][3]; }
#pragma unroll
        for (int e = 0; e < 4; ++e) { const float ss = cv[e] + (pv[e] - cv[e]) * mu[e]; o[e] = lane < 16 ? tanhf_(ss) : (lane < 32 ? ss : sigmoidf_(ss)); }
        u32x2 w; w[0] = pk2(o[0], o[1]); w[1] = pk2(o[2], o[3]); *(u32x2*)((bf16_t*)(ws + WS_XL) + (size_t)m * 256 + c4) = w; }
}
struct EpiLora {
    static constexpr bool PERM = true, AFTER_DRAIN = false;
    bf16_t *E, *A, *Gg; const float *w0, *a0;
    __device__ __forceinline__ void operator()(const f32x4 (&acc)[2][2][4][2], const pg8::Unit& u, int wr, int wc, int fr, int fq) const {
        const int seg = u.pn >> 2, colt = (u.pn & 3) * 256; bf16_t* base = E + (size_t)seg * 17301504;
        const int row0 = u.pm * 256 + wr * 64 + fr, col0 = colt + wc * 32 + 8 * fq;
        f32x4 bv[2][2];
#pragma unroll
        for (int bj = 0; bj < 2; ++bj) { if (seg == 0) { bv[bj][0] = *(const f32x4*)(w0 + col0 + bj * 128); bv[bj][1] = *(const f32x4*)(w0 + col0 + bj * 128 + 4); } else if (seg == 1) { bv[bj][0] = *(const f32x4*)(a0 + col0 + bj * 128); bv[bj][1] = *(const f32x4*)(a0 + col0 + bj * 128 + 4); } else { bv[bj][0] = (f32x4){0.f, 0.f, 0.f, 0.f}; bv[bj][1] = bv[bj][0]; } }
#pragma unroll
        for (int ai = 0; ai < 2; ++ai)
#pragma unroll
            for (int m = 0; m < 4; ++m) { const int row = row0 + ai * 128 + m * 16; bf16_t* rowp = base + (size_t)row * 1024 + col0;
#pragma unroll
                for (int bj = 0; bj < 2; ++bj) { f32x4 v0 = acc[ai][bj][m][0] + bv[bj][0], v1 = acc[ai][bj][m][1] + bv[bj][1];
                    if (seg == 0) {
#pragma unroll
                        for (int q = 0; q < 4; ++q) { v0[q] = 0.60653066f * sigmoidf_(v0[q]); v1[q] = 0.60653066f * sigmoidf_(v1[q]); } }
                    else if (seg == 1) {
#pragma unroll
                        for (int q = 0; q < 4; ++q) { v0[q] = sigmoidf_(v0[q]); v1[q] = sigmoidf_(v1[q]); } }
                    u32x4 o; o[0] = pk2(v0[0], v0[1]); o[1] = pk2(v0[2], v0[3]); o[2] = pk2(v1[0], v1[1]); o[3] = pk2(v1[2], v1[3]);
                    *(u32x4*)(rowp + bj * 128) = o; } }
    }
};

struct ScanPre { u32x2 cr, ck, cv, pr, pk, pv, e, a, g; };
__device__ __forceinline__ u32x2 pack4f(const float* s) { const f32x4 q = *(const f32x4*)s; u32x2 o; o[0] = pk2(q[0], q[1]); o[1] = pk2(q[2], q[3]); return o; }
__device__ __forceinline__ void scan_head(const Params& p, LAS unsigned char* lds, int row0, int T, int h, const float* s0, float* sfin, const float* shift0) {
    const int tid = threadIdx.x, wid = tid >> 6, lane = tid & 63; unsigned char* ws = p.ws;
    const bf16_t* SZp = (const bf16_t*)(ws + WS_SZ); const bf16_t* Ep = (const bf16_t*)(ws + WS_E); const bf16_t* Ap = (const bf16_t*)(ws + WS_AV); const bf16_t* Gp = (const bf16_t*)(ws + WS_GG);
    bf16_t* YB = (bf16_t*)(ws + WS_Y3) + (size_t)MT * 1024;
    LAS float* bufs = (LAS float*)lds;
    LAS float* Yl2 = (LAS float*)(lds + 98304);
    LAS float* BON = (LAS float*)(lds + 98304 + 16384);
    const bool helper = wid >= 4; const int htid = tid & 255;
    const int tth = htid >> 4, j4 = (htid & 15) * 4, ch = h * 64 + j4;
    const int si = (wid & 3) * 16 + (lane >> 3) * 2, jb = (lane & 7) * 8;
    f32x2 S0[4], S1[4];
    if (s0 && !helper) {
#pragma unroll
        for (int q = 0; q < 4; ++q) { S0[q] = *(const f32x2*)(s0 + si * 64 + jb + 2 * q); S1[q] = *(const f32x2*)(s0 + (si + 1) * 64 + jb + 2 * q); } }
    else {
#pragma unroll
        for (int q = 0; q < 4; ++q) { S0[q] = (f32x2){0.f, 0.f}; S1[q] = S0[q]; } }
    auto load_pre = [&](int t0, ScanPre (&P)[2]) {
#pragma unroll
        for (int pp = 0; pp < 2; ++pp) { const int t = t0 + tth + 16 * pp; ScanPre& Q = P[pp];
            if (t < T) { const size_t m = (size_t)(row0 + t); const bf16_t* c = SZp + m * PSH + ch;
                Q.cr = *(const u32x2*)c; Q.ck = *(const u32x2*)(c + 1024); Q.cv = *(const u32x2*)(c + 2048);
                if (t > 0) { Q.pr = *(const u32x2*)(c - PSH); Q.pk = *(const u32x2*)(c - PSH + 1024); Q.pv = *(const u32x2*)(c - PSH + 2048); }
                else if (shift0) { Q.pr = pack4f(shift0 + ch); Q.pk = pack4f(shift0 + 1024 + ch); Q.pv = pack4f(shift0 + 2048 + ch); }
                else { Q.pr = (u32x2){0u, 0u}; Q.pk = Q.pr; Q.pv = Q.pr; }
                Q.e = *(const u32x2*)(Ep + m * 1024 + ch); Q.a = *(const u32x2*)(Ap + m * 1024 + ch); Q.g = (u32x2){0u, 0u}; }
            else { Q.cr = (u32x2){0u, 0u}; Q.ck = Q.cr; Q.cv = Q.cr; Q.pr = Q.cr; Q.pk = Q.cr; Q.pv = Q.cr; Q.e = Q.cr; Q.a = Q.cr; Q.g = Q.cr; } }
    };
    auto store_pre = [&](const ScanPre (&P)[2], int nb) {
        const f32x4 mur = *(const f32x4*)(p.in[I_MU] + ch), muk = *(const f32x4*)(p.in[I_MU] + 1024 + ch), muv = *(const f32x4*)(p.in[I_MU] + 2048 + ch),
                    kkc = *(const f32x4*)(p.in[I_KK] + ch), kac = *(const f32x4*)(p.in[I_KA] + ch), rkc = *(const f32x4*)(p.in[I_RK] + ch);
#pragma unroll
        for (int pp = 0; pp < 2; ++pp) { const ScanPre& Q = P[pp]; const int tt = tth + 16 * pp;
            float cr[4], ck[4], cv[4], pr[4], pk[4], pv[4], e[4], a[4];
            unpack4(Q.cr, cr); unpack4(Q.ck, ck); unpack4(Q.cv, cv); unpack4(Q.pr, pr); unpack4(Q.pk, pk); unpack4(Q.pv, pv); unpack4(Q.e, e); unpack4(Q.a, a);
            f32x4 r, w, k, na, bb, v; float ssq = 0.f, bon = 0.f; float kkr[4];
#pragma unroll
            for (int q = 0; q < 4; ++q) { r[q] = cr[q] + (pr[q] - cr[q]) * mur[q]; const float kz = ck[q] + (pk[q] - ck[q]) * muk[q]; v[q] = cv[q] + (pv[q] - cv[q]) * muv[q];
                k[q] = kz * (1.f + (a[q] - 1.f) * kac[q]); kkr[q] = kz * kkc[q]; ssq += kkr[q] * kkr[q]; bon += r[q] * k[q] * rkc[q]; w[q] = __expf(-e[q]); }
            ssq = red16(ssq); bon = red16(bon); const float rn = rsqrtf(ssq + 1e-12f);
#pragma unroll
            for (int q = 0; q < 4; ++q) { const float kk = kkr[q] * rn; na[q] = -kk; bb[q] = kk * a[q]; }
            LAS float* b = bufs + nb * 12288 + tt * 64 + j4;
            *(LAS f32x4*)(b) = r; *(LAS f32x4*)(b + 2048) = w; *(LAS f32x4*)(b + 4096) = k; *(LAS f32x4*)(b + 6144) = na; *(LAS f32x4*)(b + 8192) = bb; *(LAS f32x4*)(b + 10240) = v;
            if ((htid & 15) == 0) BON[nb * 32 + tt] = bon; }
    };
    auto epilogue = [&](int c) {
        const int cb = c & 1, t0 = c * 32, nv = (T - t0) < 32 ? (T - t0) : 32;
        const f32x4 lg = *(const f32x4*)(p.in[I_LXG] + h * 64 + j4), lb = *(const f32x4*)(p.in[I_LXB] + h * 64 + j4);
        u32x2 gq[2];
#pragma unroll
        for (int pp = 0; pp < 2; ++pp) { const int tt = tth + 16 * pp; gq[pp] = (u32x2){0u, 0u}; if (tt < nv) gq[pp] = *(const u32x2*)(Gp + (size_t)(row0 + t0 + tt) * 1024 + ch); }
#pragma unroll
        for (int pp = 0; pp < 2; ++pp) { const int tt = tth + 16 * pp;
            if (tt < nv) { const size_t m = (size_t)(row0 + t0 + tt);
                const f32x4 y = *(const LAS f32x4*)(Yl2 + cb * 2048 + tt * 64 + j4); const f32x4 v = *(const LAS f32x4*)(bufs + cb * 12288 + 10240 + tt * 64 + j4); const float bon = BON[cb * 32 + tt];
                float s = y[0] + y[1] + y[2] + y[3]; s = red16(s); const float mean = s * (1.f / 64.f);
                float d[4], vs = 0.f;
#pragma unroll
                for (int q = 0; q < 4; ++q) { d[q] = y[q] - mean; vs += d[q] * d[q]; }
                vs = red16(vs); const float rstd = rsqrtf(vs * (1.f / 64.f) + 64e-5f);
                float g[4]; unpack4(gq[pp], g); float o[4];
#pragma unroll
                for (int q = 0; q < 4; ++q) o[q] = (d[q] * rstd * lg[q] + lb[q] + bon * v[q]) * g[q];
                u32x2 w; w[0] = pk2(o[0], o[1]); w[1] = pk2(o[2], o[3]); *(u32x2*)(YB + m * 1024 + h * 64 + j4) = w; } }
    };
    ScanPre P[2];
    if (helper) { load_pre(0, P); store_pre(P, 0); }
    __syncthreads();
    const int nch = (T + 31) >> 5;
    for (int c = 0; c < nch; ++c) {
        const int cb = c & 1, t0 = c * 32, nv = (T - t0) < 32 ? (T - t0) : 32;
        if (!helper) { const LAS float* b = bufs + cb * 12288 + jb; const LAS float* vb = bufs + cb * 12288 + 10240 + si; LAS float* Yl = Yl2 + cb * 2048;
          f32x4 R[2], W[2], K[2], A[2], B[2], nR[2], nW[2], nK[2], nA[2], nB[2]; f32x2 v, nvv;
#define SCAN_LOAD(R_, W_, K_, A_, B_, V_, t) { const LAS float* bt = b + (t) * 64; _Pragma("unroll") for (int x = 0; x < 2; ++x) { \
              A_[x] = *(const LAS f32x4*)(bt + 6144 + 4 * x); B_[x] = *(const LAS f32x4*)(bt + 8192 + 4 * x); W_[x] = *(const LAS f32x4*)(bt + 2048 + 4 * x); \
              K_[x] = *(const LAS f32x4*)(bt + 4096 + 4 * x); R_[x] = *(const LAS f32x4*)(bt + 4 * x); } V_ = *(const LAS f32x2*)(vb + (t) * 64); }
#define H2(X, q) ((f32x2){X[(q) >> 1][((q) & 1) * 2], X[(q) >> 1][((q) & 1) * 2 + 1]})
          SCAN_LOAD(R, W, K, A, B, v, 0)
#pragma unroll 4
          for (int t = 0; t < nv; ++t) {
              { const int tn = (t + 1 < 32) ? t + 1 : 31; SCAN_LOAD(nR, nW, nK, nA, nB, nvv, tn) }
              asm volatile("" ::: "memory");
              f32x2 d0 = S0[0] * H2(A, 0), d1 = S1[0] * H2(A, 0);
#pragma unroll
              for (int q = 1; q < 4; ++q) { d0 += S0[q] * H2(A, q); d1 += S1[q] * H2(A, q); }
              const float sa0 = red8(d0[0] + d0[1]), sa1 = red8(d1[0] + d1[1]);
              const f32x2 sa02 = {sa0, sa0}, sa12 = {sa1, sa1}, v02 = {v[0], v[0]}, v12 = {v[1], v[1]};
#pragma unroll
              for (int q = 0; q < 4; ++q) { S0[q] = S0[q] * H2(W, q) + (sa02 * H2(B, q) + v02 * H2(K, q)); S1[q] = S1[q] * H2(W, q) + (sa12 * H2(B, q) + v12 * H2(K, q)); }
              f32x2 y0 = S0[0] * H2(R, 0), y1 = S1[0] * H2(R, 0);
#pragma unroll
              for (int q = 1; q < 4; ++q) { y0 += S0[q] * H2(R, q); y1 += S1[q] * H2(R, q); }
              float yy0 = y0[0] + y0[1], yy1 = y1[0] + y1[1];
              asm("" : "+v"(yy0)); asm("" : "+v"(yy1));
              yy0 = red8(yy0); yy1 = red8(yy1);
              *(LAS f32x2*)(Yl + t * 64 + si) = (f32x2){yy0, yy1};
#pragma unroll
              for (int x = 0; x < 2; ++x) { R[x] = nR[x]; W[x] = nW[x]; K[x] = nK[x]; A[x] = nA[x]; B[x] = nB[x]; }
              v = nvv; }
#undef SCAN_LOAD
#undef H2
        } else {
            if (c + 1 < nch) load_pre(t0 + 32, P);
            if (c > 0) epilogue(c - 1);
            if (c + 1 < nch) store_pre(P, cb ^ 1);
        }
        __syncthreads();
    }
    if (helper) epilogue(nch - 1);
#pragma unroll
    for (int q = 0; q < 4; ++q) if (!helper) { *(f32x2*)(sfin + si * 64 + jb + 2 * q) = S0[q]; *(f32x2*)(sfin + (si + 1) * 64 + jb + 2 * q) = S1[q]; }
}

template <bool DUMMY> __device__ __forceinline__ void attn_prompt_item(const Params& p, LAS unsigned char* lds, int item) {
    const int tid = threadIdx.x, wid = tid >> 6, lane = tid & 63, fr = lane & 15, fq = lane >> 4; unsigned char* ws = p.ws;
    const int b = item >> 6, head = (item >> 4) & 3, qt = item & 15;
    bf16_t* Qp = (bf16_t*)(ws + WS_Y3) + (size_t)2 * MT * 1024; const bf16_t* MKB = (const bf16_t*)(ws + WS_MKB); const bf16_t* MVT = (const bf16_t*)(ws + WS_MVT);
    const int qrow = b * 2048 + qt * 128 + wid * 16;
    bf16x8 qf[8];
#pragma unroll
    for (int ks = 0; ks < 8; ++ks) qf[ks] = *(const bf16x8*)(Qp + (size_t)(qrow + fr) * 1024 + head * 256 + ks * 32 + fq * 8);
#pragma unroll 1
    for (int rnd = 0; rnd < 2; ++rnd) { u32x4 kv[8];
#pragma unroll
      for (int it = 0; it < 8; ++it) { const int idx = (rnd * 8 + it) * 512 + tid, row = idx >> 5, c = idx & 31; kv[it] = *(const u32x4*)(MKB + (size_t)(b * 256 + row) * 1024 + head * 256 + c * 8); }
#pragma unroll
      for (int it = 0; it < 8; ++it) { const int idx = (rnd * 8 + it) * 512 + tid, row = idx >> 5, c = idx & 31; *(LAS u32x4*)(lds + (row * 32 + (c ^ (row & 15))) * 16) = kv[it]; } }
    __syncthreads();
    u32x4 pf[8];
    { f32x4 s[16];
      int koff[8];
#pragma unroll
      for (int ks = 0; ks < 8; ++ks) koff[ks] = (fr * 32 + ((ks * 4 + fq) ^ fr)) * 16;
#pragma unroll
      for (int nt = 0; nt < 16; ++nt) { f32x4 acc = {0.f, 0.f, 0.f, 0.f};
#pragma unroll
          for (int ks = 0; ks < 8; ++ks) { const bf16x8 kf = *(const LAS bf16x8*)(lds + nt * 8192 + koff[ks]); acc = mfma16(kf, qf[ks], acc); }
          s[nt] = acc; }
      float mx = -3.0e38f;
#pragma unroll
      for (int nt = 0; nt < 16; ++nt) mx = fmaxf(fmaxf(fmaxf(s[nt][0], s[nt][1]), fmaxf(s[nt][2], s[nt][3])), mx);
      mx = fmaxf(mx, __shfl_xor(mx, 16)); mx = fmaxf(mx, __shfl_xor(mx, 32));
      float sum = 0.f;
#pragma unroll
      for (int nt = 0; nt < 16; ++nt)
#pragma unroll
          for (int q = 0; q < 4; ++q) { const float e = __expf((s[nt][q] - mx) * 0.0625f); s[nt][q] = e; sum += e; }
      sum += __shfl_xor(sum, 16); sum += __shfl_xor(sum, 32); const float inv = rcpf(sum);
#pragma unroll
      for (int ks = 0; ks < 8; ++ks) { pf[ks][0] = pk2(s[2 * ks][0] * inv, s[2 * ks][1] * inv); pf[ks][1] = pk2(s[2 * ks][2] * inv, s[2 * ks][3] * inv);
          pf[ks][2] = pk2(s[2 * ks + 1][0] * inv, s[2 * ks + 1][1] * inv); pf[ks][3] = pk2(s[2 * ks + 1][2] * inv, s[2 * ks + 1][3] * inv); } }
    __syncthreads();
#pragma unroll 1
    for (int rnd = 0; rnd < 2; ++rnd) { u32x4 kv[8];
#pragma unroll
      for (int it = 0; it < 8; ++it) { const int idx = (rnd * 8 + it) * 512 + tid, row = idx >> 5, c = idx & 31; kv[it] = *(const u32x4*)(MVT + ((size_t)((b * 4 + head) * 256 + row)) * 256 + c * 8); }
#pragma unroll
      for (int it = 0; it < 8; ++it) { const int idx = (rnd * 8 + it) * 512 + tid, row = idx >> 5, c = idx & 31; *(LAS u32x4*)(lds + (row * 32 + (c ^ (row & 15))) * 16) = kv[it]; } }
    __syncthreads();
    { int voff[8][2];
#pragma unroll
      for (int ks = 0; ks < 8; ++ks) { const int c1 = ks * 4 + (fq >> 1); voff[ks][0] = (fr * 32 + (c1 ^ fr)) * 16 + (fq & 1) * 8; voff[ks][1] = (fr * 32 + ((c1 + 2) ^ fr)) * 16 + (fq & 1) * 8; }
#pragma unroll 2
      for (int dt = 0; dt < 16; ++dt) { f32x4 acc = {0.f, 0.f, 0.f, 0.f};
#pragma unroll
          for (int ks = 0; ks < 8; ++ks) { const u32x2 lo = *(const LAS u32x2*)(lds + dt * 8192 + voff[ks][0]), hi = *(const LAS u32x2*)(lds + dt * 8192 + voff[ks][1]);
              u32x4 vv; vv[0] = lo[0]; vv[1] = lo[1]; vv[2] = hi[0]; vv[3] = hi[1]; acc = mfma16(__builtin_bit_cast(bf16x8, vv), __builtin_bit_cast(bf16x8, pf[ks]), acc); }
          u32x2 w; w[0] = pk2(acc[0], acc[1]); w[1] = pk2(acc[2], acc[3]);
          bf16_t* o = Qp + (size_t)(qrow + fr) * 1024 + head * 256 + dt * 16 + 4 * fq;
          if (!DUMMY) *(u32x2*)o = w; else if (w[0] == 0x12345678u) Qp[0] = 0; } }
    __syncthreads();
}

template <bool DUMMY> __device__ __forceinline__ void attn_sample_item(const Params& p, LAS unsigned char* lds, int item) {
    const int tid = threadIdx.x, wid = tid >> 6, lane = tid & 63, l16 = lane & 15, rg = lane >> 4; unsigned char* ws = p.ws;
    const int b = item >> 2, head = item & 3;
    bf16_t* Qp = (bf16_t*)(ws + WS_Y3) + (size_t)2 * MT * 1024 + (size_t)(MP + 4 * b) * 1024 + head * 256;
    const float* Kp = p.in[I_CK] + ((size_t)b * 256 * 4 + head) * 256; const float* Vp = p.in[I_CV] + ((size_t)b * 256 * 4 + head) * 256;
    LAS float* sc = (LAS float*)lds; LAS float* pr = (LAS float*)(lds + 4096); LAS float* part = (LAS float*)(lds + 8192);
    float qv[4][4][4];
#pragma unroll
    for (int t = 0; t < 4; ++t)
#pragma unroll
        for (int c = 0; c < 4; ++c) { const u32x2 q = *(const u32x2*)(Qp + t * 1024 + 64 * c + 4 * l16); unpack4(q, qv[t][c]); }
#pragma unroll 2
    for (int it = 0; it < 8; ++it) { const int mrow = wid * 32 + it * 4 + rg; const float* kr = Kp + (size_t)mrow * 1024 + 4 * l16; float d[4] = {0.f, 0.f, 0.f, 0.f};
#pragma unroll
        for (int c = 0; c < 4; ++c) { const f32x4 kv = *(const f32x4*)(kr + 64 * c);
#pragma unroll
            for (int t = 0; t < 4; ++t) d[t] += kv[0] * qv[t][c][0] + kv[1] * qv[t][c][1] + kv[2] * qv[t][c][2] + kv[3] * qv[t][c][3]; }
#pragma unroll
        for (int t = 0; t < 4; ++t) { const float r = red16(d[t]); if (l16 == 0) sc[t * 256 + mrow] = r * 0.0625f; } }
    __syncthreads();
    if (wid < 4) { const f32x4 x = *(const LAS f32x4*)(sc + wid * 256 + lane * 4); float mx = fmaxf(fmaxf(x[0], x[1]), fmaxf(x[2], x[3])); mx = wave_max(mx);
        float e[4], sum = 0.f;
#pragma unroll
        for (int q = 0; q < 4; ++q) { e[q] = __expf(x[q] - mx); sum += e[q]; }
        sum = wave_sum(sum); const float inv = rcpf(sum);
#pragma unroll
        for (int q = 0; q < 4; ++q) pr[(lane * 4 + q) * 4 + wid] = e[q] * inv; }
    __syncthreads();
    { f32x4 acc[4];
#pragma unroll
      for (int t = 0; t < 4; ++t) acc[t] = (f32x4){0.f, 0.f, 0.f, 0.f};
#pragma unroll 8
      for (int it = 0; it < 32; ++it) { const int mrow = wid * 32 + it; const f32x4 vv = *(const f32x4*)(Vp + (size_t)mrow * 1024 + lane * 4); const f32x4 pp = *(const LAS f32x4*)(pr + mrow * 4);
#pragma unroll
          for (int t = 0; t < 4; ++t) acc[t] += pp[t] * vv; }
#pragma unroll
      for (int t = 0; t < 4; ++t) *(LAS f32x4*)(part + (wid * 4 + t) * 256 + lane * 4) = acc[t]; }
    __syncthreads();
    { const int o = tid * 2, t = o >> 8, d = o & 255; float a0 = 0.f, a1 = 0.f;
#pragma unroll
      for (int w = 0; w < 8; ++w) { const f32x2 v = *(const LAS f32x2*)(part + (w * 4 + t) * 256 + d); a0 += v[0]; a1 += v[1]; }
      const unsigned wv = pk2(a0, a1); if (!DUMMY) *(unsigned*)(Qp + t * 1024 + d) = wv; else if (wv == 0x12345678u) Qp[0] = 0; }
    __syncthreads();
}

template <bool DUMMY> __device__ __forceinline__ void sg_prompt_item(const Params& p, LAS unsigned char* lds, int item) {
    const int tid = threadIdx.x, wid = tid >> 6, lane = tid & 63, fr = lane & 15, fq = lane >> 4; unsigned char* ws = p.ws;
    const int chn = item >> 3, g = item & 7, m0 = chn * 128;
    const bf16_t* VN = (const bf16_t*)(ws + WS_GV); const bf16_t* SGW = (const bf16_t*)(ws + WS_SGW) + g * 16384; bf16_t* U = (bf16_t*)(ws + WS_Y3);
    LAS bf16_t* VT = (LAS bf16_t*)lds;
    { const int s = tid >> 2, hq = (tid & 3) * 32; const bf16_t* src = VN + (size_t)(m0 + s) * 1024 + g * 128 + hq;
#pragma unroll
      for (int c = 0; c < 4; ++c) { const u32x4 q = *(const u32x4*)(src + c * 8);
#pragma unroll
          for (int k = 0; k < 4; ++k) { VT[(hq + c * 8 + 2 * k) * 136 + s] = (bf16_t)(q[k] & 0xffffu); VT[(hq + c * 8 + 2 * k + 1) * 136 + s] = (bf16_t)(q[k] >> 16); } } }
    const int h0 = wid * 16; bf16x8 xf[4];
    const float* sgb = p.in[I_SGB] + g * 128;
    bf16x8 yf[8][4]; u32x2 uq[8]; float bias[8];
#pragma unroll
    for (int mt = 0; mt < 8; ++mt) {
#pragma unroll
        for (int ks = 0; ks < 4; ++ks) if (32 * ks <= 16 * mt + 15) yf[mt][ks] = *(const bf16x8*)(SGW + (mt * 16 + fr) * 128 + ks * 32 + fq * 8);
        uq[mt] = *(const u32x2*)(U + (size_t)(m0 + mt * 16 + fr) * 1024 + g * 128 + h0 + 4 * fq); bias[mt] = sgb[mt * 16 + fr]; }
    __syncthreads();
#pragma unroll
    for (int ks = 0; ks < 4; ++ks) xf[ks] = *(const LAS bf16x8*)(VT + (h0 + fr) * 136 + ks * 32 + fq * 8);
#pragma unroll
    for (int mt = 0; mt < 8; ++mt) { f32x4 acc = {0.f, 0.f, 0.f, 0.f};
#pragma unroll
        for (int ks = 0; ks < 4; ++ks) if (32 * ks <= 16 * mt + 15) acc = mfma16(xf[ks], yf[mt][ks], acc);
        bf16_t* up = U + (size_t)(m0 + mt * 16 + fr) * 1024 + g * 128 + h0 + 4 * fq; float uf[4]; unpack4(uq[mt], uf);
        u32x2 w; w[0] = pk2(uf[0] * (acc[0] + bias[mt]), uf[1] * (acc[1] + bias[mt])); w[1] = pk2(uf[2] * (acc[2] + bias[mt]), uf[3] * (acc[3] + bias[mt])); if (!DUMMY) *(u32x2*)up = w; else if (w[0] == 0x12345678u) up[0] = 0; }
    __syncthreads();
}
__device__ __forceinline__ void sg_sample_item(const Params& p, int item) {
    const int tid = threadIdx.x; unsigned char* ws = p.ws; const bf16_t* VN = (const bf16_t*)(ws + WS_GV); bf16_t* U = (bf16_t*)(ws + WS_Y3);
    const float* sgw = p.in[I_SGW]; const float* sgb = p.in[I_SGB];
    for (int e = tid; e < 32 * 128; e += 512) { const int r = e >> 7, c8 = (e & 127) * 8; const int m = MP + item * 32 + r, t = r & 3, g = c8 >> 7; float a[8];
#pragma unroll
        for (int k = 0; k < 8; ++k) a[k] = sgb[g * 128 + t];
        for (int s = 0; s <= t; ++s) { const float w = sgw[(g * 128 + t) * 128 + s]; const u32x4 q = *(const u32x4*)(VN + (size_t)(m - t + s) * 1024 + c8);
#pragma unroll
            for (int k = 0; k < 4; ++k) { a[2 * k] += w * bflo(q[k]); a[2 * k + 1] += w * bfhi(q[k]); } }
        bf16_t* up = U + (size_t)m * 1024 + c8; const u32x4 uq = *(const u32x4*)up; u32x4 o;
#pragma unroll
        for (int k = 0; k < 4; ++k) o[k] = pk2(bflo(uq[k]) * a[2 * k], bfhi(uq[k]) * a[2 * k + 1]);
        *(u32x4*)up = o; }
}

constexpr int Q_SATT = 0, Q_PATT = 512, Q_SGP = 1024, Q_SGS = 2048, Q_SSCAN = 2064, Q_END = 2064 + 2048;

template <int PH, bool DUMMY = false> __device__ __forceinline__ void run_phase(const Params& p, LAS unsigned char* lds) {
    unsigned char* ws = p.ws; const int G = gridDim.x, bid = blockIdx.x;
    if constexpr (PH == 0) phase0(p, lds);
    else if constexpr (PH == 1) {
        { pg8::Gemm g{(const bf16_t*)(ws + WS_HMB), (const bf16_t*)(ws + WS_WTMKV), 2048, 2048, 1024}; pg8::StaticOrder S; S.init(2048, 2048, G, (bid + 64) % G);
          EpiMem E{p.out, (bf16_t*)(ws + WS_MKB), (bf16_t*)(ws + WS_MVT)}; pg8::gemm_phase<EpiMem, pg8::StaticOrder, false>(lds, g, S, E, nullptr); }
        __syncthreads();
        { pg8::Gemm g{(const bf16_t*)(ws + WS_HB), (const bf16_t*)(ws + WS_WTIN), MT, PIN, 1024}; pg8::StaticOrder S; S.init(MT, PIN, G, bid);
          EpiZ E{(bf16_t*)(ws + WS_Y3), (bf16_t*)(ws + WS_GV), (bf16_t*)(ws + WS_SZ), (bf16_t*)(ws + WS_Y3) + (size_t)2 * MT * 1024, (bf16_t*)(ws + WS_GT), p.out};
          pg8::gemm_phase<EpiZ, pg8::StaticOrder, false>(lds, g, S, E, nullptr); }
    }
    else if constexpr (PH == 2) { const int wid = threadIdx.x >> 6, lane = threadIdx.x & 63; for (int m = wid * G + bid; m < MT; m += 24 * G) { const int mr[3] = {m, m + 8 * G, m + 16 * G}; p2_rows<3, DUMMY>(p, mr, lane); } }
    else if constexpr (PH == 11) { int kk = 256; asm volatile("" : "+s"(kk));
        pg8::Gemm g{(const bf16_t*)(ws + WS_XL), (const bf16_t*)(ws + WS_WTLORA), MP, 3072, kk}; pg8::StaticOrder S; S.init(MP, 3072, G, bid);
        EpiLora E{(bf16_t*)(ws + WS_E), (bf16_t*)(ws + WS_AV), (bf16_t*)(ws + WS_GG), p.in[I_W0], p.in[I_A0]}; pg8::gemm_phase<EpiLora, pg8::StaticOrder, false>(lds, g, S, E, nullptr);
        bf16_t* Eb = (bf16_t*)(ws + WS_E); const float* w0 = p.in[I_W0]; const float* a0 = p.in[I_A0];
        thin_gemm<1>(lds, (const bf16_t*)(ws + WS_XL), 0, (const bf16_t*)(ws + WS_WTLORA), 0, 1, 3072, kk,
            [&](int, const f32x4 (&acc)[4], f32x4 (&tot)[4], int, int) {
#pragma unroll
                for (int j = 0; j < 4; ++j) tot[j] = acc[j]; },
            [&](const f32x4 (&tot)[4], int row, int col) { const int seg = col >> 10;
#pragma unroll
                for (int j = 0; j < 4; ++j) { const int cc = (col & 1023) + 16 * j; f32x4 v = tot[j];
                    if (seg == 0) { const f32x4 bq = *(const f32x4*)(w0 + cc);
#pragma unroll
                        for (int q = 0; q < 4; ++q) v[q] = 0.60653066f * sigmoidf_(v[q] + bq[q]); }
                    else if (seg == 1) { const f32x4 bq = *(const f32x4*)(a0 + cc);
#pragma unroll
                        for (int q = 0; q < 4; ++q) v[q] = sigmoidf_(v[q] + bq[q]); }
                    u32x2 w; w[0] = pk2(v[0], v[1]); w[1] = pk2(v[2], v[3]); *(u32x2*)(Eb + (size_t)seg * 17301504 + (size_t)row * 1024 + cc) = w; } }); }
    else if constexpr (PH == 3 || PH == 10) {
#ifndef P3SPLIT
#define P3SPLIT 0
#endif
#ifndef P3SUB
#define P3SUB 31
#endif
        constexpr int SUB = DUMMY ? P3SUB : 31;
        constexpr bool DO_SCAN = (PH == 3), DO_REST = P3SPLIT ? (PH == 10) : (PH == 3);
        if (DO_SCAN && !DUMMY && bid >= 128) {
#pragma unroll 1
            for (int it = 2368 + (bid - 128); it < 5440; it += G - 128) tr_late(p, lds, it); }
        if (DO_SCAN && (SUB & 1) && bid < 128) { const int b = bid >> 4, h = bid & 15; scan_head(p, lds, b * 2048, 2048, h, nullptr, p.out + O_PWKV + (size_t)bid * 4096, nullptr); }
        unsigned* ctr = (unsigned*)(ws + WS_CTL) + (PH == 10 ? 1 : 0) + (DUMMY ? 2 : 0); LAS unsigned* qw = (LAS unsigned*)(lds + QW_OFF);
        const int q_lo = DO_REST ? 0 : Q_SSCAN, q_hi = DO_SCAN ? Q_END : Q_SSCAN;
        unsigned nxt = 0; if (threadIdx.x == 0) nxt = atomicAdd(ctr, 1u);
        for (;;) {
            __syncthreads();
            if (threadIdx.x == 0) { *qw = nxt; nxt = atomicAdd(ctr, 1u); }
            __syncthreads();
            const int it = (int)*qw + q_lo; if (it >= q_hi) break;
            if (it < Q_PATT) { if (SUB & 2) attn_sample_item<DUMMY>(p, lds, it); }
            else if (it < Q_SGP) { if (SUB & 4) attn_prompt_item<DUMMY>(p, lds, it - Q_PATT); }
            else if (it < Q_SGS) { if (SUB & 8) sg_prompt_item<DUMMY>(p, lds, it - Q_SGP); }
            else if (it < Q_SSCAN) { if (!DUMMY) sg_sample_item(p, it - Q_SGS); }
            else if (SUB & 16) { const int bh = it - Q_SSCAN, b = bh >> 4, h = bh & 15;
                scan_head(p, lds, MP + b * 4, 4, h, p.in[I_SWKV] + (size_t)bh * 4096, p.out + O_SWKV + (size_t)bh * 4096, p.in[I_SSH] + (size_t)b * PSH); }
        }
    }
    else if constexpr (PH == 4) { pg8::Gemm g{(const bf16_t*)(ws + WS_Y3), (const bf16_t*)(ws + WS_WTBR), 3 * MT, 3072, 1024}; BranchOrder S{G, bid};
        EpiMerge E{(const bf16_t*)(ws + WS_GT), (float*)(ws + WS_MF), (bf16_t*)(ws + WS_MB)}; pg8::gemm_phase<EpiMerge, BranchOrder, false>(lds, g, S, E, nullptr);
        const bf16_t* GT = (const bf16_t*)(ws + WS_GT); bf16_t* MB = (bf16_t*)(ws + WS_MB);
        thin_gemm<4>(lds, (const bf16_t*)(ws + WS_Y3), (size_t)MT * 1024, (const bf16_t*)(ws + WS_WTBR), (size_t)1048576, 3, 1024, 1024,
            [&](int n, const f32x4 (&acc)[4], f32x4 (&tot)[4], int row, int col) {
#pragma unroll
                for (int j = 0; j < 4; ++j) { float gf[4]; unpack4(*(const u32x2*)(GT + (size_t)row * 3072 + n * 1024 + col + 16 * j), gf);
                    tot[j][0] += acc[j][0] * gf[0]; tot[j][1] += acc[j][1] * gf[1]; tot[j][2] += acc[j][2] * gf[2]; tot[j][3] += acc[j][3] * gf[3]; } },
            [&](const f32x4 (&tot)[4], int row, int col) {
#pragma unroll
                for (int j = 0; j < 4; ++j) { u32x2 w; w[0] = pk2(tot[j][0], tot[j][1]); w[1] = pk2(tot[j][2], tot[j][3]); *(u32x2*)(MB + (size_t)row * 1024 + col + 16 * j) = w; } }); }
    else if constexpr (PH == 5) { pg8::Gemm g{(const bf16_t*)(ws + WS_MB), (const bf16_t*)(ws + WS_WTOUT), MP, 1024, 1024}; pg8::StaticOrder S; S.init(MP, 1024, G, bid);
        EpiRes E{p.in[I_XP], p.in[I_XS], (float*)(ws + WS_X1), (bf16_t*)(ws + WS_X1B), (float*)(ws + (DUMMY ? WS_XL : WS_SSQ1))}; pg8::gemm_phase<EpiRes, pg8::StaticOrder, false>(lds, g, S, E, nullptr);
        const float* xs = p.in[I_XS]; float* X1 = (float*)(ws + WS_X1); bf16_t* X1B = (bf16_t*)(ws + WS_X1B); float* ssq = (float*)(ws + (DUMMY ? WS_XL : WS_SSQ1));
        thin_gemm<4>(lds, (const bf16_t*)(ws + WS_MB), 0, (const bf16_t*)(ws + WS_WTOUT), 0, 1, 1024, 1024,
            [&](int, const f32x4 (&acc)[4], f32x4 (&tot)[4], int, int) {
#pragma unroll
                for (int j = 0; j < 4; ++j) tot[j] = acc[j]; },
            [&](const f32x4 (&tot)[4], int row, int col) { float ss = 0.f;
#pragma unroll
                for (int j = 0; j < 4; ++j) { const f32x4 v = tot[j] + *(const f32x4*)(xs + (size_t)(row - MP) * 1024 + col + 16 * j); *(f32x4*)(X1 + (size_t)row * 1024 + col + 16 * j) = v;
                    u32x2 w; w[0] = pk2(v[0], v[1]); w[1] = pk2(v[2], v[3]); *(u32x2*)(X1B + (size_t)row * 1024 + col + 16 * j) = w; ss += v[0] * v[0] + v[1] * v[1] + v[2] * v[2] + v[3] * v[3]; }
                ss += __shfl_xor(ss, 16); ss += __shfl_xor(ss, 32); if ((threadIdx.x & 63) < 16) atomicAdd(ssq + row, ss); }); }
    else if constexpr (PH == 6) { pg8::Gemm g{(const bf16_t*)(ws + WS_X1B), (const bf16_t*)(ws + WS_WTUP), MP, DFF, 1024}; pg8::StaticOrder S; S.init(MP, DFF, G, bid);
        EpiUp E{(const float*)(ws + WS_SSQ1), (bf16_t*)(ws + WS_HID)}; pg8::gemm_phase<EpiUp, pg8::StaticOrder, false>(lds, g, S, E, nullptr);
        const float* ssq = (const float*)(ws + WS_SSQ1); bf16_t* H = (bf16_t*)(ws + WS_HID);
        thin_gemm<1>(lds, (const bf16_t*)(ws + WS_X1B), 0, (const bf16_t*)(ws + WS_WTUP), 0, 1, DFF, 1024,
            [&](int, const f32x4 (&acc)[4], f32x4 (&tot)[4], int, int) {
#pragma unroll
                for (int j = 0; j < 4; ++j) tot[j] = acc[j]; },
            [&](const f32x4 (&tot)[4], int row, int col) { const float rs = rsqrtf(ssq[row] * (1.f / 1024.f) + 1e-6f);
#pragma unroll
                for (int j = 0; j < 4; ++j) { float h[4];
#pragma unroll
                    for (int q = 0; q < 4; ++q) { const float a = fmaxf(tot[j][q] * rs, 0.f); h[q] = a * a; }
                    u32x2 w; w[0] = pk2(h[0], h[1]); w[1] = pk2(h[2], h[3]); *(u32x2*)(H + (size_t)row * DFF + col + 16 * j) = w; } }); }
    else if constexpr (PH == 7) { pg8::Gemm g{(const bf16_t*)(ws + WS_HID), (const bf16_t*)(ws + WS_WTDN), MP, 1024, DFF}; pg8::StaticOrder S; S.init(MP, 1024, G, bid);
        const float* x1 = (const float*)(ws + WS_X1);
        EpiRes E{x1, x1 + (size_t)MP * 1024, (float*)(ws + WS_X2), nullptr, (float*)(ws + (DUMMY ? WS_XL : WS_SSQ2))}; pg8::gemm_phase<EpiRes, pg8::StaticOrder, false>(lds, g, S, E, nullptr);
        float* X2 = (float*)(ws + WS_X2); float* ssq = (float*)(ws + (DUMMY ? WS_XL : WS_SSQ2));
        thin_gemm<4>(lds, (const bf16_t*)(ws + WS_HID), 0, (const bf16_t*)(ws + WS_WTDN), 0, 1, 1024, DFF,
            [&](int, const f32x4 (&acc)[4], f32x4 (&tot)[4], int, int) {
#pragma unroll
                for (int j = 0; j < 4; ++j) tot[j] = acc[j]; },
            [&](const f32x4 (&tot)[4], int row, int col) { float ss = 0.f;
#pragma unroll
                for (int j = 0; j < 4; ++j) { const f32x4 v = tot[j] + *(const f32x4*)(x1 + (size_t)row * 1024 + col + 16 * j); *(f32x4*)(X2 + (size_t)row * 1024 + col + 16 * j) = v;
                    ss += v[0] * v[0] + v[1] * v[1] + v[2] * v[2] + v[3] * v[3]; }
                ss += __shfl_xor(ss, 16); ss += __shfl_xor(ss, 32); if ((threadIdx.x & 63) < 16) atomicAdd(ssq + row, ss); }); }
    else if constexpr (PH == 8) { const float* x2 = (const float*)(ws + WS_X2); const float* ssq = (const float*)(ws + WS_SSQ2); const float* gf = p.in[I_NFG];
        const int wid = threadIdx.x >> 6, lane = threadIdx.x & 63;
        f32x4 g[4];
#pragma unroll
        for (int c = 0; c < 4; ++c) g[c] = *(const f32x4*)(gf + c * 256 + lane * 4);
        for (int r0 = wid * G + bid; r0 < MT; r0 += 24 * G) {
            f32x4 v[3][4]; float rs[3];
#pragma unroll
            for (int i = 0; i < 3; ++i) { const int r = r0 + i * 8 * G; if (r < MT) { rs[i] = ssq[r];
#pragma unroll
                for (int c = 0; c < 4; ++c) v[i][c] = *(const f32x4*)(x2 + (size_t)r * 1024 + c * 256 + lane * 4); } }
#pragma unroll
            for (int i = 0; i < 3; ++i) { const int r = r0 + i * 8 * G; if (r < MT) { const float s = rsqrtf(rs[i] * (1.f / 1024.f) + 1e-6f);
#pragma unroll
                for (int c = 0; c < 4; ++c) *(f32x4*)(p.out + (size_t)r * 1024 + c * 256 + lane * 4) = v[i][c] * s * g[c]; } } } }
}
#ifdef DIAG_PHASES
template <int PH> __global__ __launch_bounds__(512, 2) void diag_phase(Params p) {
    extern __shared__ __attribute__((aligned(16))) unsigned char shm[];
    run_phase<PH>(p, (LAS unsigned char*)shm);
}
template __global__ void diag_phase<0>(Params); template __global__ void diag_phase<1>(Params); template __global__ void diag_phase<2>(Params);
template __global__ void diag_phase<3>(Params); template __global__ void diag_phase<4>(Params); template __global__ void diag_phase<5>(Params);
template __global__ void diag_phase<6>(Params); template __global__ void diag_phase<7>(Params); template __global__ void diag_phase<8>(Params);
#endif
template <int PH, bool DUMMY = false> __device__ __forceinline__ void phase_step(int ph_lo, int ph_hi, LAS unsigned char* lds, cg::grid_group& grid, unsigned& nbar) {
    constexpr int PE = (PH == 10) ? 3 : (PH == 11 ? 2 : PH);
    if (ph_lo <= PE && PE < ph_hi) {
        if (PH > ph_lo) {
            asm volatile("s_waitcnt vmcnt(0)" ::: "memory");
            __syncthreads();
            ++nbar;
            if (threadIdx.x == 0) {
                const __attribute__((address_space(4))) Params* pq = (const __attribute__((address_space(4))) Params*)__builtin_amdgcn_kernarg_segment_ptr();
                __attribute__((address_space(1))) unsigned char* wsb = (__attribute__((address_space(1))) unsigned char*)pq->ws;
                if (nbar == 1) {
                    __attribute__((address_space(1))) unsigned* bar = (__attribute__((address_space(1))) unsigned*)(wsb + WS_CTL + 128);
                    __builtin_amdgcn_fence(__ATOMIC_RELEASE, "agent"); asm volatile("s_waitcnt vmcnt(0)" ::: "memory");
                    __hip_atomic_fetch_add(bar, 1u, __ATOMIC_RELAXED, __HIP_MEMORY_SCOPE_AGENT);
                    while (__hip_atomic_load(bar, __ATOMIC_RELAXED, __HIP_MEMORY_SCOPE_AGENT) < gridDim.x) __builtin_amdgcn_s_sleep(2);
                    __builtin_amdgcn_fence(__ATOMIC_ACQUIRE, "agent"); asm volatile("s_waitcnt vmcnt(0)" ::: "memory");
                } else {
                    __attribute__((address_space(1))) unsigned* c2 = (__attribute__((address_space(1))) unsigned*)(wsb + WS_CTL2);
                    const unsigned xcc = (unsigned)__builtin_amdgcn_s_getreg((3 << 11) | 20) & 0xFu;
                    const unsigned nx = __hip_atomic_load(c2 + 1024 + xcc, __ATOMIC_RELAXED, __HIP_MEMORY_SCOPE_AGENT);
                    unsigned nxcc = 0;
                    for (int j = 0; j < 16; ++j) nxcc += __hip_atomic_load(c2 + 1024 + j, __ATOMIC_RELAXED, __HIP_MEMORY_SCOPE_AGENT) != 0u;
                    const unsigned k = nbar - 1;
                    const unsigned old = __hip_atomic_fetch_add(c2 + 64 * xcc, 1u, __ATOMIC_RELAXED, __HIP_MEMORY_SCOPE_AGENT);
                    if (old + 1 == k * nx) {
                        __builtin_amdgcn_fence(__ATOMIC_RELEASE, "agent"); asm volatile("s_waitcnt vmcnt(0)" ::: "memory");
                        const unsigned t = __hip_atomic_fetch_add(c2 + 1088, 1u, __ATOMIC_RELAXED, __HIP_MEMORY_SCOPE_AGENT);
                        if (t + 1 == k * nxcc) __hip_atomic_store(c2 + 1152, k, __ATOMIC_RELAXED, __HIP_MEMORY_SCOPE_AGENT);
                    }
                    while (__hip_atomic_load(c2 + 1152, __ATOMIC_RELAXED, __HIP_MEMORY_SCOPE_AGENT) < k) __builtin_amdgcn_s_sleep(1);
                    __builtin_amdgcn_fence(__ATOMIC_ACQUIRE, "agent"); asm volatile("s_waitcnt vmcnt(0)" ::: "memory");
                }
            }
            __syncthreads();
        }
        const __attribute__((address_space(4))) Params* pp = (const __attribute__((address_space(4))) Params*)__builtin_amdgcn_kernarg_segment_ptr();
        asm volatile("" : "+s"(pp) :: "memory");
        Params p;
#pragma unroll
        for (int i = 0; i < 33; ++i) p.in[i] = (const float*)(__attribute__((address_space(1))) const float*)pp->in[i];
        p.out = (float*)(__attribute__((address_space(1))) float*)pp->out; p.ws = (unsigned char*)(__attribute__((address_space(1))) unsigned char*)pp->ws;
        run_phase<PH, DUMMY>(p, lds);
    }
}
template <> __device__ __forceinline__ void run_phase<9, false>(const Params& p, LAS unsigned char* lds) {
    unsigned char* ws = p.ws; const int G = gridDim.x, bid = blockIdx.x; const int wid = threadIdx.x >> 6, lane = threadIdx.x & 63;
    for (int r = bid * 8 + wid; r < MT; r += G * 8) {
#pragma unroll
        for (int c = 0; c < 4; ++c) { const int col = c * 256 + lane * 4; f32x4 o;
#if DBG == 1
            const bf16_t* y3 = (const bf16_t*)(ws + WS_Y3); float a[4], b[4], d[4];
            unpack4(*(const u32x2*)(y3 + (size_t)r * 1024 + col), a); unpack4(*(const u32x2*)(y3 + (size_t)(MT + r) * 1024 + col), b); unpack4(*(const u32x2*)(y3 + (size_t)(2 * MT + r) * 1024 + col), d);
            for (int q = 0; q < 4; ++q) o[q] = a[q] + 2.f * b[q] + 4.f * d[q];
#elif DBG == 2
            float a[4]; unpack4(*(const u32x2*)((const bf16_t*)(ws + WS_MB) + (size_t)r * 1024 + col), a); for (int q = 0; q < 4; ++q) o[q] = a[q];
#elif DBG == 3
            o = *(const f32x4*)((const float*)(ws + WS_X1) + (size_t)r * 1024 + col);
#elif DBG == 4
            float a[4], b[4]; unpack4(*(const u32x2*)((const bf16_t*)(ws + WS_HID) + (size_t)r * DFF + col), a); unpack4(*(const u32x2*)((const bf16_t*)(ws + WS_HID) + (size_t)r * DFF + 2048 + col), b); for (int q = 0; q < 4; ++q) o[q] = a[q] + b[q];
#elif DBG == 5
            const bf16_t* y3 = (const bf16_t*)(ws + WS_Y3) + (size_t)(DBGSEL * MT + r) * 1024 + col; float a[4]; unpack4(*(const u32x2*)y3, a); for (int q = 0; q < 4; ++q) o[q] = a[q];
#else
            o = (f32x4){0.f, 0.f, 0.f, 0.f};
#endif
            *(f32x4*)(p.out + (size_t)r * 1024 + col) = o; } }
}
__global__ __launch_bounds__(512, 2) void mega(Params p, int ph_lo, int ph_hi) {
    extern __shared__ __attribute__((aligned(16))) unsigned char shm[];
    LAS unsigned char* lds = (LAS unsigned char*)shm;
    cg::grid_group grid = cg::this_grid();
#ifndef DUP
#define DUP -1
#endif
    unsigned nbar = 0;
    { const __attribute__((address_space(4))) Params* pq = (const __attribute__((address_space(4))) Params*)__builtin_amdgcn_kernarg_segment_ptr();
      __attribute__((address_space(1))) unsigned char* wsb = (__attribute__((address_space(1))) unsigned char*)pq->ws;
      if (ph_lo < 0) grid.sync();
      if (threadIdx.x == 0) { const unsigned xcc = (unsigned)__builtin_amdgcn_s_getreg((3 << 11) | 20) & 0xFu;
          __hip_atomic_fetch_add((__attribute__((address_space(1))) unsigned*)(wsb + WS_CTL2) + 1024 + xcc, 1u, __ATOMIC_RELAXED, __HIP_MEMORY_SCOPE_AGENT); } }
#define PSTEP(k) if (DUP == k) phase_step<k, true>(ph_lo, ph_hi, lds, grid, nbar); phase_step<k, false>(ph_lo, ph_hi, lds, grid, nbar);
    PSTEP(0) PSTEP(1) PSTEP(2) PSTEP(11) PSTEP(3)
#if P3SPLIT
    PSTEP(10)
#endif
    PSTEP(4) PSTEP(5) PSTEP(6) PSTEP(7) PSTEP(8)
#if DBG
    phase_step<9>(ph_lo, 10, lds, grid, nbar);
#endif
}

extern "C" void kernel_launch(void* const* d_in, const int* in_sizes, int n_in, void* d_out, int out_size, void* d_ws, size_t ws_size, hipStream_t stream) {
    static int grid_blocks = 0;
    if (grid_blocks == 0) {
        if (n_in != 33 || out_size != (int)O_END || ws_size < WS_END) { fprintf(stderr, "kernel_launch: unexpected shapes (n_in %d out %d ws %zu, need ws %zu)\n", n_in, out_size, ws_size, (size_t)WS_END); grid_blocks = -1; return; }
        int dev = 0, cus = 0, per_cu = 0;
        hipGetDevice(&dev); hipDeviceGetAttribute(&cus, hipDeviceAttributeMultiprocessorCount, dev);
        hipFuncSetAttribute((const void*)mega, hipFuncAttributeMaxDynamicSharedMemorySize, LDS_BYTES);
        hipOccupancyMaxActiveBlocksPerMultiprocessor(&per_cu, (const void*)mega, 512, LDS_BYTES);
        if (per_cu < 1) { fprintf(stderr, "kernel_launch: occupancy query says %d blocks per CU\n", per_cu); grid_blocks = -1; return; }
        grid_blocks = cus * 1;
        if (grid_blocks < 128) { fprintf(stderr, "kernel_launch: needs >= 128 CUs\n"); grid_blocks = -1; return; }
    }
    if (grid_blocks < 0) return;
    hipMemsetAsync((char*)d_ws + WS_CTL, 0, WS_WTIN - WS_CTL, stream);
    Params p{};
    for (int i = 0; i < 33; ++i) p.in[i] = (const float*)d_in[i];
    p.out = (float*)d_out; p.ws = (unsigned char*)d_ws;
#if DBG
    int lo = 0, hi = DBG_HI;
#else
    int lo = 0, hi = 9;
#endif
    void* args[] = {&p, &lo, &hi};
    hipError_t e = hipLaunchCooperativeKernel((const void*)mega, dim3(grid_blocks), dim3(512), args, LDS_BYTES, stream);
    if (e != hipSuccess) fprintf(stderr, "cooperative launch failed: %s (grid %d)\n", hipGetErrorString(e), grid_blocks);
}
```

```cpp
#include <hip/hip_runtime.h>
#include <hip/hip_cooperative_groups.h>
#include <cstdio>
namespace cg = cooperative_groups;
namespace pg8 {
#define PG8_LAS __attribute__((address_space(3)))
typedef unsigned short bf16_t;
typedef short bf16x8 __attribute__((ext_vector_type(8)));
typedef float f32x4 __attribute__((ext_vector_type(4)));
typedef unsigned u32x4 __attribute__((ext_vector_type(4)));
constexpr int BM = 256, BK = 64, HALF = 128, HTB = HALF * BK * 2  , STAGE_BYTES = 8 * HTB, NXCD = 8, WGM = 8;

__host__ __device__ __forceinline__ int lds_byte(int r, int c) { const int st = (r >> 4) * 2 + (c >> 5), rr = r & 15, cc = c & 31, ob = rr * 64 + cc * 2; return st * 1024 + (ob ^ (((ob >> 9) & 1) << 5)); }
__host__ __device__ __forceinline__ void stage_rc(int b, int& R, int& C) { const int st = b / 1024, sb = b % 1024, swz = sb ^ (((sb >> 9) & 1) << 5); R = (st >> 1) * 16 + swz / 64; C = (st & 1) * 32 + (swz % 64) / 2; }
__host__ __device__ __forceinline__ int perm32(int rho) { const int n = rho >> 4, i = rho & 15; return 8 * (i >> 2) + 4 * n + (i & 3); }

struct Unit { int pm, pn; };
struct Gemm { const bf16_t* A; const bf16_t* Bt; int M, N, K; };

struct StaticOrder {
    int nM, nN, nwg, G, c;
    __host__ __device__ void init(int M, int N, int G_, int c_) { nM = M / BM; nN = N / BM; nwg = nM * nN; G = G_; c = c_; }
    __host__ __device__ bool next(int i, Unit& u) const {
        const long L = (long)i * G + c; if (L >= nwg) return false;
        int wgid = (int)L; { const int q = nwg / NXCD, r = nwg % NXCD, xcd = wgid % NXCD, off = wgid / NXCD; wgid = (xcd < r ? xcd * (q + 1) : r * (q + 1) + (xcd - r) * q) + off; }
        const int nig = WGM * nN, gid = wgid / nig, fm = gid * WGM, gsz = (nM - fm) < WGM ? (nM - fm) : WGM;
        u.pm = fm + ((wgid % nig) % gsz); u.pn = (wgid % nig) / gsz; return true;
    }
    __device__ __forceinline__ void a_ready(const Unit&) const {}
    __device__ __forceinline__ void done(const Unit&) const {}
};
__device__ __forceinline__ unsigned cvt_pk_bf16(float lo, float hi) { unsigned r; asm volatile("v_cvt_pk_bf16_f32 %0, %1, %2" : "=v"(r) : "v"(lo), "v"(hi)); return r; }
template <class Epi, class Sched, bool STAMP = false>
__device__ __forceinline__ void gemm_phase(PG8_LAS unsigned char* lds, const Gemm g, const Sched& S, const Epi& E, unsigned long long* stamps) {
    const int tid = threadIdx.x, wid = __builtin_amdgcn_readfirstlane(tid >> 6), lane = tid & 63, wr = wid >> 2, wc = wid & 3, fr = lane & 15, fq = lane >> 4;
    const int K = g.K, nt = K / BK;
    int ts_lo = 0, ts_hi = 0, nts = 0; const unsigned long long rt_entry = STAMP ? (unsigned long long)wall_clock64() : 0ull;
#define PG8_STAMP() do { if (STAMP && wid == 0 && nts < 64) { const unsigned long long _c = (unsigned long long)clock64(); \
        ts_lo = (lane == nts) ? (int)(unsigned)_c : ts_lo; ts_hi = (lane == nts) ? (int)(unsigned)(_c >> 32) : ts_hi; ++nts; } } while (0)
    PG8_STAMP();
    unsigned voffA[2], voffB[2];
#pragma unroll
    for (int i = 0; i < 2; ++i) { int R, C; stage_rc(tid * 16 + i * 8192, R, C); const int Rb = Epi::PERM ? ((R & ~31) + perm32(R & 31)) : R;
        voffA[i] = (unsigned)(R * K + C) * 2u; voffB[i] = (unsigned)(Rb * K + C) * 2u; }
    const size_t kstep = (size_t)(BK * 2);
    const size_t hstep = (size_t)HALF * K * 2;
    const size_t tstep = 2 * hstep;
    const unsigned ldsw = (unsigned)wid * 1024u;
    const int aoff = lds_byte(wr * 64 + fr, fq * 8), boff = lds_byte(wc * 32 + fr, fq * 8);
#define PG8_SA(b, h) (((b) * 2 + (h)) * HTB)
#define PG8_SB(b, h) ((4 + (b) * 2 + (h)) * HTB)
#define PG8_STAGE(bufoff, gbase, voff) do { _Pragma("unroll") for (int _i = 0; _i < 2; ++_i) \
        __builtin_amdgcn_global_load_lds((const unsigned*)((const char*)(gbase) + (voff)[_i]), (PG8_LAS unsigned*)(lds + (bufoff) + ldsw + _i * 8192), 16, 0, 0); } while (0)
#define PG8_LDA(dst, b, h) do { _Pragma("unroll") for (int m = 0; m < 4; ++m) _Pragma("unroll") for (int k = 0; k < 2; ++k) dst[m][k] = *(const PG8_LAS bf16x8*)(lds + PG8_SA(b, h) + aoff + m * 2048 + k * 1024); } while (0)
#define PG8_LDB(dst, b, h) do { _Pragma("unroll") for (int n = 0; n < 2; ++n) _Pragma("unroll") for (int k = 0; k < 2; ++k) dst[n][k] = *(const PG8_LAS bf16x8*)(lds + PG8_SB(b, h) + boff + n * 2048 + k * 1024); } while (0)
#define PG8_MMA(ai, bj, At, Bt) do { __builtin_amdgcn_s_setprio(1); _Pragma("unroll") for (int m = 0; m < 4; ++m) _Pragma("unroll") for (int n = 0; n < 2; ++n) _Pragma("unroll") for (int k = 0; k < 2; ++k) \
        acc[ai][bj][m][n] = __builtin_amdgcn_mfma_f32_16x16x32_bf16(Bt[n][k], At[m][k], acc[ai][bj][m][n], 0, 0, 0); __builtin_amdgcn_s_setprio(0); } while (0)
#define PG8_WAIT_V(n) asm volatile("s_waitcnt vmcnt(" #n ")" ::: "memory")
#define PG8_WAIT_L(n) asm volatile("s_waitcnt lgkmcnt(" #n ")" ::: "memory")
#define PG8_BAR __builtin_amdgcn_s_barrier()
#define PG8_SCHED __builtin_amdgcn_sched_barrier(0)
    Unit cur, nxt; int ui = 0;
    if (!S.next(0, cur)) return;
    f32x4 acc[2][2][4][2];
#pragma unroll
    for (int a = 0; a < 2; ++a)
#pragma unroll
        for (int b = 0; b < 2; ++b)
#pragma unroll
            for (int m = 0; m < 4; ++m)
#pragma unroll
                for (int n = 0; n < 2; ++n) acc[a][b][m][n] = (f32x4){0.f, 0.f, 0.f, 0.f};
    bf16x8 At[4][2], B0[2][2], B1[2][2];
    const char* cA = (const char*)g.A + (size_t)cur.pm * tstep; const char* cB = (const char*)g.Bt + (size_t)cur.pn * tstep;
    S.a_ready(cur);
    PG8_STAGE(PG8_SB(0, 0), cB, voffB); PG8_STAGE(PG8_SA(0, 0), cA, voffA); PG8_STAGE(PG8_SB(0, 1), cB + hstep, voffB); PG8_STAGE(PG8_SA(0, 1), cA + hstep, voffA);
    if (wr == 1) PG8_BAR;
    PG8_WAIT_V(4); PG8_BAR;
    PG8_STAGE(PG8_SB(1, 0), cB + kstep, voffB); PG8_STAGE(PG8_SA(1, 0), cA + kstep, voffA); PG8_STAGE(PG8_SB(1, 1), cB + hstep + kstep, voffB);
    PG8_WAIT_V(6); PG8_BAR;
    PG8_STAMP();
    for (;;) {
        const bool has_next = S.next(ui + 1, nxt);
        const char* nA = has_next ? (const char*)g.A + (size_t)nxt.pm * tstep : cA; const char* nB = has_next ? (const char*)g.Bt + (size_t)nxt.pn * tstep : cB;
        for (int t = 0; t < nt; t += 2) {
            const bool last = (t == nt - 2);
            const char* a1 = cA + (size_t)(t + 1) * kstep;
            const char* a2 = last ? nA : cA + (size_t)(t + 2) * kstep; const char* b2 = last ? nB : cB + (size_t)(t + 2) * kstep;
            const char* a3 = a2 + kstep; const char* b3 = b2 + kstep;
            if (last && has_next) S.a_ready(nxt);
            PG8_LDB(B0, 0, 0); PG8_SCHED; PG8_LDA(At, 0, 0); PG8_STAGE(PG8_SA(1, 1), a1 + hstep, voffA);
            PG8_WAIT_L(8); PG8_BAR; PG8_WAIT_L(0); PG8_MMA(0, 0, At, B0); PG8_BAR; PG8_SCHED;
            PG8_LDB(B1, 0, 1); PG8_STAGE(PG8_SB(0, 0), b2, voffB);
            PG8_BAR; PG8_WAIT_L(0); PG8_MMA(0, 1, At, B1); PG8_BAR;
            PG8_LDA(At, 0, 1); PG8_STAGE(PG8_SA(0, 0), a2, voffA);
            PG8_BAR; PG8_WAIT_L(0); PG8_MMA(1, 0, At, B0); PG8_BAR; PG8_SCHED;
            PG8_STAGE(PG8_SB(0, 1), b2 + hstep, voffB);
            PG8_WAIT_V(6); PG8_BAR; PG8_MMA(1, 1, At, B1); PG8_BAR;
            PG8_LDB(B0, 1, 0); PG8_SCHED; PG8_LDA(At, 1, 0); PG8_STAGE(PG8_SA(0, 1), a2 + hstep, voffA);
            PG8_WAIT_L(8); PG8_BAR; PG8_WAIT_L(0); PG8_MMA(0, 0, At, B0); PG8_BAR; PG8_SCHED;
            PG8_LDB(B1, 1, 1); PG8_STAGE(PG8_SB(1, 0), b3, voffB);
            PG8_BAR; PG8_WAIT_L(0); PG8_MMA(0, 1, At, B1); PG8_BAR;
            PG8_LDA(At, 1, 1); PG8_STAGE(PG8_SA(1, 0), a3, voffA);
            PG8_BAR; PG8_WAIT_L(0); PG8_MMA(1, 0, At, B0); PG8_BAR; PG8_SCHED;
            PG8_STAGE(PG8_SB(1, 1), b3 + hstep, voffB);
            PG8_WAIT_V(6); PG8_BAR; PG8_MMA(1, 1, At, B1); PG8_BAR;
        }
        PG8_STAMP();
        if constexpr (!Epi::AFTER_DRAIN) { E(acc, cur, wr, wc, fr, fq); S.done(cur); }
        PG8_STAMP();
        if (!has_next) break;
#pragma unroll
        for (int a = 0; a < 2; ++a)
#pragma unroll
            for (int b = 0; b < 2; ++b)
#pragma unroll
                for (int m = 0; m < 4; ++m)
#pragma unroll
                    for (int n = 0; n < 2; ++n) acc[a][b][m][n] = (f32x4){0.f, 0.f, 0.f, 0.f};
        cur = nxt; cA = nA; cB = nB; ++ui;
    }
    PG8_WAIT_V(0);
    if (wr == 0) PG8_BAR;
    PG8_BAR;
    if constexpr (Epi::AFTER_DRAIN) { E.fused(acc, cur, wr, wc, fr, fq, lds, wid, lane); S.done(cur); }
    PG8_STAMP();
    if (STAMP && wid == 0) { stamps[lane] = lane < nts ? (((unsigned long long)(unsigned)ts_hi << 32) | (unsigned)ts_lo) : 0ull;
        if (lane == 62) stamps[62] = rt_entry; if (lane == 63) stamps[63] = (unsigned long long)wall_clock64(); }
#undef PG8_STAMP
#undef PG8_SA
#undef PG8_SB
#undef PG8_STAGE
#undef PG8_LDA
#undef PG8_LDB
#undef PG8_MMA
#undef PG8_WAIT_V
#undef PG8_WAIT_L
#undef PG8_BAR
#undef PG8_SCHED
}
}

using pg8::bf16_t; using pg8::bf16x8; using pg8::f32x4; using pg8::u32x4;
typedef unsigned u32x2 __attribute__((ext_vector_type(2)));
typedef float f32x2 __attribute__((ext_vector_type(2)));
#define LAS __attribute__((address_space(3)))
#ifndef DBG
#define DBG 0
#endif
#ifndef DBGSEL
#define DBGSEL 0
#endif

constexpr int MP = 16384, MS = 512, MT = 16896, DM = 1024, PIN = 9472, PSH = 3328, DFF = 4096;
constexpr int NPANEL = MT / 256;
constexpr size_t O_YP = 0, O_YS = 16777216, O_PSH = 17301504, O_PWKV = 17328128, O_PMK = 17852416, O_PMV = 19949568,
                 O_SSH = 22046720, O_SWKV = 22472704, O_SGV = 30861312, O_END = 31385600;
constexpr size_t WS_CTL = 0, WS_CTL2 = 256, WS_SSQ1 = 256 + 8192, WS_SSQ2 = WS_SSQ1 + 67584, WS_WTIN = WS_SSQ2 + 67584,
    WS_WTBR = WS_WTIN + 19398656, WS_WTOUT = WS_WTBR + 6291456, WS_WTUP = WS_WTOUT + 2097152, WS_WTDN = WS_WTUP + 8388608,
    WS_WTMKV = WS_WTDN + 8388608, WS_WTW2 = WS_WTMKV + 4194304, WS_WTA2 = WS_WTW2 + 131072, WS_WTG2 = WS_WTA2 + 131072,
    WS_SGW = WS_WTG2 + 262144, WS_HMB = WS_SGW + 262144, WS_MKB = WS_HMB + 4194304, WS_MVT = WS_MKB + 4194304,
    WS_Y3 = WS_MVT + 4194304, WS_GV = WS_Y3 + 103809024, WS_SZ = WS_GV + 34603008, WS_GT = WS_SZ + 112459776,
    WS_HB = WS_GT + 103809024, WS_AV = WS_HB + 34603008, WS_GG = WS_AV + 34603008, WS_XL = WS_GG + 34603008, WS_WTLORA = WS_XL + 8650752, WS_END = WS_WTLORA + 1572864;
constexpr size_t WS_MF = WS_SZ, WS_MB = WS_GV, WS_X1 = WS_GT, WS_X1B = WS_HB, WS_HID = WS_Y3, WS_X2 = WS_SZ, WS_E = WS_HB;
constexpr int LDS_BYTES = 131072 + 256;
constexpr int QW_OFF = 131072;

struct Params { const float* in[33]; float* out; unsigned char* ws; };

enum { I_XP = 0, I_XS, I_MEM, I_CK, I_CV, I_SSH, I_SWKV, I_N1G, I_WIN, I_MU, I_LNG, I_LNB, I_SGW, I_SGB, I_W0, I_WW2, I_A0, I_WA2,
       I_WG2, I_KK, I_KA, I_RK, I_LXG, I_LXB, I_MNG, I_WMK, I_WMV, I_WBR, I_WOUT, I_N2G, I_WUP, I_WDN, I_NFG };

__device__ __forceinline__ float bflo(unsigned u) { return __uint_as_float(u << 16); }
__device__ __forceinline__ float bfhi(unsigned u) { return __uint_as_float(u & 0xffff0000u); }
typedef __bf16 bf2_t __attribute__((ext_vector_type(2)));
__device__ __forceinline__ unsigned pk2(float lo, float hi) { const f32x2 v = {lo, hi}; const bf2_t b = __builtin_convertvector(v, bf2_t); return __builtin_bit_cast(unsigned, b); }
__device__ __forceinline__ float rcpf(float x) { return __builtin_amdgcn_rcpf(x); }
__device__ __forceinline__ float sigmoidf_(float x) { return rcpf(1.f + __expf(-x)); }
__device__ __forceinline__ float gelu_tanh(float x) { const float t = 1.5957691216f * (x + 0.044715f * x * x * x); return x * sigmoidf_(t); }
__device__ __forceinline__ float tanhf_(float x) { return 1.f - 2.f * rcpf(__expf(2.f * x) + 1.f); }
template <int CTRL> __device__ __forceinline__ float dpp_mov(float x) { return __int_as_float(__builtin_amdgcn_update_dpp(0, __float_as_int(x), CTRL, 0xF, 0xF, true)); }
__device__ __forceinline__ float red8(float x) { x += dpp_mov<0xB1>(x); x += dpp_mov<0x4E>(x); x += dpp_mov<0x141>(x); return x; }
__device__ __forceinline__ float red16(float x) { x = red8(x); x += dpp_mov<0x140>(x); return x; }
__device__ __forceinline__ float wave_sum(float x) { x = red16(x); x += __shfl_xor(x, 16); x += __shfl_xor(x, 32); return x; }
__device__ __forceinline__ float wave_max(float x) {
#pragma unroll
    for (int o = 1; o < 64; o <<= 1) x = fmaxf(x, __shfl_xor(x, o));
    return x; }
__device__ __forceinline__ f32x4 mfma16(bf16x8 a, bf16x8 b, f32x4 c) { return __builtin_amdgcn_mfma_f32_16x16x32_bf16(a, b, c, 0, 0, 0); }
__device__ __forceinline__ void unpack4(u32x2 q, float (&o)[4]) { o[0] = bflo(q[0]); o[1] = bfhi(q[0]); o[2] = bflo(q[1]); o[3] = bfhi(q[1]); }

struct TJob { const float* src; bf16_t* dst; const float* gain; int K, N, ldd; };
__device__ __forceinline__ void transpose_tile(const TJob& j, int tile, LAS float* t) {
    const int tid = threadIdx.x; const int tn = j.N >> 6; const int k0 = (tile / tn) << 6, n0 = (tile % tn) << 6;
#pragma unroll
    for (int pp = 0; pp < 2; ++pp) { const int r = (tid >> 4) + pp * 32, c = (tid & 15) * 4;
        const f32x4 v = *(const f32x4*)(j.src + (size_t)(k0 + r) * j.N + n0 + c); const float g = j.gain ? j.gain[k0 + r] : 1.f;
        t[r * 65 + c] = v[0] * g; t[r * 65 + c + 1] = v[1] * g; t[r * 65 + c + 2] = v[2] * g; t[r * 65 + c + 3] = v[3] * g; }
    __syncthreads();
    { const int n = tid >> 3, k8 = (tid & 7) * 8; u32x4 o;
#pragma unroll
      for (int q = 0; q < 4; ++q) o[q] = pk2(t[(k8 + 2 * q) * 65 + n], t[(k8 + 2 * q + 1) * 65 + n]);
      *(u32x4*)(j.dst + (size_t)(n0 + n) * j.ldd + k0 + k8) = o; }
    __syncthreads();
}
__device__ __forceinline__ void tr_one(const Params& p, LAS unsigned char* lds, int it) {
    unsigned char* ws = p.ws; TJob j; int base;
    if (it < 2368)      { j = {p.in[I_WIN], (bf16_t*)(ws + WS_WTIN), p.in[I_N1G], 1024, PIN, 1024}; base = 0; }
    else if (it < 3136) { const int n = (it - 2368) >> 8; j = {p.in[I_WBR] + (size_t)n * 1048576, (bf16_t*)(ws + WS_WTBR) + (size_t)n * 1048576, nullptr, 1024, 1024, 1024}; base = 2368 + n * 256; }
    else if (it < 3392) { j = {p.in[I_WOUT], (bf16_t*)(ws + WS_WTOUT), nullptr, 1024, 1024, 1024}; base = 3136; }
    else if (it < 4416) { j = {p.in[I_WUP], (bf16_t*)(ws + WS_WTUP), p.in[I_N2G], 1024, 4096, 1024}; base = 3392; }
    else if (it < 5440) { j = {p.in[I_WDN], (bf16_t*)(ws + WS_WTDN), nullptr, 4096, 1024, 4096}; base = 4416; }
    else if (it < 5696) { j = {p.in[I_WMK], (bf16_t*)(ws + WS_WTMKV), p.in[I_MNG], 1024, 1024, 1024}; base = 5440; }
    else if (it < 5952) { j = {p.in[I_WMV], (bf16_t*)(ws + WS_WTMKV) + 1048576, p.in[I_MNG], 1024, 1024, 1024}; base = 5696; }
    else if (it < 5968) { j = {p.in[I_WW2], (bf16_t*)(ws + WS_WTLORA), nullptr, 64, 1024, 256}; base = 5952; }
    else if (it < 5984) { j = {p.in[I_WA2], (bf16_t*)(ws + WS_WTLORA) + 1024 * 256 + 64, nullptr, 64, 1024, 256}; base = 5968; }
    else                { j = {p.in[I_WG2], (bf16_t*)(ws + WS_WTLORA) + 2048 * 256 + 128, nullptr, 128, 1024, 256}; base = 5984; }
    transpose_tile(j, it - base, (LAS float*)lds);
}
__device__ __forceinline__ void tr_late(const Params& p, LAS unsigned char* lds, int it) {
    unsigned char* ws = p.ws; TJob j; int base;
    if (it < 3392)      { const int n = (it - 2368) >> 8; j = {p.in[I_WBR] + (size_t)n * 1048576, (bf16_t*)(ws + WS_WTBR) + (size_t)n * 1048576, nullptr, 1024, 1024, 1024}; base = 2368 + n * 256; }
    else if (it < 4416) { j = {p.in[I_WUP], (bf16_t*)(ws + WS_WTUP), p.in[I_N2G], 1024, 4096, 1024}; base = 3392; }
    else                { j = {p.in[I_WDN], (bf16_t*)(ws + WS_WTDN), nullptr, 4096, 1024, 4096}; base = 4416; }
    if (it >= 3136 && it < 3392) { j = {p.in[I_WOUT], (bf16_t*)(ws + WS_WTOUT), nullptr, 1024, 1024, 1024}; base = 3136; }
    transpose_tile(j, it - base, (LAS float*)lds);
}
__device__ __forceinline__ void phase0(const Params& p, LAS unsigned char* lds) {
    const int tid = threadIdx.x, wid = tid >> 6, lane = tid & 63; unsigned char* ws = p.ws;
    for (int i = blockIdx.x; i < 2368 + 576; i += gridDim.x) tr_one(p, lds, i < 2368 ? i : i + 3072);
    for (int r = blockIdx.x * 8 + wid; r < MT + 2048; r += gridDim.x * 8) {
        const float* src; bf16_t* dst;
        if (r < MP) { src = p.in[I_XP] + (size_t)r * 1024; dst = (bf16_t*)(ws + WS_HB) + (size_t)r * 1024; }
        else if (r < MT) { src = p.in[I_XS] + (size_t)(r - MP) * 1024; dst = (bf16_t*)(ws + WS_HB) + (size_t)r * 1024; }
        else { src = p.in[I_MEM] + (size_t)(r - MT) * 1024; dst = (bf16_t*)(ws + WS_HMB) + (size_t)(r - MT) * 1024; }
        f32x4 v[4]; float ss = 0.f;
#pragma unroll
        for (int c = 0; c < 4; ++c) { v[c] = *(const f32x4*)(src + c * 256 + lane * 4); ss += v[c][0] * v[c][0] + v[c][1] * v[c][1] + v[c][2] * v[c][2] + v[c][3] * v[c][3]; }
        ss = wave_sum(ss); const float rs = rsqrtf(ss * (1.f / 1024.f) + 1e-6f);
#pragma unroll
        for (int c = 0; c < 4; ++c) { u32x2 o; o[0] = pk2(v[c][0] * rs, v[c][1] * rs); o[1] = pk2(v[c][2] * rs, v[c][3] * rs); *(u32x2*)(dst + c * 256 + lane * 4) = o; }
    }
    { bf16_t* wl = (bf16_t*)(ws + WS_WTLORA);
      for (int i = blockIdx.x * 512 + tid; i < 3072 * 32; i += gridDim.x * 512) { const int row = i >> 5, cc = (i & 31) * 8, blk = row >> 10;
          const bool used = (blk == 0 && cc < 64) || (blk == 1 && cc >= 64 && cc < 128) || (blk == 2 && cc >= 128);
          if (!used) *(u32x4*)(wl + (size_t)row * 256 + cc) = (u32x4){0u, 0u, 0u, 0u}; } }
    { const float* sg = p.in[I_SGW]; bf16_t* d = (bf16_t*)(ws + WS_SGW);
      for (int i = blockIdx.x * 512 + tid; i < 8 * 128 * 128; i += gridDim.x * 512) { const int t = (i >> 7) & 127, s = i & 127; d[i] = (bf16_t)(pk2(s <= t ? sg[i] : 0.f, 0.f) & 0xffffu); } }
}

struct EpiZ {
    static constexpr bool PERM = true, AFTER_DRAIN = false;
    bf16_t *U, *GVp, *SZp, *Qp, *GTp; float* out;
    __device__ __forceinline__ void operator()(const f32x4 (&acc)[2][2][4][2], const pg8::Unit& u, int wr, int wc, int fr, int fq) const {
        const int pn = u.pn; bf16_t* base; int ldc, colt, act;
        if (pn < 4) { base = U; ldc = 1024; colt = pn * 256; act = 1; }
        else if (pn < 8) { base = GVp; ldc = 1024; colt = (pn - 4) * 256; act = 1; }
        else if (pn < 21) { base = SZp; ldc = PSH; colt = (pn - 8) * 256; act = 0; }
        else if (pn < 25) { base = Qp; ldc = 1024; colt = (pn - 21) * 256; act = 3; }
        else { base = GTp; ldc = 3072; colt = (pn - 25) * 256; act = 2; }
        const int row0 = u.pm * 256 + wr * 64 + fr, col0 = colt + wc * 32 + 8 * fq;
#pragma unroll
        for (int ai = 0; ai < 2; ++ai)
#pragma unroll
            for (int m = 0; m < 4; ++m) { const int row = row0 + ai * 128 + m * 16; bf16_t* rowp = base + (size_t)row * ldc + col0;
#pragma unroll
                for (int bj = 0; bj < 2; ++bj) { f32x4 v0 = acc[ai][bj][m][0], v1 = acc[ai][bj][m][1];
                    if (act == 1) {
#pragma unroll
                        for (int q = 0; q < 4; ++q) { v0[q] = gelu_tanh(v0[q]); v1[q] = gelu_tanh(v1[q]); } }
                    else if (act == 2) {
#pragma unroll
                        for (int q = 0; q < 4; ++q) { v0[q] = sigmoidf_(v0[q]); v1[q] = sigmoidf_(v1[q]); } }
                    else if (act == 0) {
                        const bool lastp = row < MP ? ((row & 2047) == 2047) : (((row - MP) & 3) == 3);
                        if (lastp) { float* d = (row < MP ? out + O_PSH + (size_t)(row >> 11) * PSH : out + O_SSH + (size_t)((row - MP) >> 2) * PSH) + col0 + bj * 128;
                            *(f32x4*)d = v0; *(f32x4*)(d + 4) = v1; } }
                    u32x4 o; o[0] = pk2(v0[0], v0[1]); o[1] = pk2(v0[2], v0[3]); o[2] = pk2(v1[0], v1[1]); o[3] = pk2(v1[2], v1[3]);
                    __builtin_nontemporal_store(o, (u32x4*)(rowp + bj * 128)); } }
    }
};
struct EpiMem {
    static constexpr bool PERM = false, AFTER_DRAIN = false;
    float* out; bf16_t *MKB, *MVT;
    __device__ __forceinline__ void operator()(const f32x4 (&acc)[2][2][4][2], const pg8::Unit& u, int wr, int wc, int fr, int fq) const {
        const int row0 = u.pm * 256 + wr * 64 + fr, col0 = u.pn * 256 + wc * 32 + 4 * fq; const bool isv = u.pn >= 4;
#pragma unroll
        for (int ai = 0; ai < 2; ++ai)
#pragma unroll
            for (int m = 0; m < 4; ++m) { const int row = row0 + ai * 128 + m * 16;
#pragma unroll
                for (int bj = 0; bj < 2; ++bj)
#pragma unroll
                    for (int n = 0; n < 2; ++n) { const f32x4 v = acc[ai][bj][m][n]; const int col = col0 + bj * 128 + n * 16;
                        if (!isv) { *(f32x4*)(out + O_PMK + (size_t)row * 1024 + col) = v; u32x2 o; o[0] = pk2(v[0], v[1]); o[1] = pk2(v[2], v[3]); *(u32x2*)(MKB + (size_t)row * 1024 + col) = o; }
                        else { const int c = col - 1024; *(f32x4*)(out + O_PMV + (size_t)row * 1024 + c) = v;
                            const int b = row >> 8, mem = row & 255, head = c >> 8, d = c & 255; bf16_t* dst = MVT + ((size_t)((b * 4 + head) * 256 + d)) * 256 + mem;
                            const unsigned p0 = pk2(v[0], v[1]), p1 = pk2(v[2], v[3]);
                            dst[0] = (bf16_t)(p0 & 0xffffu); dst[256] = (bf16_t)(p0 >> 16); dst[512] = (bf16_t)(p1 & 0xffffu); dst[768] = (bf16_t)(p1 >> 16); } } }
    }
};
struct BranchOrder {
    int G, c;
    __device__ bool next(int i, pg8::Unit& u) const { const int tile = (i / 3) * G + c, n = i % 3; if (tile >= (MP / 256) * 4) return false;
        const int xcd = tile & 7, q = tile >> 3, pm = xcd * 8 + (q >> 2), pn = q & 3;
        u.pm = n * NPANEL + pm; u.pn = n * 4 + pn; return true; }
    __device__ __forceinline__ void a_ready(const pg8::Unit&) const {}
    __device__ __forceinline__ void done(const pg8::Unit&) const {}
};
struct EpiMerge {
    static constexpr bool PERM = false, AFTER_DRAIN = false;
    const bf16_t* GT; float* MF; bf16_t* MB;
    __device__ __forceinline__ void operator()(const f32x4 (&acc)[2][2][4][2], const pg8::Unit& u, int wr, int wc, int fr, int fq) const {
        const int n = u.pm / NPANEL, pm = u.pm - n * NPANEL, pn = u.pn & 3;
        const int row0 = pm * 256 + wr * 64 + fr, col0 = pn * 256 + wc * 32 + 4 * fq;
        u32x2 g[2][4]; f32x4 o[2][4];
        auto issue = [&](int grp, int slot) { const int row = row0 + (grp >> 2) * 128 + (grp & 3) * 16; const bf16_t* gp = GT + (size_t)row * 3072 + n * 1024 + col0; const float* mp = MF + (size_t)row * 1024 + col0;
#pragma unroll
            for (int x = 0; x < 4; ++x) { g[slot][x] = *(const u32x2*)(gp + (x >> 1) * 128 + (x & 1) * 16); if (n > 0) o[slot][x] = *(const f32x4*)(mp + (x >> 1) * 128 + (x & 1) * 16); else o[slot][x] = (f32x4){0.f, 0.f, 0.f, 0.f}; } };
        issue(0, 0);
#pragma unroll
        for (int grp = 0; grp < 8; ++grp) { const int slot = grp & 1, ai = grp >> 2, m = grp & 3; const int row = row0 + ai * 128 + m * 16;
            if (grp < 7) issue(grp + 1, slot ^ 1);
            float* mp = MF + (size_t)row * 1024 + col0;
#pragma unroll
            for (int x = 0; x < 4; ++x) { float gf[4]; unpack4(g[slot][x], gf); f32x4 v = acc[ai][x >> 1][m][x & 1];
                v[0] = v[0] * gf[0] + o[slot][x][0]; v[1] = v[1] * gf[1] + o[slot][x][1]; v[2] = v[2] * gf[2] + o[slot][x][2]; v[3] = v[3] * gf[3] + o[slot][x][3];
                if (n < 2) *(f32x4*)(mp + (x >> 1) * 128 + (x & 1) * 16) = v;
                else { u32x2 w; w[0] = pk2(v[0], v[1]); w[1] = pk2(v[2], v[3]); *(u32x2*)(MB + (size_t)row * 1024 + col0 + (x >> 1) * 128 + (x & 1) * 16) = w; } } }
    }
};
template <int KS, class Mid, class Fin>
__device__ __forceinline__ void thin_gemm(LAS unsigned char* lds, const bf16_t* A0, size_t a_bstride, const bf16_t* B0, size_t b_bstride, int nb, int N, int K, const Mid& mid, const Fin& fin) {
    const int wid = threadIdx.x >> 6, lane = threadIdx.x & 63, fr = lane & 15, fq = lane >> 4; const int ntask = 32 * (N >> 6);
    constexpr int TPB = 8 / KS; const int grp = wid / KS, kq = wid % KS, kspan = K / KS;
    LAS f32x4* red = (LAS f32x4*)lds;
    for (int t0 = blockIdx.x * TPB; t0 < ntask; t0 += gridDim.x * TPB) {
        const int t = t0 + grp; const bool valid = t < ntask;
        const int r0 = MP + (t & 31) * 16, c0 = (t >> 5) * 64;
        f32x4 tot[4];
#pragma unroll
        for (int j = 0; j < 4; ++j) tot[j] = (f32x4){0.f, 0.f, 0.f, 0.f};
        if (valid) for (int n = 0; n < nb; ++n) { f32x4 acc[4];
#pragma unroll
            for (int j = 0; j < 4; ++j) acc[j] = (f32x4){0.f, 0.f, 0.f, 0.f};
            const bf16_t* ap = A0 + (size_t)n * a_bstride + (size_t)(r0 + fr) * K + kq * kspan + fq * 8; const bf16_t* bp = B0 + (size_t)n * b_bstride + (size_t)(c0 + fr) * K + kq * kspan + fq * 8;
#pragma unroll 4
            for (int ks = 0; ks < (kspan >> 5); ++ks) { const bf16x8 a = *(const bf16x8*)(ap + ks * 32);
#pragma unroll
                for (int j = 0; j < 4; ++j) { const bf16x8 b = *(const bf16x8*)(bp + (size_t)j * 16 * K + ks * 32); acc[j] = mfma16(b, a, acc[j]); } }
            mid(n, acc, tot, r0 + fr, c0 + 4 * fq); }
        if (KS > 1) {
#pragma unroll
            for (int j = 0; j < 4; ++j) red[(wid * 4 + j) * 64 + lane] = tot[j];
            __syncthreads();
            if (kq == 0 && valid) {
#pragma unroll
                for (int q = 1; q < KS; ++q)
#pragma unroll
                    for (int j = 0; j < 4; ++j) tot[j] += red[((wid + q) * 4 + j) * 64 + lane];
                fin(tot, r0 + fr, c0 + 4 * fq); }
            __syncthreads();
        } else if (valid) fin(tot, r0 + fr, c0 + 4 * fq);
    }
}
struct EpiRes {
    static constexpr bool PERM = false, AFTER_DRAIN = false;
    const float* resP; const float* resS; float* X; bf16_t* XB; float* ssq;
    __device__ __forceinline__ void operator()(const f32x4 (&acc)[2][2][4][2], const pg8::Unit& u, int wr, int wc, int fr, int fq) const {
        const int row0 = u.pm * 256 + wr * 64 + fr, col0 = u.pn * 256 + wc * 32 + 4 * fq;
#pragma unroll
        for (int ai = 0; ai < 2; ++ai) { f32x4 r[4][4];
#pragma unroll
            for (int m = 0; m < 4; ++m) { const int row = row0 + ai * 128 + m * 16; const float* rp = (row < MP ? resP + (size_t)row * 1024 : resS + (size_t)(row - MP) * 1024) + col0;
#pragma unroll
                for (int x = 0; x < 4; ++x) r[m][x] = *(const f32x4*)(rp + (x >> 1) * 128 + (x & 1) * 16); }
#pragma unroll
            for (int m = 0; m < 4; ++m) { const int row = row0 + ai * 128 + m * 16; float ss = 0.f;
#pragma unroll
                for (int x = 0; x < 4; ++x) { const int col = col0 + (x >> 1) * 128 + (x & 1) * 16; const f32x4 v = acc[ai][x >> 1][m][x & 1] + r[m][x];
                    *(f32x4*)(X + (size_t)row * 1024 + col) = v; ss += v[0] * v[0] + v[1] * v[1] + v[2] * v[2] + v[3] * v[3];
                    if (XB) { u32x2 w; w[0] = pk2(v[0], v[1]); w[1] = pk2(v[2], v[3]); *(u32x2*)(XB + (size_t)row * 1024 + col) = w; } }
                ss += __shfl_xor(ss, 16); ss += __shfl_xor(ss, 32);
                if (fq == 0) atomicAdd(ssq + row, ss); } }
    }
};
struct EpiUp {
    static constexpr bool PERM = true, AFTER_DRAIN = false;
    const float* ssq; bf16_t* H;
    __device__ __forceinline__ void operator()(const f32x4 (&acc)[2][2][4][2], const pg8::Unit& u, int wr, int wc, int fr, int fq) const {
        const int row0 = u.pm * 256 + wr * 64 + fr, col0 = u.pn * 256 + wc * 32 + 8 * fq;
#pragma unroll
        for (int ai = 0; ai < 2; ++ai)
#pragma unroll
            for (int m = 0; m < 4; ++m) { const int row = row0 + ai * 128 + m * 16; const float rs = rsqrtf(ssq[row] * (1.f / 1024.f) + 1e-6f);
#pragma unroll
                for (int bj = 0; bj < 2; ++bj) { f32x4 v0 = acc[ai][bj][m][0], v1 = acc[ai][bj][m][1];
#pragma unroll
                    for (int q = 0; q < 4; ++q) { float a = fmaxf(v0[q] * rs, 0.f); v0[q] = a * a; float b = fmaxf(v1[q] * rs, 0.f); v1[q] = b * b; }
                    u32x4 o; o[0] = pk2(v0[0], v0[1]); o[1] = pk2(v0[2], v0[3]); o[2] = pk2(v1[0], v1[1]); o[3] = pk2(v1[2], v1[3]);
                    __builtin_nontemporal_store(o, (u32x4*)(H + (size_t)row * DFF + col0 + bj * 128)); } }
    }
};

template <int NR, bool DUMMY> __device__ __forceinline__ void p2_rows(const Params& p, const int (&mrow)[NR], int lane) {
    unsigned char* ws = p.ws; const float* lng = p.in[I_LNG]; const float* lnb = p.in[I_LNB];
    const int c4 = lane * 4;
    u32x4 q0[NR], q1[NR]; u32x2 cq[NR], pq[NR]; f32x4 sq[NR]; bool valid[NR], first[NR];
#pragma unroll
    for (int i = 0; i < NR; ++i) { const int m = mrow[i]; valid[i] = m < MT; const int mm = valid[i] ? m : 0;
        const bf16_t* row = (const bf16_t*)(ws + WS_GV) + (size_t)mm * 1024; q0[i] = *(const u32x4*)(row + lane * 8); q1[i] = *(const u32x4*)(row + 512 + lane * 8);
        const bf16_t* cur = (const bf16_t*)(ws + WS_SZ) + (size_t)mm * PSH + 3072 + c4; cq[i] = *(const u32x2*)cur;
        first[i] = mm < MP ? ((mm & 2047) == 0) : (((mm - MP) & 3) == 0);
        pq[i] = (u32x2){0u, 0u}; sq[i] = (f32x4){0.f, 0.f, 0.f, 0.f};
        if (!first[i]) pq[i] = *(const u32x2*)(cur - PSH);
        else if (mm >= MP) sq[i] = *(const f32x4*)(p.in[I_SSH] + (size_t)((mm - MP) >> 2) * PSH + 3072 + c4); }
    const f32x4 mu = *(const f32x4*)(p.in[I_MU] + 3072 + c4);
    f32x4 g0[2], g1[2], b0[2], b1[2];
#pragma unroll
    for (int c = 0; c < 2; ++c) { const int col = c * 512 + lane * 8; g0[c] = *(const f32x4*)(lng + col); g1[c] = *(const f32x4*)(lng + col + 4); b0[c] = *(const f32x4*)(lnb + col); b1[c] = *(const f32x4*)(lnb + col + 4); }
#pragma unroll
    for (int i = 0; i < NR; ++i) { if (!valid[i]) continue; const int m = mrow[i]; bf16_t* row = (bf16_t*)(ws + WS_GV) + (size_t)m * 1024; float x[16];
#pragma unroll
        for (int k = 0; k < 4; ++k) { x[2 * k] = bflo(q0[i][k]); x[2 * k + 1] = bfhi(q0[i][k]); x[8 + 2 * k] = bflo(q1[i][k]); x[8 + 2 * k + 1] = bfhi(q1[i][k]); }
        float s = 0.f;
#pragma unroll
        for (int k = 0; k < 16; ++k) s += x[k];
        s = wave_sum(s); const float mean = s * (1.f / 1024.f); float vs = 0.f;
#pragma unroll
        for (int k = 0; k < 16; ++k) { x[k] -= mean; vs += x[k] * x[k]; }
        vs = wave_sum(vs); const float rstd = rsqrtf(vs * (1.f / 1024.f) + 1e-5f);
#pragma unroll
        for (int c = 0; c < 2; ++c) { const int col = c * 512 + lane * 8; float y[8];
#pragma unroll
            for (int k = 0; k < 4; ++k) { y[k] = x[c * 8 + k] * rstd * g0[c][k] + b0[c][k]; y[4 + k] = x[c * 8 + 4 + k] * rstd * g1[c][k] + b1[c][k]; }
            u32x4 o; o[0] = pk2(y[0], y[1]); o[1] = pk2(y[2], y[3]); o[2] = pk2(y[4], y[5]); o[3] = pk2(y[6], y[7]); if (!DUMMY) *(u32x4*)(row + col) = o;
            if (m >= MP) { float* d = p.out + O_SGV + (size_t)(m - MP) * 1024 + col; *(f32x4*)d = (f32x4){y[0], y[1], y[2], y[3]}; *(f32x4*)(d + 4) = (f32x4){y[4], y[5], y[6], y[7]}; } }
        float cv[4], pv[4], o[4]; unpack4(cq[i], cv);
        if (!first[i]) unpack4(pq[i], pv); else { pv[0] = sq[i][0]; pv[1] = sq[i][1]; pv[2] = sq[i][2]; pv[3] = sq[i][3]; }
#pragma unroll
        for (int e = 0; e < 4; ++e) { const float ss = cv[e] + (pv[e] - cv[e]) * mu[e]; o[e] = lane < 16 ? tanhf_(ss) : (lane < 32 ? ss : sigmoidf_(ss)); }
        u32x2 w; w[0] = pk2(o[0], o[1]); w[1] = pk2(o[2], o[3]); *(u32x2*)((bf16_t*)(ws + WS_XL) + (size_t)m * 256 + c4) = w; }
}
struct EpiLora {
    static constexpr bool PERM = true, AFTER_DRAIN = false;
    bf16_t *E, *A, *Gg; const float *w0, *a0;
    __device__ __forceinline__ void operator()(const f32x4 (&acc)[2][2][4][2], const pg8::Unit& u, int wr, int wc, int fr, int fq) const {
        const int seg = u.pn >> 2, colt = (u.pn & 3) * 256; bf16_t* base = E + (size_t)seg * 17301504;
        const int row0 = u.pm * 256 + wr * 64 + fr, col0 = colt + wc * 32 + 8 * fq;
        f32x4 bv[2][2];
#pragma unroll
        for (int bj = 0; bj < 2; ++bj) { if (seg == 0) { bv[bj][0] = *(const f32x4*)(w0 + col0 + bj * 128); bv[bj][1] = *(const f32x4*)(w0 + col0 + bj * 128 + 4); } else if (seg == 1) { bv[bj][0] = *(const f32x4*)(a0 + col0 + bj * 128); bv[bj][1] = *(const f32x4*)(a0 + col0 + bj * 128 + 4); } else { bv[bj][0] = (f32x4){0.f, 0.f, 0.f, 0.f}; bv[bj][1] = bv[bj][0]; } }
#pragma unroll
        for (int ai = 0; ai < 2; ++ai)
#pragma unroll
            for (int m = 0; m < 4; ++m) { const int row = row0 + ai * 128 + m * 16; bf16_t* rowp = base + (size_t)row * 1024 + col0;
#pragma unroll
                for (int bj = 0; bj < 2; ++bj) { f32x4 v0 = acc[ai][bj][m][0] + bv[bj][0], v1 = acc[ai][bj][m][1] + bv[bj][1];
                    if (seg == 0) {
#pragma unroll
                        for (int q = 0; q < 4; ++q) { v0[q] = 0.60653066f * sigmoidf_(v0[q]); v1[q] = 0.60653066f * sigmoidf_(v1[q]); } }
                    else if (seg == 1) {
#pragma unroll
                        for (int q = 0; q < 4; ++q) { v0[q] = sigmoidf_(v0[q]); v1[q] = sigmoidf_(v1[q]); } }
                    u32x4 o; o[0] = pk2(v0[0], v0[1]); o[1] = pk2(v0[2], v0[3]); o[2] = pk2(v1[0], v1[1]); o[3] = pk2(v1[2], v1[3]);
                    *(u32x4*)(rowp + bj * 128) = o; } }
    }
};

struct ScanPre { u32x2 cr, ck, cv, pr, pk, pv, e, a, g; };
__device__ __forceinline__ u32x2 pack4f(const float* s) { const f32x4 q = *(const f32x4*)s; u32x2 o; o[0] = pk2(q[0], q[1]); o[1] = pk2(q[2], q[3]); return o; }
__device__ __forceinline__ void scan_head(const Params& p, LAS unsigned char* lds, int row0, int T, int h, const float* s0, float* sfin, const float* shift0) {
    const int tid = threadIdx.x, wid = tid >> 6, lane = tid & 63; unsigned char* ws = p.ws;
    const bf16_t* SZp = (const bf16_t*)(ws + WS_SZ); const bf16_t* Ep = (const bf16_t*)(ws + WS_E); const bf16_t* Ap = (const bf16_t*)(ws + WS_AV); const bf16_t* Gp = (const bf16_t*)(ws + WS_GG);
    bf16_t* YB = (bf16_t*)(ws + WS_Y3) + (size_t)MT * 1024;
    LAS float* bufs = (LAS float*)lds;
    LAS float* Yl2 = (LAS float*)(lds + 98304);
    LAS float* BON = (LAS float*)(lds + 98304 + 16384);
    const bool helper = wid >= 4; const int htid = tid & 255;
    const int tth = htid >> 4, j4 = (htid & 15) * 4, ch = h * 64 + j4;
    const int si = (wid & 3) * 16 + (lane >> 3) * 2, jb = (lane & 7) * 8;
    f32x2 S0[4], S1[4];
    if (s0 && !helper) {
#pragma unroll
        for (int q = 0; q < 4; ++q) { S0[q] = *(const f32x2*)(s0 + si * 64 + jb + 2 * q); S1[q] = *(const f32x2*)(s0 + (si + 1) * 64 + jb + 2 * q); } }
    else {
#pragma unroll
        for (int q = 0; q < 4; ++q) { S0[q] = (f32x2){0.f, 0.f}; S1[q] = S0[q]; } }
    auto load_pre = [&](int t0, ScanPre (&P)[2]) {
#pragma unroll
        for (int pp = 0; pp < 2; ++pp) { const int t = t0 + tth + 16 * pp; ScanPre& Q = P[pp];
            if (t < T) { const size_t m = (size_t)(row0 + t); const bf16_t* c = SZp + m * PSH + ch;
                Q.cr = *(const u32x2*)c; Q.ck = *(const u32x2*)(c + 1024); Q.cv = *(const u32x2*)(c + 2048);
                if (t > 0) { Q.pr = *(const u32x2*)(c - PSH); Q.pk = *(const u32x2*)(c - PSH + 1024); Q.pv = *(const u32x2*)(c - PSH + 2048); }
                else if (shift0) { Q.pr = pack4f(shift0 + ch); Q.pk = pack4f(shift0 + 1024 + ch); Q.pv = pack4f(shift0 + 2048 + ch); }
                else { Q.pr = (u32x2){0u, 0u}; Q.pk = Q.pr; Q.pv = Q.pr; }
                Q.e = *(const u32x2*)(Ep + m * 1024 + ch); Q.a = *(const u32x2*)(Ap + m * 1024 + ch); Q.g = (u32x2){0u, 0u}; }
            else { Q.cr = (u32x2){0u, 0u}; Q.ck = Q.cr; Q.cv = Q.cr; Q.pr = Q.cr; Q.pk = Q.cr; Q.pv = Q.cr; Q.e = Q.cr; Q.a = Q.cr; Q.g = Q.cr; } }
    };
    auto store_pre = [&](const ScanPre (&P)[2], int nb) {
        const f32x4 mur = *(const f32x4*)(p.in[I_MU] + ch), muk = *(const f32x4*)(p.in[I_MU] + 1024 + ch), muv = *(const f32x4*)(p.in[I_MU] + 2048 + ch),
                    kkc = *(const f32x4*)(p.in[I_KK] + ch), kac = *(const f32x4*)(p.in[I_KA] + ch), rkc = *(const f32x4*)(p.in[I_RK] + ch);
#pragma unroll
        for (int pp = 0; pp < 2; ++pp) { const ScanPre& Q = P[pp]; const int tt = tth + 16 * pp;
            float cr[4], ck[4], cv[4], pr[4], pk[4], pv[4], e[4], a[4];
            unpack4(Q.cr, cr); unpack4(Q.ck, ck); unpack4(Q.cv, cv); unpack4(Q.pr, pr); unpack4(Q.pk, pk); unpack4(Q.pv, pv); unpack4(Q.e, e); unpack4(Q.a, a);
            f32x4 r, w, k, na, bb, v; float ssq = 0.f, bon = 0.f; float kkr[4];
#pragma unroll
            for (int q = 0; q < 4; ++q) { r[q] = cr[q] + (pr[q] - cr[q]) * mur[q]; const float kz = ck[q] + (pk[q] - ck[q]) * muk[q]; v[q] = cv[q] + (pv[q] - cv[q]) * muv[q];
                k[q] = kz * (1.f + (a[q] - 1.f) * kac[q]); kkr[q] = kz * kkc[q]; ssq += kkr[q] * kkr[q]; bon += r[q] * k[q] * rkc[q]; w[q] = __expf(-e[q]); }
            ssq = red16(ssq); bon = red16(bon); const float rn = rsqrtf(ssq + 1e-12f);
#pragma unroll
            for (int q = 0; q < 4; ++q) { const float kk = kkr[q] * rn; na[q] = -kk; bb[q] = kk * a[q]; }
            LAS float* b = bufs + nb * 12288 + tt * 64 + j4;
            *(LAS f32x4*)(b) = r; *(LAS f32x4*)(b + 2048) = w; *(LAS f32x4*)(b + 4096) = k; *(LAS f32x4*)(b + 6144) = na; *(LAS f32x4*)(b + 8192) = bb; *(LAS f32x4*)(b + 10240) = v;
            if ((htid & 15) == 0) BON[nb * 32 + tt] = bon; }
    };
    auto epilogue = [&](int c) {
        const int cb = c & 1, t0 = c * 32, nv = (T - t0) < 32 ? (T - t0) : 32;
        const f32x4 lg = *(const f32x4*)(p.in[I_LXG] + h * 64 + j4), lb = *(const f32x4*)(p.in[I_LXB] + h * 64 + j4);
        u32x2 gq[2];
#pragma unroll
        for (int pp = 0; pp < 2; ++pp) { const int tt = tth + 16 * pp; gq[pp] = (u32x2){0u, 0u}; if (tt < nv) gq[pp] = *(const u32x2*)(Gp + (size_t)(row0 + t0 + tt) * 1024 + ch); }
#pragma unroll
        for (int pp = 0; pp < 2; ++pp) { const int tt = tth + 16 * pp;
            if (tt < nv) { const size_t m = (size_t)(row0 + t0 + tt);
                const f32x4 y = *(const LAS f32x4*)(Yl2 + cb * 2048 + tt * 64 + j4); const f32x4 v = *(const LAS f32x4*)(bufs + cb * 12288 + 10240 + tt * 64 + j4); const float bon = BON[cb * 32 + tt];
                float s = y[0] + y[1] + y[2] + y[3]; s = red16(s); const float mean = s * (1.f / 64.f);
                float d[4], vs = 0.f;
#pragma unroll
                for (int q = 0; q < 4; ++q) { d[q] = y[q] - mean; vs += d[q] * d[q]; }
                vs = red16(vs); const float rstd = rsqrtf(vs * (1.f / 64.f) + 64e-5f);
                float g[4]; unpack4(gq[pp], g); float o[4];
#pragma unroll
                for (int q = 0; q < 4; ++q) o[q] = (d[q] * rstd * lg[q] + lb[q] + bon * v[q]) * g[q];
                u32x2 w; w[0] = pk2(o[0], o[1]); w[1] = pk2(o[2], o[3]); *(u32x2*)(YB + m * 1024 + h * 64 + j4) = w; } }
    };
    ScanPre P[2];
    if (helper) { load_pre(0, P); store_pre(P, 0); }
    __syncthreads();
    const int nch = (T + 31) >> 5;
    for (int c = 0; c < nch; ++c) {
        const int cb = c & 1, t0 = c * 32, nv = (T - t0) < 32 ? (T - t0) : 32;
        if (!helper) { const LAS float* b = bufs + cb * 12288 + jb; const LAS float* vb = bufs + cb * 12288 + 10240 + si; LAS float* Yl = Yl2 + cb * 2048;
          f32x4 R[2], W[2], K[2], A[2], B[2], nR[2], nW[2], nK[2], nA[2], nB[2]; f32x2 v, nvv;
#define SCAN_LOAD(R_, W_, K_, A_, B_, V_, t) { const LAS float* bt = b + (t) * 64; _Pragma("unroll") for (int x = 0; x < 2; ++x) { \
              A_[x] = *(const LAS f32x4*)(bt + 6144 + 4 * x); B_[x] = *(const LAS f32x4*)(bt + 8192 + 4 * x); W_[x] = *(const LAS f32x4*)(bt + 2048 + 4 * x); \
              K_[x] = *(const LAS f32x4*)(bt + 4096 + 4 * x); R_[x] = *(const LAS f32x4*)(bt + 4 * x); } V_ = *(const LAS f32x2*)(vb + (t) * 64); }
#define H2(X, q) ((f32x2){X[(q) >> 1][((q) & 1) * 2], X[(q) >> 1][((q) & 1) * 2 + 1]})
          SCAN_LOAD(R, W, K, A, B, v, 0)
#pragma unroll 4
          for (int t = 0; t < nv; ++t) {
              { const int tn = (t + 1 < 32) ? t + 1 : 31; SCAN_LOAD(nR, nW, nK, nA, nB, nvv, tn) }
              asm volatile("" ::: "memory");
              f32x2 d0 = S0[0] * H2(A, 0), d1 = S1[0] * H2(A, 0);
#pragma unroll
              for (int q = 1; q < 4; ++q) { d0 += S0[q] * H2(A, q); d1 += S1[q] * H2(A, q); }
              const float sa0 = red8(d0[0] + d0[1]), sa1 = red8(d1[0] + d1[1]);
              const f32x2 sa02 = {sa0, sa0}, sa12 = {sa1, sa1}, v02 = {v[0], v[0]}, v12 = {v[1], v[1]};
#pragma unroll
              for (int q = 0; q < 4; ++q) { S0[q] = S0[q] * H2(W, q) + (sa02 * H2(B, q) + v02 * H2(K, q)); S1[q] = S1[q] * H2(W, q) + (sa12 * H2(B, q) + v12 * H2(K, q)); }
              f32x2 y0 = S0[0] * H2(R, 0), y1 = S1[0] * H2(R, 0);
#pragma unroll
              for (int q = 1; q < 4; ++q) { y0 += S0[q] * H2(R, q); y1 += S1[q] * H2(R, q); }
              float yy0 = y0[0] + y0[1], yy1 = y1[0] + y1[1];
              asm("" : "+v"(yy0)); asm("" : "+v"(yy1));
              yy0 = red8(yy0); yy1 = red8(yy1);
              *(LAS f32x2*)(Yl + t * 64 + si) = (f32x2){yy0, yy1};
#pragma unroll
              for (int x = 0; x < 2; ++x) { R[x] = nR[x]; W[x] = nW[x]; K[x] = nK[x]; A[x] = nA[x]; B[x] = nB[x]; }
              v = nvv; }
#undef SCAN_LOAD
#undef H2
        } else {
            if (c + 1 < nch) load_pre(t0 + 32, P);
            if (c > 0) epilogue(c - 1);
            if (c + 1 < nch) store_pre(P, cb ^ 1);
        }
        __syncthreads();
    }
    if (helper) epilogue(nch - 1);
#pragma unroll
    for (int q = 0; q < 4; ++q) if (!helper) { *(f32x2*)(sfin + si * 64 + jb + 2 * q) = S0[q]; *(f32x2*)(sfin + (si + 1) * 64 + jb + 2 * q) = S1[q]; }
}

template <bool DUMMY> __device__ __forceinline__ void attn_prompt_item(const Params& p, LAS unsigned char* lds, int item) {
    const int tid = threadIdx.x, wid = tid >> 6, lane = tid & 63, fr = lane & 15, fq = lane >> 4; unsigned char* ws = p.ws;
    const int b = item >> 6, head = (item >> 4) & 3, qt = item & 15;
    bf16_t* Qp = (bf16_t*)(ws + WS_Y3) + (size_t)2 * MT * 1024; const bf16_t* MKB = (const bf16_t*)(ws + WS_MKB); const bf16_t* MVT = (const bf16_t*)(ws + WS_MVT);
    const int qrow = b * 2048 + qt * 128 + wid * 16;
    bf16x8 qf[8];
#pragma unroll
    for (int ks = 0; ks < 8; ++ks) qf[ks] = *(const bf16x8*)(Qp + (size_t)(qrow + fr) * 1024 + head * 256 + ks * 32 + fq * 8);
#pragma unroll 1
    for (int rnd = 0; rnd < 2; ++rnd) { u32x4 kv[8];
#pragma unroll
      for (int it = 0; it < 8; ++it) { const int idx = (rnd * 8 + it) * 512 + tid, row = idx >> 5, c = idx & 31; kv[it] = *(const u32x4*)(MKB + (size_t)(b * 256 + row) * 1024 + head * 256 + c * 8); }
#pragma unroll
      for (int it = 0; it < 8; ++it) { const int idx = (rnd * 8 + it) * 512 + tid, row = idx >> 5, c = idx & 31; *(LAS u32x4*)(lds + (row * 32 + (c ^ (row & 15))) * 16) = kv[it]; } }
    __syncthreads();
    u32x4 pf[8];
    { f32x4 s[16];
      int koff[8];
#pragma unroll
      for (int ks = 0; ks < 8; ++ks) koff[ks] = (fr * 32 + ((ks * 4 + fq) ^ fr)) * 16;
#pragma unroll
      for (int nt = 0; nt < 16; ++nt) { f32x4 acc = {0.f, 0.f, 0.f, 0.f};
#pragma unroll
          for (int ks = 0; ks < 8; ++ks) { const bf16x8 kf = *(const LAS bf16x8*)(lds + nt * 8192 + koff[ks]); acc = mfma16(kf, qf[ks], acc); }
          s[nt] = acc; }
      float mx = -3.0e38f;
#pragma unroll
      for (int nt = 0; nt < 16; ++nt) mx = fmaxf(fmaxf(fmaxf(s[nt][0], s[nt][1]), fmaxf(s[nt][2], s[nt][3])), mx);
      mx = fmaxf(mx, __shfl_xor(mx, 16)); mx = fmaxf(mx, __shfl_xor(mx, 32));
      float sum = 0.f;
#pragma unroll
      for (int nt = 0; nt < 16; ++nt)
#pragma unroll
          for (int q = 0; q < 4; ++q) { const float e = __expf((s[nt][q] - mx) * 0.0625f); s[nt][q] = e; sum += e; }
      sum += __shfl_xor(sum, 16); sum += __shfl_xor(sum, 32); const float inv = rcpf(sum);
#pragma unroll
      for (int ks = 0; ks < 8; ++ks) { pf[ks][0] = pk2(s[2 * ks][0] * inv, s[2 * ks][1] * inv); pf[ks][1] = pk2(s[2 * ks][2] * inv, s[2 * ks][3] * inv);
          pf[ks][2] = pk2(s[2 * ks + 1][0] * inv, s[2 * ks + 1][1] * inv); pf[ks][3] = pk2(s[2 * ks + 1][2] * inv, s[2 * ks + 1][3] * inv); } }
    __syncthreads();
#pragma unroll 1
    for (int rnd = 0; rnd < 2; ++rnd) { u32x4 kv[8];
#pragma unroll
      for (int it = 0; it < 8; ++it) { const int idx = (rnd * 8 + it) * 512 + tid, row = idx >> 5, c = idx & 31; kv[it] = *(const u32x4*)(MVT + ((size_t)((b * 4 + head) * 256 + row)) * 256 + c * 8); }
#pragma unroll
      for (int it = 0; it < 8; ++it) { const int idx = (rnd * 8 + it) * 512 + tid, row = idx >> 5, c = idx & 31; *(LAS u32x4*)(lds + (row * 32 + (c ^ (row & 15))) * 16) = kv[it]; } }
    __syncthreads();
    { int voff[8][2];
#pragma unroll
      for (int ks = 0; ks < 8; ++ks) { const int c1 = ks * 4 + (fq >> 1); voff[ks][0] = (fr * 32 + (c1 ^ fr)) * 16 + (fq & 1) * 8; voff[ks][1] = (fr * 32 + ((c1 + 2) ^ fr)) * 16 + (fq & 1) * 8; }
#pragma unroll 2
      for (int dt = 0; dt < 16; ++dt) { f32x4 acc = {0.f, 0.f, 0.f, 0.f};
#pragma unroll
          for (int ks = 0; ks < 8; ++ks) { const u32x2 lo = *(const LAS u32x2*)(lds + dt * 8192 + voff[ks][0]), hi = *(const LAS u32x2*)(lds + dt * 8192 + voff[ks][1]);
              u32x4 vv; vv[0] = lo[0]; vv[1] = lo[1]; vv[2] = hi[0]; vv[3] = hi[1]; acc = mfma16(__builtin_bit_cast(bf16x8, vv), __builtin_bit_cast(bf16x8, pf[ks]), acc); }
          u32x2 w; w[0] = pk2(acc[0], acc[1]); w[1] = pk2(acc[2], acc[3]);
          bf16_t* o = Qp + (size_t)(qrow + fr) * 1024 + head * 256 + dt * 16 + 4 * fq;
          if (!DUMMY) *(u32x2*)o = w; else if (w[0] == 0x12345678u) Qp[0] = 0; } }
    __syncthreads();
}

template <bool DUMMY> __device__ __forceinline__ void attn_sample_item(const Params& p, LAS unsigned char* lds, int item) {
    const int tid = threadIdx.x, wid = tid >> 6, lane = tid & 63, l16 = lane & 15, rg = lane >> 4; unsigned char* ws = p.ws;
    const int b = item >> 2, head = item & 3;
    bf16_t* Qp = (bf16_t*)(ws + WS_Y3) + (size_t)2 * MT * 1024 + (size_t)(MP + 4 * b) * 1024 + head * 256;
    const float* Kp = p.in[I_CK] + ((size_t)b * 256 * 4 + head) * 256; const float* Vp = p.in[I_CV] + ((size_t)b * 256 * 4 + head) * 256;
    LAS float* sc = (LAS float*)lds; LAS float* pr = (LAS float*)(lds + 4096); LAS float* part = (LAS float*)(lds + 8192);
    float qv[4][4][4];
#pragma unroll
    for (int t = 0; t < 4; ++t)
#pragma unroll
        for (int c = 0; c < 4; ++c) { const u32x2 q = *(const u32x2*)(Qp + t * 1024 + 64 * c + 4 * l16); unpack4(q, qv[t][c]); }
#pragma unroll 2
    for (int it = 0; it < 8; ++it) { const int mrow = wid * 32 + it * 4 + rg; const float* kr = Kp + (size_t)mrow * 1024 + 4 * l16; float d[4] = {0.f, 0.f, 0.f, 0.f};
#pragma unroll
        for (int c = 0; c < 4; ++c) { const f32x4 kv = *(const f32x4*)(kr + 64 * c);
#pragma unroll
            for (int t = 0; t < 4; ++t) d[t] += kv[0] * qv[t][c][0] + kv[1] * qv[t][c][1] + kv[2] * qv[t][c][2] + kv[3] * qv[t][c][3]; }
#pragma unroll
        for (int t = 0; t < 4; ++t) { const float r = red16(d[t]); if (l16 == 0) sc[t * 256 + mrow] = r * 0.0625f; } }
    __syncthreads();
    if (wid < 4) { const f32x4 x = *(const LAS f32x4*)(sc + wid * 256 + lane * 4); float mx = fmaxf(fmaxf(x[0], x[1]), fmaxf(x[2], x[3])); mx = wave_max(mx);
        float e[4], sum = 0.f;
#pragma unroll
        for (int q = 0; q < 4; ++q) { e[q] = __expf(x[q] - mx); sum += e[q]; }
        sum = wave_sum(sum); const float inv = rcpf(sum);
#pragma unroll
        for (int q = 0; q < 4; ++q) pr[(lane * 4 + q) * 4 + wid] = e[q] * inv; }
    __syncthreads();
    { f32x4 acc[4];
#pragma unroll
      for (int t = 0; t < 4; ++t) acc[t] = (f32x4){0.f, 0.f, 0.f, 0.f};
#pragma unroll 8
      for (int it = 0; it < 32; ++it) { const int mrow = wid * 32 + it; const f32x4 vv = *(const f32x4*)(Vp + (size_t)mrow * 1024 + lane * 4); const f32x4 pp = *(const LAS f32x4*)(pr + mrow * 4);
#pragma unroll
          for (int t = 0; t < 4; ++t) acc[t] += pp[t] * vv; }
#pragma unroll
      for (int t = 0; t < 4; ++t) *(LAS f32x4*)(part + (wid * 4 + t) * 256 + lane * 4) = acc[t]; }
    __syncthreads();
    { const int o = tid * 2, t = o >> 8, d = o & 255; float a0 = 0.f, a1 = 0.f;
#pragma unroll
      for (int w = 0; w < 8; ++w) { const f32x2 v = *(const LAS f32x2*)(part + (w * 4 + t) * 256 + d); a0 += v[0]; a1 += v[1]; }
      const unsigned wv = pk2(a0, a1); if (!DUMMY) *(unsigned*)(Qp + t * 1024 + d) = wv; else if (wv == 0x12345678u) Qp[0] = 0; }
    __syncthreads();
}

template <bool DUMMY> __device__ __forceinline__ void sg_prompt_item(const Params& p, LAS unsigned char* lds, int item) {
    const int tid = threadIdx.x, wid = tid >> 6, lane = tid & 63, fr = lane & 15, fq = lane >> 4; unsigned char* ws = p.ws;
    const int chn = item >> 3, g = item & 7, m0 = chn * 128;
    const bf16_t* VN = (const bf16_t*)(ws + WS_GV); const bf16_t* SGW = (const bf16_t*)(ws + WS_SGW) + g * 16384; bf16_t* U = (bf16_t*)(ws + WS_Y3);
    LAS bf16_t* VT = (LAS bf16_t*)lds;
    { const int s = tid >> 2, hq = (tid & 3) * 32; const bf16_t* src = VN + (size_t)(m0 + s) * 1024 + g * 128 + hq;
#pragma unroll
      for (int c = 0; c < 4; ++c) { const u32x4 q = *(const u32x4*)(src + c * 8);
#pragma unroll
          for (int k = 0; k < 4; ++k) { VT[(hq + c * 8 + 2 * k) * 136 + s] = (bf16_t)(q[k] & 0xffffu); VT[(hq + c * 8 + 2 * k + 1) * 136 + s] = (bf16_t)(q[k] >> 16); } } }
    const int h0 = wid * 16; bf16x8 xf[4];
    const float* sgb = p.in[I_SGB] + g * 128;
    bf16x8 yf[8][4]; u32x2 uq[8]; float bias[8];
#pragma unroll
    for (int mt = 0; mt < 8; ++mt) {
#pragma unroll
        for (int ks = 0; ks < 4; ++ks) if (32 * ks <= 16 * mt + 15) yf[mt][ks] = *(const bf16x8*)(SGW + (mt * 16 + fr) * 128 + ks * 32 + fq * 8);
        uq[mt] = *(const u32x2*)(U + (size_t)(m0 + mt * 16 + fr) * 1024 + g * 128 + h0 + 4 * fq); bias[mt] = sgb[mt * 16 + fr]; }
    __syncthreads();
#pragma unroll
    for (int ks = 0; ks < 4; ++ks) xf[ks] = *(const LAS bf16x8*)(VT + (h0 + fr) * 136 + ks * 32 + fq * 8);
#pragma unroll
    for (int mt = 0; mt < 8; ++mt) { f32x4 acc = {0.f, 0.f, 0.f, 0.f};
#pragma unroll
        for (int ks = 0; ks < 4; ++ks) if (32 * ks <= 16 * mt + 15) acc = mfma16(xf[ks], yf[mt][ks], acc);
        bf16_t* up = U + (size_t)(m0 + mt * 16 + fr) * 1024 + g * 128 + h0 + 4 * fq; float uf[4]; unpack4(uq[mt], uf);
        u32x2 w; w[0] = pk2(uf[0] * (acc[0] + bias[mt]), uf[1] * (acc[1] + bias[mt])); w[1] = pk2(uf[2] * (acc[2] + bias[mt]), uf[3] * (acc[3] + bias[mt])); if (!DUMMY) *(u32x2*)up = w; else if (w[0] == 0x12345678u) up[0] = 0; }
    __syncthreads();
}
__device__ __forceinline__ void sg_sample_item(const Params& p, int item) {
    const int tid = threadIdx.x; unsigned char* ws = p.ws; const bf16_t* VN = (const bf16_t*)(ws + WS_GV); bf16_t* U = (bf16_t*)(ws + WS_Y3);
    const float* sgw = p.in[I_SGW]; const float* sgb = p.in[I_SGB];
    for (int e = tid; e < 32 * 128; e += 512) { const int r = e >> 7, c8 = (e & 127) * 8; const int m = MP + item * 32 + r, t = r & 3, g = c8 >> 7; float a[8];
#pragma unroll
        for (int k = 0; k < 8; ++k) a[k] = sgb[g * 128 + t];
        for (int s = 0; s <= t; ++s) { const float w = sgw[(g * 128 + t) * 128 + s]; const u32x4 q = *(const u32x4*)(VN + (size_t)(m - t + s) * 1024 + c8);
#pragma unroll
            for (int k = 0; k < 4; ++k) { a[2 * k] += w * bflo(q[k]); a[2 * k + 1] += w * bfhi(q[k]); } }
        bf16_t* up = U + (size_t)m * 1024 + c8; const u32x4 uq = *(const u32x4*)up; u32x4 o;
#pragma unroll
        for (int k = 0; k < 4; ++k) o[k] = pk2(bflo(uq[k]) * a[2 * k], bfhi(uq[k]) * a[2 * k + 1]);
        *(u32x4*)up = o; }
}

constexpr int Q_SATT = 0, Q_PATT = 512, Q_SGP = 1024, Q_SGS = 2048, Q_SSCAN = 2064, Q_END = 2064 + 2048;

template <int PH, bool DUMMY = false> __device__ __forceinline__ void run_phase(const Params& p, LAS unsigned char* lds) {
    unsigned char* ws = p.ws; const int G = gridDim.x, bid = blockIdx.x;
    if constexpr (PH == 0) phase0(p, lds);
    else if constexpr (PH == 1) {
        { pg8::Gemm g{(const bf16_t*)(ws + WS_HMB), (const bf16_t*)(ws + WS_WTMKV), 2048, 2048, 1024}; pg8::StaticOrder S; S.init(2048, 2048, G, (bid + 64) % G);
          EpiMem E{p.out, (bf16_t*)(ws + WS_MKB), (bf16_t*)(ws + WS_MVT)}; pg8::gemm_phase<EpiMem, pg8::StaticOrder, false>(lds, g, S, E, nullptr); }
        __syncthreads();
        { pg8::Gemm g{(const bf16_t*)(ws + WS_HB), (const bf16_t*)(ws + WS_WTIN), MT, PIN, 1024}; pg8::StaticOrder S; S.init(MT, PIN, G, bid);
          EpiZ E{(bf16_t*)(ws + WS_Y3), (bf16_t*)(ws + WS_GV), (bf16_t*)(ws + WS_SZ), (bf16_t*)(ws + WS_Y3) + (size_t)2 * MT * 1024, (bf16_t*)(ws + WS_GT), p.out};
          pg8::gemm_phase<EpiZ, pg8::StaticOrder, false>(lds, g, S, E, nullptr); }
    }
    else if constexpr (PH == 2) { const int wid = threadIdx.x >> 6, lane = threadIdx.x & 63; for (int m = wid * G + bid; m < MT; m += 24 * G) { const int mr[3] = {m, m + 8 * G, m + 16 * G}; p2_rows<3, DUMMY>(p, mr, lane); } }
    else if constexpr (PH == 11) { int kk = 256; asm volatile("" : "+s"(kk));
        pg8::Gemm g{(const bf16_t*)(ws + WS_XL), (const bf16_t*)(ws + WS_WTLORA), MP, 3072, kk}; pg8::StaticOrder S; S.init(MP, 3072, G, bid);
        EpiLora E{(bf16_t*)(ws + WS_E), (bf16_t*)(ws + WS_AV), (bf16_t*)(ws + WS_GG), p.in[I_W0], p.in[I_A0]}; pg8::gemm_phase<EpiLora, pg8::StaticOrder, false>(lds, g, S, E, nullptr);
        bf16_t* Eb = (bf16_t*)(ws + WS_E); const float* w0 = p.in[I_W0]; const float* a0 = p.in[I_A0];
        thin_gemm<1>(lds, (const bf16_t*)(ws + WS_XL), 0, (const bf16_t*)(ws + WS_WTLORA), 0, 1, 3072, kk,
            [&](int, const f32x4 (&acc)[4], f32x4 (&tot)[4], int, int) {
#pragma unroll
                for (int j = 0; j < 4; ++j) tot[j] = acc[j]; },
            [&](const f32x4 (&tot)[4], int row, int col) { const int seg = col >> 10;
#pragma unroll
                for (int j = 0; j < 4; ++j) { const int cc = (col & 1023) + 16 * j; f32x4 v = tot[j];
                    if (seg == 0) { const f32x4 bq = *(const f32x4*)(w0 + cc);
#pragma unroll
                        for (int q = 0; q < 4; ++q) v[q] = 0.60653066f * sigmoidf_(v[q] + bq[q]); }
                    else if (seg == 1) { const f32x4 bq = *(const f32x4*)(a0 + cc);
#pragma unroll
                        for (int q = 0; q < 4; ++q) v[q] = sigmoidf_(v[q] + bq[q]); }
                    u32x2 w; w[0] = pk2(v[0], v[1]); w[1] = pk2(v[2], v[3]); *(u32x2*)(Eb + (size_t)seg * 17301504 + (size_t)row * 1024 + cc) = w; } }); }
    else if constexpr (PH == 3 || PH == 10) {
#ifndef P3SPLIT
#define P3SPLIT 0
#endif
#ifndef P3SUB
#define P3SUB 31
#endif
        constexpr int SUB = DUMMY ? P3SUB : 31;
        constexpr bool DO_SCAN = (PH == 3), DO_REST = P3SPLIT ? (PH == 10) : (PH == 3);
        if (DO_SCAN && !DUMMY && bid >= 128) {
#pragma unroll 1
            for (int it = 2368 + (bid - 128); it < 5440; it += G - 128) tr_late(p, lds, it); }
        if (DO_SCAN && (SUB & 1) && bid < 128) { const int b = bid >> 4, h = bid & 15; scan_head(p, lds, b * 2048, 2048, h, nullptr, p.out + O_PWKV + (size_t)bid * 4096, nullptr); }
        unsigned* ctr = (unsigned*)(ws + WS_CTL) + (PH == 10 ? 1 : 0) + (DUMMY ? 2 : 0); LAS unsigned* qw = (LAS unsigned*)(lds + QW_OFF);
        const int q_lo = DO_REST ? 0 : Q_SSCAN, q_hi = DO_SCAN ? Q_END : Q_SSCAN;
        unsigned nxt = 0; if (threadIdx.x == 0) nxt = atomicAdd(ctr, 1u);
        for (;;) {
            __syncthreads();
            if (threadIdx.x == 0) { *qw = nxt; nxt = atomicAdd(ctr, 1u); }
            __syncthreads();
            const int pop = (int)*qw + q_lo; if (pop >= q_hi) break;
            const int it = (P3SPLIT || DUMMY) ? pop : (pop < 2048 ? Q_SSCAN + pop : pop - 2048);
            if (it < Q_PATT) { if (SUB & 2) attn_sample_item<DUMMY>(p, lds, it); }
            else if (it < Q_SGP) { if (SUB & 4) attn_prompt_item<DUMMY>(p, lds, it - Q_PATT); }
            else if (it < Q_SGS) { if (SUB & 8) sg_prompt_item<DUMMY>(p, lds, it - Q_SGP); }
            else if (it < Q_SSCAN) { if (!DUMMY) sg_sample_item(p, it - Q_SGS); }
            else if (SUB & 16) { const int bh = it - Q_SSCAN, b = bh >> 4, h = bh & 15;
                scan_head(p, lds, MP + b * 4, 4, h, p.in[I_SWKV] + (size_t)bh * 4096, p.out + O_SWKV + (size_t)bh * 4096, p.in[I_SSH] + (size_t)b * PSH); }
        }
    }
    else if constexpr (PH == 4) { pg8::Gemm g{(const bf16_t*)(ws + WS_Y3), (const bf16_t*)(ws + WS_WTBR), 3 * MT, 3072, 1024}; BranchOrder S{G, bid};
        EpiMerge E{(const bf16_t*)(ws + WS_GT), (float*)(ws + WS_MF), (bf16_t*)(ws + WS_MB)}; pg8::gemm_phase<EpiMerge, BranchOrder, false>(lds, g, S, E, nullptr);
        const bf16_t* GT = (const bf16_t*)(ws + WS_GT); bf16_t* MB = (bf16_t*)(ws + WS_MB);
        thin_gemm<4>(lds, (const bf16_t*)(ws + WS_Y3), (size_t)MT * 1024, (const bf16_t*)(ws + WS_WTBR), (size_t)1048576, 3, 1024, 1024,
            [&](int n, const f32x4 (&acc)[4], f32x4 (&tot)[4], int row, int col) {
#pragma unroll
                for (int j = 0; j < 4; ++j) { float gf[4]; unpack4(*(const u32x2*)(GT + (size_t)row * 3072 + n * 1024 + col + 16 * j), gf);
                    tot[j][0] += acc[j][0] * gf[0]; tot[j][1] += acc[j][1] * gf[1]; tot[j][2] += acc[j][2] * gf[2]; tot[j][3] += acc[j][3] * gf[3]; } },
            [&](const f32x4 (&tot)[4], int row, int col) {
#pragma unroll
                for (int j = 0; j < 4; ++j) { u32x2 w; w[0] = pk2(tot[j][0], tot[j][1]); w[1] = pk2(tot[j][2], tot[j][3]); *(u32x2*)(MB + (size_t)row * 1024 + col + 16 * j) = w; } }); }
    else if constexpr (PH == 5) { pg8::Gemm g{(const bf16_t*)(ws + WS_MB), (const bf16_t*)(ws + WS_WTOUT), MP, 1024, 1024}; pg8::StaticOrder S; S.init(MP, 1024, G, bid);
        EpiRes E{p.in[I_XP], p.in[I_XS], (float*)(ws + WS_X1), (bf16_t*)(ws + WS_X1B), (float*)(ws + (DUMMY ? WS_XL : WS_SSQ1))}; pg8::gemm_phase<EpiRes, pg8::StaticOrder, false>(lds, g, S, E, nullptr);
        const float* xs = p.in[I_XS]; float* X1 = (float*)(ws + WS_X1); bf16_t* X1B = (bf16_t*)(ws + WS_X1B); float* ssq = (float*)(ws + (DUMMY ? WS_XL : WS_SSQ1));
        thin_gemm<4>(lds, (const bf16_t*)(ws + WS_MB), 0, (const bf16_t*)(ws + WS_WTOUT), 0, 1, 1024, 1024,
            [&](int, const f32x4 (&acc)[4], f32x4 (&tot)[4], int, int) {
#pragma unroll
                for (int j = 0; j < 4; ++j) tot[j] = acc[j]; },
            [&](const f32x4 (&tot)[4], int row, int col) { float ss = 0.f;
#pragma unroll
                for (int j = 0; j < 4; ++j) { const f32x4 v = tot[j] + *(const f32x4*)(xs + (size_t)(row - MP) * 1024 + col + 16 * j); *(f32x4*)(X1 + (size_t)row * 1024 + col + 16 * j) = v;
                    u32x2 w; w[0] = pk2(v[0], v[1]); w[1] = pk2(v[2], v[3]); *(u32x2*)(X1B + (size_t)row * 1024 + col + 16 * j) = w; ss += v[0] * v[0] + v[1] * v[1] + v[2] * v[2] + v[3] * v[3]; }
                ss += __shfl_xor(ss, 16); ss += __shfl_xor(ss, 32); if ((threadIdx.x & 63) < 16) atomicAdd(ssq + row, ss); }); }
    else if constexpr (PH == 6) { pg8::Gemm g{(const bf16_t*)(ws + WS_X1B), (const bf16_t*)(ws + WS_WTUP), MP, DFF, 1024}; pg8::StaticOrder S; S.init(MP, DFF, G, bid);
        EpiUp E{(const float*)(ws + WS_SSQ1), (bf16_t*)(ws + WS_HID)}; pg8::gemm_phase<EpiUp, pg8::StaticOrder, false>(lds, g, S, E, nullptr);
        const float* ssq = (const float*)(ws + WS_SSQ1); bf16_t* H = (bf16_t*)(ws + WS_HID);
        thin_gemm<1>(lds, (const bf16_t*)(ws + WS_X1B), 0, (const bf16_t*)(ws + WS_WTUP), 0, 1, DFF, 1024,
            [&](int, const f32x4 (&acc)[4], f32x4 (&tot)[4], int, int) {
#pragma unroll
                for (int j = 0; j < 4; ++j) tot[j] = acc[j]; },
            [&](const f32x4 (&tot)[4], int row, int col) { const float rs = rsqrtf(ssq[row] * (1.f / 1024.f) + 1e-6f);
#pragma unroll
                for (int j = 0; j < 4; ++j) { float h[4];
#pragma unroll
                    for (int q = 0; q < 4; ++q) { const float a = fmaxf(tot[j][q] * rs, 0.f); h[q] = a * a; }
                    u32x2 w; w[0] = pk2(h[0], h[1]); w[1] = pk2(h[2], h[3]); *(u32x2*)(H + (size_t)row * DFF + col + 16 * j) = w; } }); }
    else if constexpr (PH == 7) { pg8::Gemm g{(const bf16_t*)(ws + WS_HID), (const bf16_t*)(ws + WS_WTDN), MP, 1024, DFF}; pg8::StaticOrder S; S.init(MP, 1024, G, bid);
        const float* x1 = (const float*)(ws + WS_X1);
        EpiRes E{x1, x1 + (size_t)MP * 1024, (float*)(ws + WS_X2), nullptr, (float*)(ws + (DUMMY ? WS_XL : WS_SSQ2))}; pg8::gemm_phase<EpiRes, pg8::StaticOrder, false>(lds, g, S, E, nullptr);
        float* X2 = (float*)(ws + WS_X2); float* ssq = (float*)(ws + (DUMMY ? WS_XL : WS_SSQ2));
        thin_gemm<4>(lds, (const bf16_t*)(ws + WS_HID), 0, (const bf16_t*)(ws + WS_WTDN), 0, 1, 1024, DFF,
            [&](int, const f32x4 (&acc)[4], f32x4 (&tot)[4], int, int) {
#pragma unroll
                for (int j = 0; j < 4; ++j) tot[j] = acc[j]; },
            [&](const f32x4 (&tot)[4], int row, int col) { float ss = 0.f;
#pragma unroll
                for (int j = 0; j < 4; ++j) { const f32x4 v = tot[j] + *(const f32x4*)(x1 + (size_t)row * 1024 + col + 16 * j); *(f32x4*)(X2 + (size_t)row * 1024 + col + 16 * j) = v;
                    ss += v[0] * v[0] + v[1] * v[1] + v[2] * v[2] + v[3] * v[3]; }
                ss += __shfl_xor(ss, 16); ss += __shfl_xor(ss, 32); if ((threadIdx.x & 63) < 16) atomicAdd(ssq + row, ss); }); }
    else if constexpr (PH == 8) { const float* x2 = (const float*)(ws + WS_X2); const float* ssq = (const float*)(ws + WS_SSQ2); const float* gf = p.in[I_NFG];
        const int wid = threadIdx.x >> 6, lane = threadIdx.x & 63;
        f32x4 g[4];
#pragma unroll
        for (int c = 0; c < 4; ++c) g[c] = *(const f32x4*)(gf + c * 256 + lane * 4);
        for (int r0 = wid * G + bid; r0 < MT; r0 += 24 * G) {
            f32x4 v[3][4]; float rs[3];
#pragma unroll
            for (int i = 0; i < 3; ++i) { const int r = r0 + i * 8 * G; if (r < MT) { rs[i] = ssq[r];
#pragma unroll
                for (int c = 0; c < 4; ++c) v[i][c] = *(const f32x4*)(x2 + (size_t)r * 1024 + c * 256 + lane * 4); } }
#pragma unroll
            for (int i = 0; i < 3; ++i) { const int r = r0 + i * 8 * G; if (r < MT) { const float s = rsqrtf(rs[i] * (1.f / 1024.f) + 1e-6f);
#pragma unroll
                for (int c = 0; c < 4; ++c) *(f32x4*)(p.out + (size_t)r * 1024 + c * 256 + lane * 4) = v[i][c] * s * g[c]; } } } }
}
#ifdef DIAG_PHASES
template <int PH> __global__ __launch_bounds__(512, 2) void diag_phase(Params p) {
    extern __shared__ __attribute__((aligned(16))) unsigned char shm[];
    run_phase<PH>(p, (LAS unsigned char*)shm);
}
template __global__ void diag_phase<0>(Params); template __global__ void diag_phase<1>(Params); template __global__ void diag_phase<2>(Params);
template __global__ void diag_phase<3>(Params); template __global__ void diag_phase<4>(Params); template __global__ void diag_phase<5>(Params);
template __global__ void diag_phase<6>(Params); template __global__ void diag_phase<7>(Params); template __global__ void diag_phase<8>(Params);
#endif
template <int PH, bool DUMMY = false> __device__ __forceinline__ void phase_step(int ph_lo, int ph_hi, LAS unsigned char* lds, cg::grid_group& grid, unsigned& nbar) {
    constexpr int PE = (PH == 10) ? 3 : (PH == 11 ? 2 : PH);
    if (ph_lo <= PE && PE < ph_hi) {
        if (PH > ph_lo) {
            asm volatile("s_waitcnt vmcnt(0)" ::: "memory");
            __syncthreads();
            ++nbar;
            if (threadIdx.x == 0) {
                const __attribute__((address_space(4))) Params* pq = (const __attribute__((address_space(4))) Params*)__builtin_amdgcn_kernarg_segment_ptr();
                __attribute__((address_space(1))) unsigned char* wsb = (__attribute__((address_space(1))) unsigned char*)pq->ws;
                if (nbar == 1) {
                    __attribute__((address_space(1))) unsigned* bar = (__attribute__((address_space(1))) unsigned*)(wsb + WS_CTL + 128);
                    __builtin_amdgcn_fence(__ATOMIC_RELEASE, "agent"); asm volatile("s_waitcnt vmcnt(0)" ::: "memory");
                    __hip_atomic_fetch_add(bar, 1u, __ATOMIC_RELAXED, __HIP_MEMORY_SCOPE_AGENT);
                    while (__hip_atomic_load(bar, __ATOMIC_RELAXED, __HIP_MEMORY_SCOPE_AGENT) < gridDim.x) __builtin_amdgcn_s_sleep(2);
                    __builtin_amdgcn_fence(__ATOMIC_ACQUIRE, "agent"); asm volatile("s_waitcnt vmcnt(0)" ::: "memory");
                } else {
                    __attribute__((address_space(1))) unsigned* c2 = (__attribute__((address_space(1))) unsigned*)(wsb + WS_CTL2);
                    const unsigned xcc = (unsigned)__builtin_amdgcn_s_getreg((3 << 11) | 20) & 0xFu;
                    const unsigned nx = __hip_atomic_load(c2 + 1024 + xcc, __ATOMIC_RELAXED, __HIP_MEMORY_SCOPE_AGENT);
                    unsigned nxcc = 0;
                    for (int j = 0; j < 16; ++j) nxcc += __hip_atomic_load(c2 + 1024 + j, __ATOMIC_RELAXED, __HIP_MEMORY_SCOPE_AGENT) != 0u;
                    const unsigned k = nbar - 1;
                    const unsigned old = __hip_atomic_fetch_add(c2 + 64 * xcc, 1u, __ATOMIC_RELAXED, __HIP_MEMORY_SCOPE_AGENT);
                    if (old + 1 == k * nx) {
                        __builtin_amdgcn_fence(__ATOMIC_RELEASE, "agent"); asm volatile("s_waitcnt vmcnt(0)" ::: "memory");
                        const unsigned t = __hip_atomic_fetch_add(c2 + 1088, 1u, __ATOMIC_RELAXED, __HIP_MEMORY_SCOPE_AGENT);
                        if (t + 1 == k * nxcc) __hip_atomic_store(c2 + 1152, k, __ATOMIC_RELAXED, __HIP_MEMORY_SCOPE_AGENT);
                    }
                    while (__hip_atomic_load(c2 + 1152, __ATOMIC_RELAXED, __HIP_MEMORY_SCOPE_AGENT) < k) __builtin_amdgcn_s_sleep(1);
                    __builtin_amdgcn_fence(__ATOMIC_ACQUIRE, "agent"); asm volatile("s_waitcnt vmcnt(0)" ::: "memory");
                }
            }
            __syncthreads();
        }
        const __attribute__((address_space(4))) Params* pp = (const __attribute__((address_space(4))) Params*)__builtin_amdgcn_kernarg_segment_ptr();
        asm volatile("" : "+s"(pp) :: "memory");
        Params p;
#pragma unroll
        for (int i = 0; i < 33; ++i) p.in[i] = (const float*)(__attribute__((address_space(1))) const float*)pp->in[i];
        p.out = (float*)(__attribute__((address_space(1))) float*)pp->out; p.ws = (unsigned char*)(__attribute__((address_space(1))) unsigned char*)pp->ws;
        run_phase<PH, DUMMY>(p, lds);
    }
}
template <> __device__ __forceinline__ void run_phase<9, false>(const Params& p, LAS unsigned char* lds) {
    unsigned char* ws = p.ws; const int G = gridDim.x, bid = blockIdx.x; const int wid = threadIdx.x >> 6, lane = threadIdx.x & 63;
    for (int r = bid * 8 + wid; r < MT; r += G * 8) {
#pragma unroll
        for (int c = 0; c < 4; ++c) { const int col = c * 256 + lane * 4; f32x4 o;
#if DBG == 1
            const bf16_t* y3 = (const bf16_t*)(ws + WS_Y3); float a[4], b[4], d[4];
            unpack4(*(const u32x2*)(y3 + (size_t)r * 1024 + col), a); unpack4(*(const u32x2*)(y3 + (size_t)(MT + r) * 1024 + col), b); unpack4(*(const u32x2*)(y3 + (size_t)(2 * MT + r) * 1024 + col), d);
            for (int q = 0; q < 4; ++q) o[q] = a[q] + 2.f * b[q] + 4.f * d[q];
#elif DBG == 2
            float a[4]; unpack4(*(const u32x2*)((const bf16_t*)(ws + WS_MB) + (size_t)r * 1024 + col), a); for (int q = 0; q < 4; ++q) o[q] = a[q];
#elif DBG == 3
            o = *(const f32x4*)((const float*)(ws + WS_X1) + (size_t)r * 1024 + col);
#elif DBG == 4
            float a[4], b[4]; unpack4(*(const u32x2*)((const bf16_t*)(ws + WS_HID) + (size_t)r * DFF + col), a); unpack4(*(const u32x2*)((const bf16_t*)(ws + WS_HID) + (size_t)r * DFF + 2048 + col), b); for (int q = 0; q < 4; ++q) o[q] = a[q] + b[q];
#elif DBG == 5
            const bf16_t* y3 = (const bf16_t*)(ws + WS_Y3) + (size_t)(DBGSEL * MT + r) * 1024 + col; float a[4]; unpack4(*(const u32x2*)y3, a); for (int q = 0; q < 4; ++q) o[q] = a[q];
#else
            o = (f32x4){0.f, 0.f, 0.f, 0.f};
#endif
            *(f32x4*)(p.out + (size_t)r * 1024 + col) = o; } }
}
__global__ __launch_bounds__(512, 2) void mega(Params p, int ph_lo, int ph_hi) {
    extern __shared__ __attribute__((aligned(16))) unsigned char shm[];
    LAS unsigned char* lds = (LAS unsigned char*)shm;
    cg::grid_group grid = cg::this_grid();
#ifndef DUP
#define DUP -1
#endif
    unsigned nbar = 0;
    { const __attribute__((address_space(4))) Params* pq = (const __attribute__((address_space(4))) Params*)__builtin_amdgcn_kernarg_segment_ptr();
      __attribute__((address_space(1))) unsigned char* wsb = (__attribute__((address_space(1))) unsigned char*)pq->ws;
      if (ph_lo < 0) grid.sync();
      if (threadIdx.x == 0) { const unsigned xcc = (unsigned)__builtin_amdgcn_s_getreg((3 << 11) | 20) & 0xFu;
          __hip_atomic_fetch_add((__attribute__((address_space(1))) unsigned*)(wsb + WS_CTL2) + 1024 + xcc, 1u, __ATOMIC_RELAXED, __HIP_MEMORY_SCOPE_AGENT); } }
#define PSTEP(k) if (DUP == k) phase_step<k, true>(ph_lo, ph_hi, lds, grid, nbar); phase_step<k, false>(ph_lo, ph_hi, lds, grid, nbar);
    PSTEP(0) PSTEP(1) PSTEP(2) PSTEP(11) PSTEP(3)
#if P3SPLIT
    PSTEP(10)
#endif
    PSTEP(4) PSTEP(5) PSTEP(6) PSTEP(7) PSTEP(8)
#if DBG
    phase_step<9>(ph_lo, 10, lds, grid, nbar);
#endif
}

extern "C" void kernel_launch(void* const* d_in, const int* in_sizes, int n_in, void* d_out, int out_size, void* d_ws, size_t ws_size, hipStream_t stream) {
    static int grid_blocks = 0;
    if (grid_blocks == 0) {
        if (n_in != 33 || out_size != (int)O_END || ws_size < WS_END) { fprintf(stderr, "kernel_launch: unexpected shapes (n_in %d out %d ws %zu, need ws %zu)\n", n_in, out_size, ws_size, (size_t)WS_END); grid_blocks = -1; return; }
        int dev = 0, cus = 0, per_cu = 0;
        hipGetDevice(&dev); hipDeviceGetAttribute(&cus, hipDeviceAttributeMultiprocessorCount, dev);
        hipFuncSetAttribute((const void*)mega, hipFuncAttributeMaxDynamicSharedMemorySize, LDS_BYTES);
        hipOccupancyMaxActiveBlocksPerMultiprocessor(&per_cu, (const void*)mega, 512, LDS_BYTES);
        if (per_cu < 1) { fprintf(stderr, "kernel_launch: occupancy query says %d blocks per CU\n", per_cu); grid_blocks = -1; return; }
        grid_blocks = cus * 1;
        if (grid_blocks < 128) { fprintf(stderr, "kernel_launch: needs >= 128 CUs\n"); grid_blocks = -1; return; }
    }
    if (grid_blocks < 0) return;
    hipMemsetAsync((char*)d_ws + WS_CTL, 0, WS_WTIN - WS_CTL, stream);
    Params p{};
    for (int i = 0; i < 33; ++i) p.in[i] = (const float*)d_in[i];
    p.out = (float*)d_out; p.ws = (unsigned char*)d_ws;
#if DBG
    int lo = 0, hi = DBG_HI;
#else
    int lo = 0, hi = 9;
#endif
    void* args[] = {&p, &lo, &hi};
    hipError_t e = hipLaunchCooperativeKernel((const void*)mega, dim3(grid_blocks), dim3(512), args, LDS_BYTES, stream);
    if (e != hipSuccess) fprintf(stderr, "cooperative launch failed: %s (grid %d)\n", hipGetErrorString(e), grid_blocks);
}
```
